# Optimizing an MI355X kernel written in HIP

```python
import math, functools
import jax, jax.numpy as jnp
from jax import lax
import numpy as np

D_MODEL = 1024
BATCH = 8
SEQ = 8192
DEPTH = 1

GRID_W = 64
CTX_LEN = 256
D_FOURIER = 512
F_GROUPS = 4
F_GROUP_DIM = D_FOURIER // F_GROUPS
D_RNN = 1024
RNN_HEADS = 8
RNN_BLOCK = D_RNN // RNN_HEADS
CONV_W = 4
CONV_LEFT = 2
LRU_C = 8.0
COL_R0 = D_FOURIER
COL_G0 = COL_R0 + D_RNN
COL_M0 = COL_G0 + D_RNN
D_IN = COL_M0 + 2 * D_MODEL
N_EXPERTS = 32
TOP_K = 4
D_EXPERT = 1024
SWIGLU_ALPHA = 1.702
SWIGLU_LIMIT = 7.0
MOE_BLOCK = 256
EPS = 1e-6

kernel_name = "hybrid_fnet_rglru_moe_dit_block"


def rms_norm(x, g):
    xf = x.astype(jnp.float32)
    y = xf * lax.rsqrt(jnp.mean(xf * xf, axis=-1, keepdims=True) + EPS)
    return (y * g.astype(jnp.float32)).astype(x.dtype)


def ada_modulation(cond, w_ada, b_ada):
    m = jax.nn.silu(cond) @ w_ada + b_ada
    return jnp.split(m, 6, axis=-1)


def centred_conv(u, w, b):
    L = u.shape[-2]
    pad = [(0, 0)] * (u.ndim - 2) + [(CONV_LEFT, CONV_W - 1 - CONV_LEFT), (0, 0)]
    up = jnp.pad(u, pad)
    out = b + up[..., 0:L, :] * w[0]
    for k in range(1, CONV_W):
        out = out + up[..., k:k + L, :] * w[k]
    return out


def fourier_mix(u):
    b_, L, _ = u.shape
    ug = u.astype(jnp.float32).reshape(b_, L, F_GROUPS, F_GROUP_DIM)
    y = jnp.fft.fftn(ug, axes=(1, 3), norm="ortho").real
    return y.reshape(b_, L, D_FOURIER).astype(u.dtype)


def rglru_coeffs(xc, wa, ba, wx, bx, lam):
    b_, L, _ = xc.shape
    xh = xc.reshape(b_, L, RNN_HEADS, RNN_BLOCK)
    r = jax.nn.sigmoid(jnp.einsum('blhi,hij->blhj', xh, wa.astype(jnp.float32)).reshape(b_, L, D_RNN) + ba.astype(jnp.float32))
    i = jax.nn.sigmoid(jnp.einsum('blhi,hij->blhj', xh, wx.astype(jnp.float32)).reshape(b_, L, D_RNN) + bx.astype(jnp.float32))
    log_a = -LRU_C * r * jax.nn.softplus(-lam.astype(jnp.float32))
    a = jnp.exp(log_a)
    bt = jnp.sqrt(-jnp.expm1(2.0 * log_a)) * (i * xc)
    return a, bt


def _combine(e1, e2):
    a1, b1 = e1
    a2, b2 = e2
    return a1 * a2, a2 * b1 + b2


def linear_scan(a, bt, h0, reverse):
    idx = -1 if reverse else 0
    bt = bt.at[:, idx].add(a[:, idx] * h0)
    _, h = lax.associative_scan(_combine, (a, bt), axis=1, reverse=reverse)
    return h


def bidir_rglru(xc, wa, ba, wx, bx, lam, h0s):
    y = None
    finals = []
    for d, rev in enumerate((False, True)):
        a, bt = rglru_coeffs(xc, wa[d], ba[d], wx[d], bx[d], lam[d])
        h = linear_scan(a, bt, h0s[d], rev)
        y = h if y is None else y + h
        finals.append(h[:, 0] if rev else h[:, -1])
    return y, finals


def merge_branches(z, y_rnn, w_f, w_r, w_o):
    f_out = fourier_mix(z[..., :COL_R0]) @ w_f
    r_out = (y_rnn.astype(z.dtype) * jax.nn.gelu(z[..., COL_G0:COL_M0])) @ w_r
    g_f = jax.nn.sigmoid(z[..., COL_M0:COL_M0 + D_MODEL])
    g_r = jax.nn.sigmoid(z[..., COL_M0 + D_MODEL:])
    return (g_f * f_out + g_r * r_out) @ w_o


def moe_ffn(h, w_router, b_router, w_gu, b_gu, w_down, b_down):
    shp = h.shape
    d = shp[-1]
    t = h.reshape(-1, d)
    T = t.shape[0]
    logits = (t @ w_router + b_router).astype(jnp.float32)
    top_v, top_i = lax.top_k(logits, TOP_K)
    wts = jax.nn.softmax(top_v, axis=-1)
    A = T * TOP_K
    flat_e = top_i.reshape(-1).astype(jnp.int32)
    order = jnp.argsort(flat_e, stable=True).astype(jnp.int32)
    sorted_e = flat_e[order]
    counts = jnp.bincount(flat_e, length=N_EXPERTS).astype(jnp.int32)
    padded = (counts + MOE_BLOCK - 1) // MOE_BLOCK * MOE_BLOCK
    start_sorted = jnp.cumsum(counts) - counts
    ends_pad = jnp.cumsum(padded)
    start_pad = ends_pad - padded
    rank = jnp.arange(A, dtype=jnp.int32) - start_sorted[sorted_e]
    dest = start_pad[sorted_e] + rank
    n_blocks = (A + N_EXPERTS * (MOE_BLOCK - 1) + MOE_BLOCK - 1) // MOE_BLOCK
    P = n_blocks * MOE_BLOCK
    slot_tok = jnp.full((P,), T, jnp.int32).at[dest].set(order // TOP_K)
    slot_w = jnp.zeros((P,), jnp.float32).at[dest].set(wts.reshape(-1)[order])
    block_start = jnp.arange(n_blocks, dtype=jnp.int32) * MOE_BLOCK
    block_expert = jnp.minimum(jnp.searchsorted(ends_pad, block_start, side='right'), N_EXPERTS - 1).astype(jnp.int32)
    t_pad = jnp.concatenate([t, jnp.zeros((1, d), t.dtype)], axis=0)

    def expert_block(args):
        idx, wgt, e = args
        xb = t_pad[idx]
        gu = xb @ w_gu[e] + b_gu[e]
        gate = jnp.minimum(gu[:, :D_EXPERT], SWIGLU_LIMIT)
        up = jnp.clip(gu[:, D_EXPERT:], -SWIGLU_LIMIT, SWIGLU_LIMIT)
        act = (up + 1.0) * gate * jax.nn.sigmoid(SWIGLU_ALPHA * gate)
        yb = act @ w_down[e] + b_down[e]
        return yb * wgt[:, None].astype(yb.dtype)

    ys = lax.map(expert_block, (slot_tok.reshape(n_blocks, MOE_BLOCK),
                                slot_w.reshape(n_blocks, MOE_BLOCK), block_expert))
    y = jnp.zeros((T + 1, d), ys.dtype).at[slot_tok].add(ys.reshape(P, d))[:T]
    return y.reshape(shp).astype(h.dtype)


def setup_inputs(seed: int = 0) -> dict:
    key = jax.random.key(seed)
    ks = jax.random.split(key, 32)
    f32 = jnp.float32
    nrm = lambda k, s, sc: jax.random.normal(k, s, f32) * sc
    u = jax.random.uniform(ks[16], (DEPTH, 2, D_RNN), f32, 0.9, 0.999)
    a0 = u ** (1.0 / LRU_C)
    lru_lambda = jnp.log(a0) - jnp.log1p(-a0)
    return {
        "x": nrm(ks[0], (BATCH, SEQ, D_MODEL), 1.0),
        "c": nrm(ks[1], (BATCH, D_MODEL), 1.0),
        "ctx": nrm(ks[2], (BATCH, CTX_LEN, D_MODEL), 1.0),
        "c_ctx": nrm(ks[3], (D_MODEL,), 1.0),
        "w_ada": nrm(ks[4], (DEPTH, D_MODEL, 6 * D_MODEL), 0.5 * D_MODEL ** -0.5),
        "b_ada": nrm(ks[5], (DEPTH, 6 * D_MODEL), 0.01),
        "norm1": 1.0 + nrm(ks[6], (DEPTH, D_MODEL), 0.02),
        "w_in": nrm(ks[7], (DEPTH, D_MODEL, D_IN), D_MODEL ** -0.5),
        "conv_w": nrm(ks[8], (DEPTH, CONV_W, D_RNN), CONV_W ** -0.5),
        "conv_b": nrm(ks[9], (DEPTH, D_RNN), 0.01),
        "gate_a_w": nrm(ks[10], (DEPTH, 2, RNN_HEADS, RNN_BLOCK, RNN_BLOCK), RNN_BLOCK ** -0.5),
        "gate_a_b": nrm(ks[11], (DEPTH, 2, D_RNN), 0.01),
        "gate_x_w": nrm(ks[12], (DEPTH, 2, RNN_HEADS, RNN_BLOCK, RNN_BLOCK), RNN_BLOCK ** -0.5),
        "gate_x_b": nrm(ks[13], (DEPTH, 2, D_RNN), 0.01),
        "lru_lambda": lru_lambda,
        "w_fourier": nrm(ks[14], (DEPTH, D_FOURIER, D_MODEL), D_FOURIER ** -0.5),
        "w_rnn": nrm(ks[15], (DEPTH, D_RNN, D_MODEL), D_RNN ** -0.5),
        "w_out": nrm(ks[17], (DEPTH, D_MODEL, D_MODEL), D_MODEL ** -0.5),
        "norm2": 1.0 + nrm(ks[18], (DEPTH, D_MODEL), 0.02),
        "w_router": nrm(ks[19], (DEPTH, D_MODEL, N_EXPERTS), D_MODEL ** -0.5),
        "b_router": nrm(ks[20], (DEPTH, N_EXPERTS), 0.01),
        "w_gu": nrm(ks[21], (DEPTH, N_EXPERTS, D_MODEL, 2 * D_EXPERT), D_MODEL ** -0.5),
        "b_gu": nrm(ks[22], (DEPTH, N_EXPERTS, 2 * D_EXPERT), 0.01),
        "w_down": nrm(ks[23], (DEPTH, N_EXPERTS, D_EXPERT, D_MODEL), D_EXPERT ** -0.5),
        "b_down": nrm(ks[24], (DEPTH, N_EXPERTS, D_MODEL), 0.01),
        "norm_f": 1.0 + nrm(ks[25], (D_MODEL,), 0.02),
    }


def reference(x, c, ctx, c_ctx, w_ada, b_ada, norm1, w_in, conv_w, conv_b, gate_a_w, gate_a_b,
              gate_x_w, gate_x_b, lru_lambda, w_fourier, w_rnn, w_out, norm2, w_router, b_router,
              w_gu, b_gu, w_down, b_down, norm_f):
    bsz, seq, _ = x.shape
    rows = seq // GRID_W
    for l in range(DEPTH):
        last = l == DEPTH - 1
        sh1, sc1, g1, sh2, sc2, g2 = [m[:, None, :] for m in ada_modulation(c, w_ada[l], b_ada[l])]
        csh1, csc1, cg1, csh2, csc2, cg2 = ada_modulation(c_ctx, w_ada[l], b_ada[l])
        lru_p = (gate_a_w[l], gate_a_b[l], gate_x_w[l], gate_x_b[l], lru_lambda[l])

        hc = rms_norm(ctx, norm1[l]) * (1.0 + csc1) + csh1
        uc = centred_conv(hc @ w_in[l][:, COL_R0:COL_G0], conv_w[l], conv_b[l]).astype(jnp.float32)
        h_zero = jnp.zeros((bsz, D_RNN), jnp.float32)
        yc, h_ctx_final = bidir_rglru(uc, *lru_p, [h_zero, h_zero])

        hx = rms_norm(x, norm1[l]) * (1.0 + sc1) + sh1
        zx = hx @ w_in[l]
        ux = centred_conv(zx[..., COL_R0:COL_G0].reshape(bsz, rows, GRID_W, D_RNN),
                          conv_w[l], conv_b[l]).reshape(bsz, seq, D_RNN).astype(jnp.float32)
        yx, _ = bidir_rglru(ux, *lru_p, h_ctx_final)
        x = x + g1 * merge_branches(zx, yx, w_fourier[l], w_rnn[l], w_out[l])
        if not last:
            zc = hc @ w_in[l]
            ctx = ctx + cg1 * merge_branches(zc, yc, w_fourier[l], w_rnn[l], w_out[l])

        moe_p = (w_router[l], b_router[l], w_gu[l], b_gu[l], w_down[l], b_down[l])
        x = x + g2 * moe_ffn(rms_norm(x, norm2[l]) * (1.0 + sc2) + sh2, *moe_p)
        if not last:
            ctx = ctx + cg2 * moe_ffn(rms_norm(ctx, norm2[l]) * (1.0 + csc2) + csh2, *moe_p)
    return rms_norm(x, norm_f)
```

```cpp
#include <hip/hip_runtime.h>
#include <cstdio>
#include <cstdint>

#ifndef SPLIT_LAUNCH
#define SPLIT_LAUNCH 0
#endif

#define GAS __attribute__((address_space(1)))
#define LAS __attribute__((address_space(3)))
typedef unsigned short bf16_t;
typedef short bf16x8 __attribute__((ext_vector_type(8)));
typedef float f32x4 __attribute__((ext_vector_type(4)));
typedef float f32x2 __attribute__((ext_vector_type(2)));
typedef unsigned u32x4 __attribute__((ext_vector_type(4)));
typedef unsigned u32x2 __attribute__((ext_vector_type(2)));

constexpr int D = 1024, NB = 8, SEQ = 8192, T = NB * SEQ, CTXL = 256, TC = NB * CTXL, MT = T + TC;
constexpr int DIN = 4608, NCAT = 5120;
constexpr int NE = 32, TOPK = 4, DE = 1024;
constexpr float EPS = 1e-6f;
constexpr int HALF_T = T / 2;
constexpr int PHALF = HALF_T * TOPK + NE * 256;

constexpr size_t MiB = 1u << 20;
constexpr size_t WS_CTL = 0, CTL_BYTES = 1 * MiB;
constexpr size_t WS_MOD = 1 * MiB;
constexpr size_t WS_WCAT = 2 * MiB;
constexpr size_t WS_WF = 12 * MiB;
constexpr size_t WS_WR = 13 * MiB;
constexpr size_t WS_WO = 15 * MiB;
constexpr size_t WS_GW = 17 * MiB;
constexpr size_t WS_WROUT = 18 * MiB;
constexpr size_t WS_AGG = 19 * MiB;
constexpr size_t WS_ROUTE = 26 * MiB;
constexpr size_t WS_B0 = 32 * MiB;
constexpr size_t WS_B1 = 164 * MiB;
constexpr size_t WS_B2 = 292 * MiB;
constexpr size_t WS_B3 = 424 * MiB;
constexpr size_t WS_B4 = 552 * MiB;
constexpr size_t WS_B5 = 680 * MiB;
constexpr size_t WS_B6 = 808 * MiB;
constexpr size_t WS_B7 = 936 * MiB;
constexpr size_t WS_WGU = WS_B1;
constexpr size_t WS_WD = WS_B2;
constexpr size_t WS_ACT = 356 * MiB;
constexpr size_t WS_OUTA = 628 * MiB;
constexpr size_t WS_END = 1000 * MiB;
static_assert((size_t)PHALF * 2048 <= 272 * MiB, "act capacity");
constexpr size_t RT_TOPI = 0;
constexpr size_t RT_TOPW = 256 * 1024;
constexpr size_t RT_RANK = RT_TOPW + 1 * MiB;
constexpr size_t RT_HIST = RT_RANK + 512 * 1024;
constexpr size_t RT_SLOTTOK = RT_HIST + 32 * 1024;
constexpr size_t RT_SLOTW = RT_SLOTTOK + 1152 * 1024;
constexpr size_t RT_TOKSLOT = RT_SLOTW + 1152 * 1024;
constexpr size_t RT_TILEEXP = RT_TOKSLOT + 1 * MiB;
constexpr size_t RT_END = RT_TILEEXP + 8192;
static_assert(RT_END <= 6 * MiB, "route tables");
constexpr int CW_NTILES = 16;
constexpr int CW_BAR = 4096;

constexpr int NWAVES = 8, NTHREADS = 512;
constexpr int LDS_BYTES = 155648;
constexpr int LDS_MISC = 151552;

__device__ __forceinline__ unsigned f2bf(float f) { unsigned u = __builtin_bit_cast(unsigned, f); return (u + 0x7fffu + ((u >> 16) & 1u)) >> 16; }
__device__ __forceinline__ unsigned pk2(float lo, float hi) { return f2bf(lo) | (f2bf(hi) << 16); }
__device__ __forceinline__ unsigned cvt_pk_bf16(float lo, float hi) { unsigned r; asm volatile("v_cvt_pk_bf16_f32 %0, %1, %2" : "=v"(r) : "v"(lo), "v"(hi)); return r; }
__device__ __forceinline__ float bf2f(unsigned short b) { return __builtin_bit_cast(float, (unsigned)b << 16); }
__device__ __forceinline__ float bflo(unsigned w) { return __builtin_bit_cast(float, w << 16); }
__device__ __forceinline__ float bfhi(unsigned w) { return __builtin_bit_cast(float, w & 0xffff0000u); }
__device__ __forceinline__ float fast_sigmoid(float x) { return __builtin_amdgcn_rcpf(1.0f + __builtin_amdgcn_exp2f(-1.44269504f * x)); }
__device__ __forceinline__ float wave_sum(float v) {
#pragma unroll
    for (int o = 1; o < 64; o <<= 1) v += __shfl_xor(v, o);
    return v;
}

namespace pg8 {
constexpr int BM = 256, BK = 64, HALF = 128, HTB = HALF * BK * 2, STAGE_BYTES = 8 * HTB, NXCD = 8, WGM = 8;
__host__ __device__ __forceinline__ int lds_byte(int r, int c) { const int st = (r >> 4) * 2 + (c >> 5), rr = r & 15, cc = c & 31, ob = rr * 64 + cc * 2; return st * 1024 + (ob ^ (((ob >> 9) & 1) << 5)); }
__host__ __device__ __forceinline__ void stage_rc(int b, int& R, int& C) { const int st = b / 1024, sb = b % 1024, swz = sb ^ (((sb >> 9) & 1) << 5); R = (st >> 1) * 16 + swz / 64; C = (st & 1) * 32 + (swz % 64) / 2; }
__host__ __device__ __forceinline__ int perm32(int rho) { const int n = rho >> 4, i = rho & 15; return 8 * (i >> 2) + 4 * n + (i & 3); }

struct Unit { int pm, pn, aux; const char* A; const char* B; };

__device__ __forceinline__ bool tile_order(long L, int nM, int nN, int& pm, int& pn) {
    const int nwg = nM * nN; if (L >= nwg) return false;
    int wgid = (int)L; { const int q = nwg / NXCD, r = nwg % NXCD, xcd = wgid % NXCD, off = wgid / NXCD; wgid = (xcd < r ? xcd * (q + 1) : r * (q + 1) + (xcd - r) * q) + off; }
    const int nig = WGM * nN, gid = wgid / nig, fm = gid * WGM, gsz = (nM - fm) < WGM ? (nM - fm) : WGM;
    pm = fm + ((wgid % nig) % gsz); pn = (wgid % nig) / gsz; return true;
}

template <class Epi, class Sched, bool GATHER>
__device__ __forceinline__ void gemm_phase(LAS unsigned char* lds, const Sched& S, const Epi& E, const int nt, const unsigned lda, const unsigned ldb) {
    int tid_ = threadIdx.x; asm volatile("" : "+v"(tid_));
    const int tid = tid_, wid = __builtin_amdgcn_readfirstlane(tid >> 6), lane = tid & 63, wr = wid >> 2, wc = wid & 3, fr = lane & 15, fq = lane >> 4;
    unsigned voffA[2][2], nvoffA[2][2], voffB[2]; int RA[2], CA[2];
#pragma unroll
    for (int i = 0; i < 2; ++i) { int R, C; stage_rc(tid * 16 + i * 8192, R, C); const int Rb = Epi::PERM ? ((R & ~31) + perm32(R & 31)) : R;
        RA[i] = R; CA[i] = C;
        voffA[0][i] = (unsigned)R * lda + (unsigned)C * 2u; voffA[1][i] = (unsigned)(R + HALF) * lda + (unsigned)C * 2u;
        nvoffA[0][i] = voffA[0][i]; nvoffA[1][i] = voffA[1][i];
        voffB[i] = (unsigned)Rb * ldb + (unsigned)C * 2u; }
    const size_t kstep = (size_t)(BK * 2);
    const size_t hstepB = (size_t)HALF * ldb;
    const unsigned ldsw = (unsigned)wid * 1024u;
    const int aoff = lds_byte(wr * 64 + fr, fq * 8), boff = lds_byte(wc * 32 + fr, fq * 8);
#define PG8_SA(b, h) (((b) * 2 + (h)) * HTB)
#define PG8_SB(b, h) ((4 + (b) * 2 + (h)) * HTB)
#define PG8_STAGE2(bufoff, gbase, o0, o1) do { \
        __builtin_amdgcn_global_load_lds((const unsigned*)((const char*)(gbase) + (o0)), (LAS unsigned*)(lds + (bufoff) + ldsw), 16, 0, 0); \
        __builtin_amdgcn_global_load_lds((const unsigned*)((const char*)(gbase) + (o1)), (LAS unsigned*)(lds + (bufoff) + ldsw + 8192), 16, 0, 0); } while (0)
#define PG8_STAGE_B(bufoff, gbase) PG8_STAGE2(bufoff, gbase, voffB[0], voffB[1])
#define PG8_STAGE_A(bufoff, gbase, hh) PG8_STAGE2(bufoff, gbase, voffA[hh][0], voffA[hh][1])
#define PG8_STAGE_AN(bufoff, gbase, hh, usenext) PG8_STAGE2(bufoff, gbase, ((usenext) ? nvoffA[hh][0] : voffA[hh][0]), ((usenext) ? nvoffA[hh][1] : voffA[hh][1]))
#define PG8_LDA(dst, b, h) do { _Pragma("unroll") for (int m = 0; m < 4; ++m) _Pragma("unroll") for (int k = 0; k < 2; ++k) dst[m][k] = *(const LAS bf16x8*)(lds + PG8_SA(b, h) + aoff + m * 2048 + k * 1024); } while (0)
#define PG8_LDB(dst, b, h) do { _Pragma("unroll") for (int n = 0; n < 2; ++n) _Pragma("unroll") for (int k = 0; k < 2; ++k) dst[n][k] = *(const LAS bf16x8*)(lds + PG8_SB(b, h) + boff + n * 2048 + k * 1024); } while (0)
#define PG8_MMA(ai, bj, At, Bt) do { __builtin_amdgcn_s_setprio(1); _Pragma("unroll") for (int m = 0; m < 4; ++m) _Pragma("unroll") for (int n = 0; n < 2; ++n) _Pragma("unroll") for (int k = 0; k < 2; ++k) \
        acc[ai][bj][m][n] = __builtin_amdgcn_mfma_f32_16x16x32_bf16(Bt[n][k], At[m][k], acc[ai][bj][m][n], 0, 0, 0); __builtin_amdgcn_s_setprio(0); } while (0)
#define PG8_WAIT_V(n) asm volatile("s_waitcnt vmcnt(" #n ")" ::: "memory")
#define PG8_WAIT_L(n) asm volatile("s_waitcnt lgkmcnt(" #n ")" ::: "memory")
#define PG8_BAR __builtin_amdgcn_s_barrier()
#define PG8_SCHED __builtin_amdgcn_sched_barrier(0)
    Unit cur, nxt; int ui = 0;
    if (!S.next(0, cur)) return;
    if constexpr (GATHER) {
#pragma unroll
        for (int hh = 0; hh < 2; ++hh)
#pragma unroll
            for (int i = 0; i < 2; ++i) voffA[hh][i] = (unsigned)S.row(cur, hh * HALF + RA[i]) * lda + (unsigned)CA[i] * 2u;
    }
    f32x4 acc[2][2][4][2];
#pragma unroll
    for (int a = 0; a < 2; ++a)
#pragma unroll
        for (int b = 0; b < 2; ++b)
#pragma unroll
            for (int m = 0; m < 4; ++m)
#pragma unroll
                for (int n = 0; n < 2; ++n) acc[a][b][m][n] = (f32x4){0.f, 0.f, 0.f, 0.f};
    bf16x8 At[4][2], B0[2][2], B1[2][2];
    const char* cA = cur.A; const char* cB = cur.B;
    PG8_STAGE_B(PG8_SB(0, 0), cB); PG8_STAGE_B(PG8_SB(0, 1), cB + hstepB); PG8_STAGE_A(PG8_SA(0, 0), cA, 0); PG8_STAGE_A(PG8_SA(0, 1), cA, 1);
    if (wr == 1) PG8_BAR;
    PG8_WAIT_V(2); PG8_BAR;
    PG8_STAGE_B(PG8_SB(1, 0), cB + kstep); PG8_STAGE_A(PG8_SA(1, 0), cA + kstep, 0); PG8_STAGE_B(PG8_SB(1, 1), cB + hstepB + kstep);
    PG8_WAIT_V(6); PG8_BAR;
    for (;;) {
        const bool has_next = S.next(ui + 1, nxt);
        const char* nA = has_next ? nxt.A : cA; const char* nB = has_next ? nxt.B : cB;
        if constexpr (GATHER) {
            if (has_next) {
#pragma unroll
                for (int hh = 0; hh < 2; ++hh)
#pragma unroll
                    for (int i = 0; i < 2; ++i) nvoffA[hh][i] = (unsigned)S.row(nxt, hh * HALF + RA[i]) * lda + (unsigned)CA[i] * 2u;
            } else {
#pragma unroll
                for (int hh = 0; hh < 2; ++hh)
#pragma unroll
                    for (int i = 0; i < 2; ++i) nvoffA[hh][i] = voffA[hh][i];
            }
        }
        for (int t = 0; t < nt; t += 2) {
            const bool last = (t == nt - 2);
            const char* a1 = cA + (size_t)(t + 1) * kstep;
            const char* a2 = last ? nA : cA + (size_t)(t + 2) * kstep; const char* b2 = last ? nB : cB + (size_t)(t + 2) * kstep;
            const char* a3 = a2 + kstep; const char* b3 = b2 + kstep;
            const bool un = GATHER && last;
            PG8_LDB(B0, 0, 0); PG8_LDB(B1, 0, 1); PG8_SCHED; PG8_LDA(At, 0, 0); PG8_STAGE_A(PG8_SA(1, 1), a1, 1);
            PG8_WAIT_V(8); PG8_WAIT_L(0); PG8_BAR; PG8_MMA(0, 0, At, B0); PG8_MMA(0, 1, At, B1); PG8_BAR; PG8_SCHED;
            PG8_LDA(At, 0, 1); PG8_STAGE_B(PG8_SB(0, 0), b2); PG8_STAGE_B(PG8_SB(0, 1), b2 + hstepB); PG8_STAGE_AN(PG8_SA(0, 0), a2, 0, un);
            PG8_WAIT_V(8); PG8_WAIT_L(0); PG8_BAR; PG8_MMA(1, 0, At, B0); PG8_MMA(1, 1, At, B1); PG8_BAR; PG8_SCHED;
            PG8_LDB(B0, 1, 0); PG8_LDB(B1, 1, 1); PG8_SCHED; PG8_LDA(At, 1, 0); PG8_STAGE_AN(PG8_SA(0, 1), a2, 1, un);
            PG8_WAIT_V(8); PG8_WAIT_L(0); PG8_BAR; PG8_MMA(0, 0, At, B0); PG8_MMA(0, 1, At, B1); PG8_BAR; PG8_SCHED;
            PG8_LDA(At, 1, 1); PG8_STAGE_B(PG8_SB(1, 0), b3); PG8_STAGE_B(PG8_SB(1, 1), b3 + hstepB); PG8_STAGE_AN(PG8_SA(1, 0), a3, 0, un);
            PG8_WAIT_V(8); PG8_WAIT_L(0); PG8_BAR; PG8_MMA(1, 0, At, B0); PG8_MMA(1, 1, At, B1); PG8_BAR; PG8_SCHED;
        }
        if (wr == 0) PG8_BAR;
        E(acc, cur, wr, wc, fr, fq);
        if (!has_next) break;
#pragma unroll
        for (int a = 0; a < 2; ++a)
#pragma unroll
            for (int b = 0; b < 2; ++b)
#pragma unroll
                for (int m = 0; m < 4; ++m)
#pragma unroll
                    for (int n = 0; n < 2; ++n) acc[a][b][m][n] = (f32x4){0.f, 0.f, 0.f, 0.f};
        cur = nxt; cA = nA; cB = nB; ++ui;
        if constexpr (GATHER) {
#pragma unroll
            for (int hh = 0; hh < 2; ++hh)
#pragma unroll
                for (int i = 0; i < 2; ++i) voffA[hh][i] = nvoffA[hh][i];
        }
        if (wr == 1) PG8_BAR;
    }
    PG8_WAIT_V(0);
    PG8_BAR;
#undef PG8_SA
#undef PG8_SB
#undef PG8_STAGE2
#undef PG8_STAGE_A
#undef PG8_STAGE_AN
#undef PG8_STAGE_B
#undef PG8_LDA
#undef PG8_LDB
#undef PG8_MMA
#undef PG8_WAIT_V
#undef PG8_WAIT_L
#undef PG8_BAR
#undef PG8_SCHED
}
}

#define XB_TMO      128
#define XB_XCNT(j)  (256  + 64 * (j))
#define XB_XSUB(j)  (1280 + 64 * (j))
#define XB_XGEN(j)  (2304 + 64 * (j))
#define XB_TOP      3328
#define XB_TOPGEN   3392
#define XCD_BAR_WORDS 3456
#define XB_SPIN_CAP (1u << 22)

__device__ __forceinline__ unsigned xb_ld(unsigned* p)              { return __hip_atomic_load(p, __ATOMIC_RELAXED, __HIP_MEMORY_SCOPE_AGENT); }
__device__ __forceinline__ unsigned xb_add(unsigned* p, unsigned v) { return __hip_atomic_fetch_add(p, v, __ATOMIC_RELAXED, __HIP_MEMORY_SCOPE_AGENT); }
__device__ __forceinline__ unsigned xb_xcc_id() { return (unsigned)__builtin_amdgcn_s_getreg((3 << 11) | 20) & 0xFu; }
#define XB_SPIN(cond, bar) do { unsigned _sp = 0; while (cond) { __builtin_amdgcn_s_sleep(1); \
    if ((++_sp & 255u) == 0u) { if (xb_ld(&(bar)[XB_TMO])) break; if (_sp > XB_SPIN_CAP) { atomicAdd(&(bar)[XB_TMO], 1u); break; } } } } while (0)

struct XcdBarrier { unsigned* bar; unsigned x; volatile LAS unsigned* st; };

__device__ __forceinline__ XcdBarrier xcd_barrier_post(unsigned* bar, volatile LAS unsigned* st) {
    XcdBarrier b; b.bar = bar; b.x = xb_xcc_id(); b.st = st;
    if (threadIdx.x == 0) (void)xb_add(&bar[XB_XCNT(b.x)], 1u);
    return b;
}
__device__ __forceinline__ void xcd_barrier_complete(unsigned* bar, unsigned x, unsigned& nloc, unsigned& nx) {
    const unsigned G = gridDim.x * gridDim.y * gridDim.z;
    unsigned sum, cnt, mine, sp = 0u;
    for (;;) {
        sum = 0u; cnt = 0u; mine = 0u;
#pragma unroll
        for (unsigned j = 0; j < 16; ++j) { const unsigned c = xb_ld(&bar[XB_XCNT(j)]); sum += c; cnt += (c > 0u) ? 1u : 0u; mine = (j == x) ? c : mine; }
        if (sum == G) break;
        __builtin_amdgcn_s_sleep(1);
        if ((++sp & 255u) == 0u) { if (xb_ld(&bar[XB_TMO])) break; if (sp > XB_SPIN_CAP) { atomicAdd(&bar[XB_TMO], 1u); break; } }
    }
    nloc = mine > 0u ? mine : 1u; nx = cnt > 0u ? cnt : 1u;
}
__device__ __forceinline__ void xcd_barrier(const XcdBarrier& b) {
    asm volatile("s_waitcnt vmcnt(0)" ::: "memory");
    __syncthreads();
    if (threadIdx.x == 0) {
        unsigned* bar = b.bar;
        __builtin_amdgcn_s_waitcnt(0);
        unsigned nloc = b.st[0], nx = b.st[1];
        if (nloc == 0u) { xcd_barrier_complete(bar, b.x, nloc, nx); b.st[0] = nloc; b.st[1] = nx; }
        const unsigned old = xb_add(&bar[XB_XSUB(b.x)], 1u);
        const unsigned gen = old / nloc;
        if (old + 1u == (gen + 1u) * nloc) {
            __builtin_amdgcn_fence(__ATOMIC_RELEASE, "agent");
            asm volatile("s_waitcnt vmcnt(0)" ::: "memory");
            const unsigned og = xb_add(&bar[XB_TOP], 1u);
            const unsigned tg = og / nx;
            if (og + 1u == (tg + 1u) * nx) xb_add(&bar[XB_TOPGEN], 1u);
            else XB_SPIN(xb_ld(&bar[XB_TOPGEN]) == tg, bar);
            __builtin_amdgcn_fence(__ATOMIC_ACQUIRE, "agent");
            xb_add(&bar[XB_XGEN(b.x)], 1u);
            asm volatile("s_waitcnt vmcnt(0)" ::: "memory");
        } else {
            XB_SPIN(xb_ld(&bar[XB_XGEN(b.x)]) == gen, bar);
            __builtin_amdgcn_fence(__ATOMIC_ACQUIRE, "agent");
            asm volatile("s_waitcnt vmcnt(0)" ::: "memory");
        }
    }
    __syncthreads();
}

struct Params {
    const float *x, *c, *ctx, *c_ctx, *w_ada, *b_ada, *norm1, *w_in, *conv_w, *conv_b, *gate_a_w, *gate_a_b, *gate_x_w, *gate_x_b, *lam,
                *w_f, *w_r, *w_o, *norm2, *w_router, *b_router, *w_gu, *b_gu, *w_down, *b_down, *norm_f;
    float* out; unsigned char* ws;
    int ph_lo, ph_hi;
};
struct Frame {
    LAS unsigned char* lds; int tid, lane, wave, G, bid;
};
#define MODP(ws) ((const float*)((ws) + WS_MOD))
enum { M_SH1 = 0, M_SC1 = 1, M_G1 = 2, M_SH2 = 3, M_SC2 = 4, M_G2 = 5 };

__device__ __forceinline__ void p0_ada(const Params& p, Frame& F) {
    LAS float* scond = (LAS float*)F.lds;
    LAS float* red = (LAS float*)(F.lds + 9 * 1024 * 4);
    for (int i = F.tid; i < 9 * 1024; i += NTHREADS) { const int r = i >> 10, k = i & 1023; const float v = r < 8 ? p.c[r * 1024 + k] : p.c_ctx[k]; scond[i] = v / (1.0f + __expf(-v)); }
    __syncthreads();
    float* mod = (float*)(p.ws + WS_MOD);
    for (int item = F.bid; item < 6144 / 32; item += F.G) {
        const int n = item * 32 + (F.lane & 31), sl = F.wave * 2 + (F.lane >> 5);
        float a[9];
#pragma unroll
        for (int r = 0; r < 9; ++r) a[r] = 0.f;
#pragma unroll 8
        for (int kk = 0; kk < 64; ++kk) { const int k = sl * 64 + kk; const float w = p.w_ada[(size_t)k * 6144 + n];
#pragma unroll
            for (int r = 0; r < 9; ++r) a[r] += scond[r * 1024 + k] * w; }
#pragma unroll
        for (int r = 0; r < 9; ++r) red[(sl * 9 + r) * 32 + (F.lane & 31)] = a[r];
        __syncthreads();
        if (F.tid < 9 * 32) { const int r = F.tid >> 5, nn = F.tid & 31; float s = p.b_ada[item * 32 + nn];
            for (int q = 0; q < 16; ++q) s += red[(q * 9 + r) * 32 + nn];
            mod[r * 6144 + item * 32 + nn] = s; }
        __syncthreads();
    }
}
__device__ __forceinline__ void transpose_item(const float* W, int ldw, int ncol0, int k0, bf16_t* WT, int ldt, int drow0, LAS float* scr, int lane) {
#pragma unroll 8
    for (int i = 0; i < 32; ++i) { const int kk = 2 * i + (lane >> 5); scr[kk * 33 + (lane & 31)] = W[(size_t)(k0 + kk) * ldw + ncol0 + (lane & 31)]; }
    asm volatile("s_waitcnt lgkmcnt(0)" ::: "memory");
    const int c = lane & 7;
#pragma unroll
    for (int j = 0; j < 4; ++j) { const int n = (lane >> 3) + 8 * j; const LAS float* s = scr + (8 * c) * 33 + n;
        u32x4 o; o.x = pk2(s[0 * 33], s[1 * 33]); o.y = pk2(s[2 * 33], s[3 * 33]); o.z = pk2(s[4 * 33], s[5 * 33]); o.w = pk2(s[6 * 33], s[7 * 33]);
        *(u32x4*)(WT + (size_t)(drow0 + n) * ldt + k0 + 8 * c) = o; }
    asm volatile("s_waitcnt lgkmcnt(0)" ::: "memory");
}
__device__ __forceinline__ void transpose_matrix(const float* W, int K, int ldw, int c0, int N, bf16_t* WT, int drow0, LAS float* scr, int gw, int ngw, int lane) {
    const int nb = N / 32, nitems = (K / 64) * nb;
    for (int it = gw; it < nitems; it += ngw) { const int kb = it / nb, b = it % nb; transpose_item(W, ldw, c0 + 32 * b, 64 * kb, WT, K, drow0 + 32 * b, scr, lane); }
}
__device__ __forceinline__ void p0_weights(const Params& p, Frame& F) {
    unsigned char* ws = p.ws;
    LAS float* scr = (LAS float*)(F.lds + 65536 + F.wave * 8704);
    LAS float* tab = (LAS float*)(F.lds + 65536 + 8 * 8704);
    if (F.tid < 128) tab[F.tid] = cospif((float)F.tid / 64.0f);
    __syncthreads();
    const int gw = F.bid * NWAVES + F.wave, ngw = F.G * NWAVES;
    bf16_t* wcat = (bf16_t*)(ws + WS_WCAT);
    for (int it = gw; it < 1024 * 4; it += ngw) {
        const int k = it >> 2, g = it & 3; const float* src = p.w_in + (size_t)k * DIN + g * 128;
        float re0 = 0.f, re1 = 0.f, im0 = 0.f, im1 = 0.f; const int m0 = F.lane, m1 = F.lane + 64;
        for (int c = 0; c < 128; ++c) { const float u = src[c];
            re0 += u * tab[(m0 * c) & 127]; im0 -= u * tab[(m0 * c + 96) & 127];
            re1 += u * tab[(m1 * c) & 127]; im1 -= u * tab[(m1 * c + 96) & 127]; }
        const float sc = 0.08838834764831845f;
        wcat[(size_t)(g * 128 + m0) * 1024 + k] = (bf16_t)f2bf(re0 * sc); wcat[(size_t)(g * 128 + m1) * 1024 + k] = (bf16_t)f2bf(re1 * sc);
        wcat[(size_t)(512 + g * 128 + m0) * 1024 + k] = (bf16_t)f2bf(im0 * sc); wcat[(size_t)(512 + g * 128 + m1) * 1024 + k] = (bf16_t)f2bf(im1 * sc);
    }
    transpose_matrix(p.w_in, 1024, DIN, 512, 4096, wcat, 1024, scr, gw, ngw, F.lane);
    transpose_matrix(p.w_f, 512, 1024, 0, 1024, (bf16_t*)(ws + WS_WF), 0, scr, gw, ngw, F.lane);
    transpose_matrix(p.w_r, 1024, 1024, 0, 1024, (bf16_t*)(ws + WS_WR), 0, scr, gw, ngw, F.lane);
    transpose_matrix(p.w_o, 1024, 1024, 0, 1024, (bf16_t*)(ws + WS_WO), 0, scr, gw, ngw, F.lane);
    transpose_matrix(p.w_router, 1024, 32, 0, 32, (bf16_t*)(ws + WS_WROUT), 0, scr, gw, ngw, F.lane);
}
__device__ __forceinline__ void p_moe_weights(const Params& p, Frame& F) {
    LAS float* scr = (LAS float*)(F.lds + 65536 + F.wave * 8704);
    const int gw = F.bid * NWAVES + F.wave, ngw = F.G * NWAVES;
    bf16_t* wgu = (bf16_t*)(p.ws + WS_WGU); bf16_t* wd = (bf16_t*)(p.ws + WS_WD);
    constexpr int IT_GU = 16 * 64, IT_D = 16 * 32;
    for (int it = gw; it < NE * (IT_GU + IT_D); it += ngw) {
        const int e = it / (IT_GU + IT_D); int r = it % (IT_GU + IT_D);
        if (r < IT_GU) { const int kb = r / 64, b = r % 64, n0 = 32 * b; const int j = n0 & 1023, up = n0 >> 10;
            const int drow = 256 * (j >> 7) + 128 * up + (j & 127);
            transpose_item(p.w_gu + (size_t)e * 1024 * 2048, 2048, n0, 64 * kb, wgu + (size_t)e * 2048 * 1024, 1024, drow, scr, F.lane);
        } else { r -= IT_GU; const int kb = r / 32, b = r % 32;
            transpose_item(p.w_down + (size_t)e * 1024 * 1024, 1024, 32 * b, 64 * kb, wd + (size_t)e * 1024 * 1024, 1024, 32 * b, scr, F.lane); }
    }
}

__device__ __forceinline__ void norm_row_bf16(const float* xrow, const float* gain, const float* sc, const float* sh, bf16_t* orow, int lane) {
    const GAS f32x4* xr = (const GAS f32x4*)xrow + lane;
    f32x4 v[4]; float s = 0.f;
#pragma unroll
    for (int j = 0; j < 4; ++j) { v[j] = xr[64 * j]; s += (v[j].x * v[j].x + v[j].y * v[j].y) + (v[j].z * v[j].z + v[j].w * v[j].w); }
    const float rs = 1.0f / sqrtf(wave_sum(s) * (1.f / D) + EPS);
    GAS unsigned long long* o8 = (GAS unsigned long long*)orow + lane;
#pragma unroll
    for (int j = 0; j < 4; ++j) { const f32x4 g = ((const f32x4*)gain)[lane + 64 * j], a = ((const f32x4*)sc)[lane + 64 * j], b = ((const f32x4*)sh)[lane + 64 * j];
        const float o0 = v[j].x * rs * g.x * (1.f + a.x) + b.x, o1 = v[j].y * rs * g.y * (1.f + a.y) + b.y, o2 = v[j].z * rs * g.z * (1.f + a.z) + b.z, o3 = v[j].w * rs * g.w * (1.f + a.w) + b.w;
        o8[64 * j] = (unsigned long long)pk2(o0, o1) | ((unsigned long long)pk2(o2, o3) << 32); }
}
__device__ __forceinline__ void p1_norm(const Params& p, Frame& F) {
    const float* mod = MODP(p.ws); bf16_t* hx = (bf16_t*)(p.ws + WS_B0);
    const int gw = F.bid * NWAVES + F.wave, ngw = F.G * NWAVES;
    for (int m = gw; m < MT; m += ngw) {
        const float* src; int r;
        if (m < T) { src = p.x + (size_t)m * D; r = m / SEQ; } else { src = p.ctx + (size_t)(m - T) * D; r = 8; }
        norm_row_bf16(src, p.norm1, mod + r * 6144 + M_SC1 * 1024, mod + r * 6144 + M_SH1 * 1024, hx + (size_t)m * D, F.lane);
    }
}

struct Sched2 {
    const char* hx; const char* wcat; int G, c;
    __device__ __forceinline__ bool next(int i, pg8::Unit& u) const {
        const long L = (long)i * G + c; int pm, pn;
        if (L < 256 * 20) { pg8::tile_order(L, 256, 20, pm, pn); }
        else if (L < 256 * 20 + 32) { const int j = (int)(L - 256 * 20); pm = 256 + (j >> 2); pn = 4 + (j & 3); }
        else return false;
        u.pm = pm; u.pn = pn; u.aux = 0; u.A = hx + (size_t)pm * 256 * 2048; u.B = wcat + (size_t)pn * 256 * 2048; return true;
    }
};
__device__ __forceinline__ f32x4 gelu_tanh4(f32x4 v) {
    f32x4 o;
#pragma unroll
    for (int j = 0; j < 4; ++j) { const float x = v[j]; o[j] = x * fast_sigmoid(1.59576912f * x * (1.0f + 0.044715f * x * x)); }
    return o;
}
__device__ __forceinline__ f32x4 sigmoid4(f32x4 v) { f32x4 o;
#pragma unroll
    for (int j = 0; j < 4; ++j) o[j] = fast_sigmoid(v[j]);
    return o; }
struct Epi2 {
    static constexpr bool PERM = true;
    unsigned char* ws;
    __device__ __forceinline__ void operator()(const f32x4 (&acc)[2][2][4][2], const pg8::Unit& u, int wr, int wc, int fr, int fq) const {
        const int t = u.pn >> 2; const size_t boff = t == 0 ? WS_B1 : t == 1 ? WS_B2 : t == 2 ? WS_B3 : t == 3 ? WS_B4 : WS_B5;
        bf16_t* base = (bf16_t*)(ws + boff);
        const int row0 = u.pm * 256 + wr * 64 + fr, col0 = (u.pn & 3) * 256 + wc * 32 + 8 * fq;
#pragma unroll
        for (int ai = 0; ai < 2; ++ai)
#pragma unroll
            for (int m = 0; m < 4; ++m) { bf16_t* rowp = base + (size_t)(row0 + ai * 128 + m * 16) * 1024 + col0;
#pragma unroll
                for (int bj = 0; bj < 2; ++bj) { f32x4 v0 = acc[ai][bj][m][0], v1 = acc[ai][bj][m][1];
                    if (t == 2) { v0 = gelu_tanh4(v0); v1 = gelu_tanh4(v1); }
                    else if (t >= 3) { v0 = sigmoid4(v0); v1 = sigmoid4(v1); }
                    u32x4 w; w.x = cvt_pk_bf16(v0[0], v0[1]); w.y = cvt_pk_bf16(v0[2], v0[3]); w.z = cvt_pk_bf16(v1[0], v1[1]); w.w = cvt_pk_bf16(v1[2], v1[3]);
                    *(u32x4*)(rowp + bj * 128) = w; } }
    }
};

__device__ __forceinline__ void p3_rnn_naive(const Params& p, Frame& F) {
    LAS float* wa = (LAS float*)F.lds;
    LAS float* wx = wa + 128 * 128;
    LAS float* urow = wx + 128 * 128;
    LAS float* part = urow + 128;
    const bf16_t* zr = (const bf16_t*)(p.ws + WS_B2);
    bf16_t* hf = (bf16_t*)(p.ws + WS_B0); bf16_t* hb = (bf16_t*)(p.ws + WS_B6);
    const int c = F.tid & 127, part_i = F.tid >> 7;
    for (int chain = F.bid; chain < 128; chain += F.G) {
        const int b = chain >> 4, d = (chain >> 3) & 1, h = chain & 7, ch = h * 128 + c;
        __syncthreads();
        for (int i = F.tid; i < 128 * 128; i += NTHREADS) { wa[i] = p.gate_a_w[((size_t)(d * 8 + h) * 128) * 128 + i]; wx[i] = p.gate_x_w[((size_t)(d * 8 + h) * 128) * 128 + i]; }
        const float ba = p.gate_a_b[d * 1024 + ch], bx = p.gate_x_b[d * 1024 + ch];
        const float lam = p.lam[d * 1024 + ch]; const float spl = 8.0f * log1pf(expf(-lam));
        const float cw0 = p.conv_w[0 * 1024 + ch], cw1 = p.conv_w[1 * 1024 + ch], cw2 = p.conv_w[2 * 1024 + ch], cw3 = p.conv_w[3 * 1024 + ch], cb = p.conv_b[ch];
        float hstate = 0.f;
        __syncthreads();
        for (int step = 0; step < CTXL + SEQ; ++step) {
            const bool isctx = step < CTXL; const int s = isctx ? step : step - CTXL; const int len = isctx ? CTXL : SEQ;
            const int t = d ? (len - 1 - s) : s;
            const size_t rbase = isctx ? (size_t)T + (size_t)b * CTXL : (size_t)b * SEQ;
            float u = 0.f;
            if (part_i == 0) {
                const int lo = isctx ? 0 : (t & ~63), hi = isctx ? CTXL : lo + 64;
                u = cb;
                if (t - 2 >= lo) u += cw0 * bf2f(zr[(rbase + t - 2) * 1024 + ch]);
                if (t - 1 >= lo) u += cw1 * bf2f(zr[(rbase + t - 1) * 1024 + ch]);
                u += cw2 * bf2f(zr[(rbase + t) * 1024 + ch]);
                if (t + 1 < hi) u += cw3 * bf2f(zr[(rbase + t + 1) * 1024 + ch]);
                urow[c] = u;
            }
            __syncthreads();
            float pa = 0.f, px = 0.f;
#pragma unroll 8
            for (int i = 0; i < 32; ++i) { const int ii = part_i * 32 + i; const float uv = urow[ii]; pa += uv * wa[ii * 128 + c]; px += uv * wx[ii * 128 + c]; }
            part[(0 * 4 + part_i) * 128 + c] = pa; part[(1 * 4 + part_i) * 128 + c] = px;
            __syncthreads();
            if (part_i == 0) {
                const float sa = ba + part[c] + part[128 + c] + part[256 + c] + part[384 + c];
                const float sx = bx + part[512 + c] + part[640 + c] + part[768 + c] + part[896 + c];
                const float r = 1.0f / (1.0f + expf(-sa)), ig = 1.0f / (1.0f + expf(-sx));
                const float la = -spl * r, a = expf(la), bt = sqrtf(-expm1f(2.0f * la)) * (ig * u);
                hstate = a * hstate + bt;
                if (!isctx) { bf16_t* o = d ? hb : hf; o[(rbase + t) * 1024 + ch] = (bf16_t)f2bf(hstate); }
            }
        }
    }
}
__device__ __forceinline__ void p3_dftA_naive(const Params& p, Frame& F, int myi, int nbl) {
    LAS float* c64 = (LAS float*)(F.lds + 140 * 1024); LAS float* s64 = c64 + 64;
    __syncthreads();
    if (F.tid < 64) { c64[F.tid] = cospif((float)F.tid / 32.0f); s64[F.tid] = sinpif((float)F.tid / 32.0f); }
    __syncthreads();
    const bf16_t* V = (const bf16_t*)(p.ws + WS_B1); bf16_t* Tb = (bf16_t*)(p.ws + WS_B1);
    const int m = F.tid;
    for (int item = myi; item < NB * 128; item += nbl) {
        const int b = item >> 7, l2 = item & 127;
        float xr[64], xi[64];
#pragma unroll
        for (int l1 = 0; l1 < 64; ++l1) { const size_t row = (size_t)b * SEQ + 128 * l1 + l2; xr[l1] = bf2f(V[row * 1024 + m]); xi[l1] = bf2f(V[row * 1024 + 512 + m]); }
        for (int k1 = 0; k1 < 64; ++k1) {
            float ar = 0.f, ai = 0.f;
#pragma unroll
            for (int l1 = 0; l1 < 64; ++l1) { const int q = (k1 * l1) & 63; const float cc = c64[q], ss = s64[q];
                ar += cc * xr[l1] + ss * xi[l1]; ai += cc * xi[l1] - ss * xr[l1]; }
            float tc, ts; sincospif((float)(k1 * l2) / 4096.0f, &ts, &tc);
            const float orr = (ar * tc + ai * ts) * 0.125f, oi = (ai * tc - ar * ts) * 0.125f;
            const size_t orow = (size_t)b * SEQ + 128 * k1 + l2;
            Tb[orow * 1024 + m] = (bf16_t)f2bf(orr); Tb[orow * 1024 + 512 + m] = (bf16_t)f2bf(oi);
        }
    }
}
__device__ __forceinline__ void p4_dftB_naive(const Params& p, Frame& F) {
    LAS bf16_t* tile = (LAS bf16_t*)F.lds;
    LAS float* c128 = (LAS float*)(F.lds + 140 * 1024); LAS float* s128 = c128 + 128;
    __syncthreads();
    if (F.tid < 128) { c128[F.tid] = cospif((float)F.tid / 64.0f); s128[F.tid] = sinpif((float)F.tid / 64.0f); }
    const bf16_t* Tb = (const bf16_t*)(p.ws + WS_B1); bf16_t* Y = (bf16_t*)(p.ws + WS_B7);
    for (int item = F.bid; item < NB * 64 * 2; item += F.G) {
        const int b = item >> 7, k1 = (item >> 1) & 63, chh = item & 1;
        __syncthreads();
        for (int i = F.tid; i < 128 * 64; i += NTHREADS) {
            const int l2 = i >> 6, pc = i & 63, im = pc >> 5, cc = (pc & 31) * 8;
            const size_t row = (size_t)b * SEQ + 128 * k1 + l2;
            *(LAS u32x4*)(tile + l2 * 512 + im * 256 + cc) = *(const u32x4*)(Tb + row * 1024 + im * 512 + chh * 256 + cc);
        }
        __syncthreads();
        const int m = F.tid & 255, kh = F.tid >> 8;
        for (int kk = 0; kk < 64; ++kk) { const int k2 = kh * 64 + kk; float s = 0.f;
#pragma unroll 8
            for (int l2 = 0; l2 < 128; ++l2) { const int q = (k2 * l2) & 127; s += c128[q] * bf2f(tile[l2 * 512 + m]) + s128[q] * bf2f(tile[l2 * 512 + 256 + m]); }
            Y[((size_t)b * SEQ + k1 + 64 * k2) * 512 + chh * 256 + m] = (bf16_t)f2bf(s * 0.08838834764831845f);
        }
    }
}
__device__ __forceinline__ void p4_yg_naive(const Params& p, Frame& F) {
    const u32x4* hf = (const u32x4*)(p.ws + WS_B0); const u32x4* hb = (const u32x4*)(p.ws + WS_B6); const u32x4* G = (const u32x4*)(p.ws + WS_B3); u32x4* yg = (u32x4*)(p.ws + WS_B2);
    const size_t n = (size_t)T * 1024 / 8;
    for (size_t i = (size_t)F.bid * NTHREADS + F.tid; i < n; i += (size_t)F.G * NTHREADS) {
        const u32x4 a = hf[i], b = hb[i], g = G[i]; u32x4 o;
        o.x = pk2((bflo(a.x) + bflo(b.x)) * bflo(g.x), (bfhi(a.x) + bfhi(b.x)) * bfhi(g.x));
        o.y = pk2((bflo(a.y) + bflo(b.y)) * bflo(g.y), (bfhi(a.y) + bfhi(b.y)) * bfhi(g.y));
        o.z = pk2((bflo(a.z) + bflo(b.z)) * bflo(g.z), (bfhi(a.z) + bfhi(b.z)) * bfhi(g.z));
        o.w = pk2((bflo(a.w) + bflo(b.w)) * bflo(g.w), (bfhi(a.w) + bfhi(b.w)) * bfhi(g.w));
        yg[i] = o;
    }
}

struct SchedPlain {
    const char* A; const char* B; size_t lda, ldb; int nM, nN, G, c;
    __device__ __forceinline__ bool next(int i, pg8::Unit& u) const {
        const long L = (long)i * G + c; int pm, pn; if (!pg8::tile_order(L, nM, nN, pm, pn)) return false;
        u.pm = pm; u.pn = pn; u.aux = 0; u.A = A + (size_t)pm * 256 * lda; u.B = B + (size_t)pn * 256 * ldb; return true;
    }
};
struct EpiR {
    static constexpr bool PERM = true;
    const bf16_t* gate; bf16_t* out;
    __device__ __forceinline__ void operator()(const f32x4 (&acc)[2][2][4][2], const pg8::Unit& u, int wr, int wc, int fr, int fq) const {
        const int row0 = u.pm * 256 + wr * 64 + fr, col0 = u.pn * 256 + wc * 32 + 8 * fq;
#pragma unroll
        for (int ai = 0; ai < 2; ++ai)
#pragma unroll
            for (int m = 0; m < 4; ++m) { const size_t off = (size_t)(row0 + ai * 128 + m * 16) * 1024 + col0;
#pragma unroll
                for (int bj = 0; bj < 2; ++bj) { const f32x4 v0 = acc[ai][bj][m][0], v1 = acc[ai][bj][m][1];
                    const u32x4 g = *(const u32x4*)(gate + off + bj * 128);
                    u32x4 w; w.x = cvt_pk_bf16(v0[0] * bflo(g.x), v0[1] * bfhi(g.x)); w.y = cvt_pk_bf16(v0[2] * bflo(g.y), v0[3] * bfhi(g.y));
                    w.z = cvt_pk_bf16(v1[0] * bflo(g.z), v1[1] * bfhi(g.z)); w.w = cvt_pk_bf16(v1[2] * bflo(g.w), v1[3] * bfhi(g.w));
                    *(u32x4*)(out + off + bj * 128) = w; } }
    }
};
struct EpiF {
    static constexpr bool PERM = true;
    const bf16_t* gate; const bf16_t* rp; bf16_t* out;
    __device__ __forceinline__ void operator()(const f32x4 (&acc)[2][2][4][2], const pg8::Unit& u, int wr, int wc, int fr, int fq) const {
        const int row0 = u.pm * 256 + wr * 64 + fr, col0 = u.pn * 256 + wc * 32 + 8 * fq;
#pragma unroll
        for (int ai = 0; ai < 2; ++ai)
#pragma unroll
            for (int m = 0; m < 4; ++m) { const size_t off = (size_t)(row0 + ai * 128 + m * 16) * 1024 + col0;
#pragma unroll
                for (int bj = 0; bj < 2; ++bj) { const f32x4 v0 = acc[ai][bj][m][0], v1 = acc[ai][bj][m][1];
                    const u32x4 g = *(const u32x4*)(gate + off + bj * 128), r = *(const u32x4*)(rp + off + bj * 128);
                    u32x4 w; w.x = cvt_pk_bf16(v0[0] * bflo(g.x) + bflo(r.x), v0[1] * bfhi(g.x) + bfhi(r.x)); w.y = cvt_pk_bf16(v0[2] * bflo(g.y) + bflo(r.y), v0[3] * bfhi(g.y) + bfhi(r.y));
                    w.z = cvt_pk_bf16(v1[0] * bflo(g.z) + bflo(r.z), v1[1] * bfhi(g.z) + bfhi(r.z)); w.w = cvt_pk_bf16(v1[2] * bflo(g.w) + bflo(r.w), v1[3] * bfhi(g.w) + bfhi(r.w));
                    *(u32x4*)(out + off + bj * 128) = w; } }
    }
};
struct EpiO {
    static constexpr bool PERM = false;
    const float* x; const float* mod; float* out;
    __device__ __forceinline__ void operator()(const f32x4 (&acc)[2][2][4][2], const pg8::Unit& u, int wr, int wc, int fr, int fq) const {
        const int row0 = u.pm * 256 + wr * 64 + fr, col0 = u.pn * 256 + wc * 32 + 4 * fq;
        const float* g1 = mod + (size_t)(u.pm >> 5) * 6144 + M_G1 * 1024;
        f32x4 gv[2][2];
#pragma unroll
        for (int bj = 0; bj < 2; ++bj)
#pragma unroll
            for (int n = 0; n < 2; ++n) gv[bj][n] = *(const f32x4*)(g1 + col0 + bj * 128 + n * 16);
#pragma unroll
        for (int ai = 0; ai < 2; ++ai)
#pragma unroll
            for (int m = 0; m < 4; ++m) { const size_t off = (size_t)(row0 + ai * 128 + m * 16) * 1024 + col0;
#pragma unroll
                for (int bj = 0; bj < 2; ++bj)
#pragma unroll
                    for (int n = 0; n < 2; ++n) { const f32x4 xs = *(const f32x4*)(x + off + bj * 128 + n * 16);
                        *(f32x4*)(out + off + bj * 128 + n * 16) = xs + gv[bj][n] * acc[ai][bj][m][n]; } }
    }
};

__device__ __forceinline__ void p7_route(const Params& p, Frame& F) {
    LAS bf16_t* At = (LAS bf16_t*)F.lds;
    LAS float* red = (LAS float*)(F.lds + 33792);
    LAS float* lg = (LAS float*)(F.lds + 33792 + 16384);
    LAS int* etop = (LAS int*)(F.lds + 33792 + 16384 + 2048);
    LAS int* wcnt = etop + 1024;
    const float* mod = MODP(p.ws);
    bf16_t* hn = (bf16_t*)(p.ws + WS_B0);
    const bf16_t* wr = (const bf16_t*)(p.ws + WS_WROUT);
    unsigned char* rt = p.ws + WS_ROUTE;
    unsigned char* topi = rt + RT_TOPI; float* topw = (float*)(rt + RT_TOPW); unsigned short* rankl = (unsigned short*)(rt + RT_RANK); unsigned* hist = (unsigned*)(rt + RT_HIST);
    const int fr = F.lane & 15, fq = F.lane >> 4;
    bf16x8 breg[4][2];
#pragma unroll
    for (int s = 0; s < 4; ++s)
#pragma unroll
        for (int h2 = 0; h2 < 2; ++h2) breg[s][h2] = *(const bf16x8*)(wr + (size_t)(16 * h2 + fr) * 1024 + 128 * F.wave + 32 * s + 8 * fq);
    for (int blk = F.bid; blk < T / 256; blk += F.G) {
        const int t0 = blk * 256, b = t0 / SEQ;
        const float* sc = mod + b * 6144 + M_SC2 * 1024; const float* sh = mod + b * 6144 + M_SH2 * 1024;
        for (int it = 0; it < 16; ++it) {
            const int r0 = t0 + 16 * it;
#pragma unroll
            for (int j2 = 0; j2 < 2; ++j2) {
                const int lr = 2 * F.wave + j2; const size_t row = (size_t)(r0 + lr);
                const GAS f32x4* xr = (const GAS f32x4*)(p.out + row * D) + F.lane;
                f32x4 v[4]; float s = 0.f;
#pragma unroll
                for (int j = 0; j < 4; ++j) { v[j] = xr[64 * j]; s += (v[j].x * v[j].x + v[j].y * v[j].y) + (v[j].z * v[j].z + v[j].w * v[j].w); }
                const float rs = 1.0f / sqrtf(wave_sum(s) * (1.f / D) + EPS);
                GAS unsigned long long* o8 = (GAS unsigned long long*)(hn + row * D) + F.lane;
#pragma unroll
                for (int j = 0; j < 4; ++j) { const f32x4 g = ((const f32x4*)p.norm2)[F.lane + 64 * j], a = ((const f32x4*)sc)[F.lane + 64 * j], bb = ((const f32x4*)sh)[F.lane + 64 * j];
                    const float o0 = v[j].x * rs * g.x * (1.f + a.x) + bb.x, o1 = v[j].y * rs * g.y * (1.f + a.y) + bb.y, o2 = v[j].z * rs * g.z * (1.f + a.z) + bb.z, o3 = v[j].w * rs * g.w * (1.f + a.w) + bb.w;
                    const unsigned long long w = (unsigned long long)pk2(o0, o1) | ((unsigned long long)pk2(o2, o3) << 32);
                    o8[64 * j] = w; *(LAS unsigned long long*)(At + lr * 1032 + 4 * F.lane + 256 * j) = w; }
            }
            __syncthreads();
            f32x4 a0 = {0.f, 0.f, 0.f, 0.f}, a1 = {0.f, 0.f, 0.f, 0.f};
#pragma unroll
            for (int s = 0; s < 4; ++s) { const bf16x8 af = *(const LAS bf16x8*)(At + fr * 1032 + 128 * F.wave + 32 * s + 8 * fq);
                a0 = __builtin_amdgcn_mfma_f32_16x16x32_bf16(af, breg[s][0], a0, 0, 0, 0); a1 = __builtin_amdgcn_mfma_f32_16x16x32_bf16(af, breg[s][1], a1, 0, 0, 0); }
#pragma unroll
            for (int j = 0; j < 4; ++j) { red[(F.wave * 16 + 4 * fq + j) * 32 + fr] = a0[j]; red[(F.wave * 16 + 4 * fq + j) * 32 + 16 + fr] = a1[j]; }
            __syncthreads();
            { const int row = F.tid >> 5, e = F.tid & 31; float s = p.b_router[e];
#pragma unroll
              for (int w = 0; w < 8; ++w) s += red[(w * 16 + row) * 32 + e];
              lg[row * 32 + e] = s; }
            __syncthreads();
            if (F.tid < 16) {
                const int row = F.tid; float v[4]; int ix[4]; unsigned used = 0u;
#pragma unroll
                for (int k = 0; k < 4; ++k) { float best = -3.0e38f; int bi = 0;
                    for (int e = 0; e < 32; ++e) { const float x = lg[row * 32 + e]; if (!((used >> e) & 1u) && x > best) { best = x; bi = e; } }
                    used |= 1u << bi; v[k] = best; ix[k] = bi; }
                const float e1 = __expf(v[1] - v[0]), e2 = __expf(v[2] - v[0]), e3 = __expf(v[3] - v[0]); const float inv = 1.0f / (1.0f + e1 + e2 + e3);
                const float w4[4] = {inv, e1 * inv, e2 * inv, e3 * inv};
                const size_t tok = (size_t)(r0 + row);
#pragma unroll
                for (int k = 0; k < 4; ++k) { topi[tok * 4 + k] = (unsigned char)ix[k]; topw[tok * 4 + k] = w4[k]; etop[(16 * it + row) * 4 + k] = ix[k]; }
            }
        }
        __syncthreads();
        const int a0i = 128 * F.wave + F.lane, a1i = a0i + 64; const int e0 = etop[a0i], e1 = etop[a1i]; int r0 = 0, r1 = 0;
        const unsigned long long lt = (1ull << F.lane) - 1ull;
#pragma unroll 1
        for (int e = 0; e < 32; ++e) { const unsigned long long m0 = __ballot(e0 == e), m1 = __ballot(e1 == e);
            if (e0 == e) r0 = __popcll(m0 & lt); if (e1 == e) r1 = __popcll(m0) + __popcll(m1 & lt);
            if (F.lane == 0) wcnt[F.wave * 32 + e] = __popcll(m0) + __popcll(m1); }
        __syncthreads();
        int b0 = 0, b1 = 0;
        for (int w = 0; w < F.wave; ++w) { b0 += wcnt[w * 32 + e0]; b1 += wcnt[w * 32 + e1]; }
        rankl[(size_t)t0 * 4 + a0i] = (unsigned short)(b0 + r0); rankl[(size_t)t0 * 4 + a1i] = (unsigned short)(b1 + r1);
        if (F.tid < 32) { int s = 0; for (int w = 0; w < 8; ++w) s += wcnt[w * 32 + F.tid]; hist[blk * 32 + F.tid] = (unsigned)s; }
        __syncthreads();
    }
}
__device__ __forceinline__ void p8_slots(const Params& p, Frame& F) {
    LAS int* tot = (LAS int*)F.lds; LAS int* base = tot + 32; LAS int* rup = tot + 64; LAS int* sp = tot + 96;
    unsigned char* rt = p.ws + WS_ROUTE;
    const unsigned char* topi = rt + RT_TOPI; const float* topw = (const float*)(rt + RT_TOPW); const unsigned short* rankl = (const unsigned short*)(rt + RT_RANK); const unsigned* hist = (const unsigned*)(rt + RT_HIST);
    int* slot_tok = (int*)(rt + RT_SLOTTOK); float* slot_w = (float*)(rt + RT_SLOTW); int* tok_slot = (int*)(rt + RT_TOKSLOT); int* tile_exp = (int*)(rt + RT_TILEEXP);
    unsigned* ctl = (unsigned*)(p.ws + WS_CTL);
    for (int blk = F.bid; blk < T / 256; blk += F.G) {
        const int half = blk >> 7;
        __syncthreads();
        if (F.tid < 32) { int t = 0, bs = 0; for (int b2 = half * 128; b2 < half * 128 + 128; ++b2) { const int h = (int)hist[b2 * 32 + F.tid]; if (b2 < blk) bs += h; t += h; }
            tot[F.tid] = t; base[F.tid] = bs; rup[F.tid] = (t + 255) & ~255; }
        __syncthreads();
        if (F.tid == 0) { int s = 0; for (int e = 0; e < 32; ++e) { sp[e] = s; s += rup[e]; } sp[32] = s; }
        __syncthreads();
        int* st = slot_tok + (size_t)half * PHALF; float* sw = slot_w + (size_t)half * PHALF;
#pragma unroll
        for (int q = 0; q < 2; ++q) { const int a = F.tid * 2 + q; const size_t ga = (size_t)blk * 1024 + a; const int e = topi[ga];
            const int slot = sp[e] + base[e] + (int)rankl[ga];
            st[slot] = (int)(ga >> 2); sw[slot] = topw[ga]; tok_slot[ga] = slot; }
        if ((blk & 127) == 0) {
            if (F.tid == 0) ctl[CW_NTILES + half] = (unsigned)(sp[32] >> 8);
            for (int e = 0; e < 32; ++e) {
                for (int s = sp[e] + tot[e] + F.tid; s < sp[e] + rup[e]; s += NTHREADS) { st[s] = half * HALF_T; sw[s] = 0.f; }
                for (int t = (sp[e] >> 8) + F.tid; t < ((sp[e] + rup[e]) >> 8); t += NTHREADS) tile_exp[half * 1024 + t] = e;
            }
        }
    }
}
struct SchedG1 {
    const char* hn; const char* wgu; const int* slot_tok; const int* tile_exp; int ntiles, G, c;
    __device__ __forceinline__ bool next(int i, pg8::Unit& u) const {
        const long L = (long)i * G + c; int pm, pn; if (!pg8::tile_order(L, ntiles, 8, pm, pn)) return false;
        const int e = tile_exp[pm]; u.pm = pm; u.pn = pn; u.aux = e; u.A = hn; u.B = wgu + ((size_t)e * 2048 + (size_t)pn * 256) * 2048; return true;
    }
    __device__ __forceinline__ int row(const pg8::Unit& u, int r) const { return slot_tok[u.pm * 256 + r]; }
};
struct EpiG1 {
    static constexpr bool PERM = true;
    const float* b_gu; bf16_t* act;
    __device__ __forceinline__ void operator()(const f32x4 (&acc)[2][2][4][2], const pg8::Unit& u, int wr, int wc, int fr, int fq) const {
        const int row0 = u.pm * 256 + wr * 64 + fr, col0 = u.pn * 128 + wc * 32 + 8 * fq;
        const float* bg = b_gu + (size_t)u.aux * 2048 + col0;
        const f32x4 bg0 = *(const f32x4*)bg, bg1 = *(const f32x4*)(bg + 4), bu0 = *(const f32x4*)(bg + 1024), bu1 = *(const f32x4*)(bg + 1028);
#pragma unroll
        for (int ai = 0; ai < 2; ++ai)
#pragma unroll
            for (int m = 0; m < 4; ++m) {
                const f32x4 g0 = acc[ai][0][m][0] + bg0, g1 = acc[ai][0][m][1] + bg1, u0 = acc[ai][1][m][0] + bu0, u1 = acc[ai][1][m][1] + bu1;
                float o[8];
#pragma unroll
                for (int j = 0; j < 4; ++j) { const float ga = fminf(g0[j], 7.0f), gb = fminf(g1[j], 7.0f); const float ua = fminf(fmaxf(u0[j], -7.0f), 7.0f), ub = fminf(fmaxf(u1[j], -7.0f), 7.0f);
                    o[j] = (ua + 1.0f) * ga * fast_sigmoid(1.702f * ga); o[4 + j] = (ub + 1.0f) * gb * fast_sigmoid(1.702f * gb); }
                u32x4 w; w.x = cvt_pk_bf16(o[0], o[1]); w.y = cvt_pk_bf16(o[2], o[3]); w.z = cvt_pk_bf16(o[4], o[5]); w.w = cvt_pk_bf16(o[6], o[7]);
                *(u32x4*)(act + (size_t)(row0 + ai * 128 + m * 16) * 1024 + col0) = w; }
    }
};
struct SchedG2 {
    const char* act; const char* wd; const int* tile_exp; int ntiles, G, c;
    __device__ __forceinline__ bool next(int i, pg8::Unit& u) const {
        const long L = (long)i * G + c; int pm, pn; if (!pg8::tile_order(L, ntiles, 4, pm, pn)) return false;
        const int e = tile_exp[pm]; u.pm = pm; u.pn = pn; u.aux = e; u.A = act + (size_t)pm * 256 * 2048; u.B = wd + ((size_t)e * 1024 + (size_t)pn * 256) * 2048; return true;
    }
};
struct EpiG2 {
    static constexpr bool PERM = true;
    const float* b_down; const float* slot_w; bf16_t* outa;
    __device__ __forceinline__ void operator()(const f32x4 (&acc)[2][2][4][2], const pg8::Unit& u, int wr, int wc, int fr, int fq) const {
        const int row0 = u.pm * 256 + wr * 64 + fr, col0 = u.pn * 256 + wc * 32 + 8 * fq;
        const float* bd = b_down + (size_t)u.aux * 1024 + col0;
        f32x4 bv[2][2];
#pragma unroll
        for (int bj = 0; bj < 2; ++bj) { bv[bj][0] = *(const f32x4*)(bd + bj * 128); bv[bj][1] = *(const f32x4*)(bd + bj * 128 + 4); }
#pragma unroll
        for (int ai = 0; ai < 2; ++ai)
#pragma unroll
            for (int m = 0; m < 4; ++m) { const int row = row0 + ai * 128 + m * 16; const float sw = slot_w[row];
#pragma unroll
                for (int bj = 0; bj < 2; ++bj) { const f32x4 v0 = (acc[ai][bj][m][0] + bv[bj][0]) * sw, v1 = (acc[ai][bj][m][1] + bv[bj][1]) * sw;
                    u32x4 w; w.x = cvt_pk_bf16(v0[0], v0[1]); w.y = cvt_pk_bf16(v0[2], v0[3]); w.z = cvt_pk_bf16(v1[0], v1[1]); w.w = cvt_pk_bf16(v1[2], v1[3]);
                    *(u32x4*)(outa + (size_t)row * 1024 + col0 + bj * 128) = w; } }
    }
};
__device__ __forceinline__ void p11_combine(const Params& p, Frame& F, int half) {
    const float* mod = MODP(p.ws); const int* tok_slot = (const int*)(p.ws + WS_ROUTE + RT_TOKSLOT); const bf16_t* outa = (const bf16_t*)(p.ws + WS_OUTA);
    const int gw = F.bid * NWAVES + F.wave, ngw = F.G * NWAVES;
    for (int m = half * HALF_T + gw; m < (half + 1) * HALF_T; m += ngw) {
        const float* g2 = mod + (size_t)(m / SEQ) * 6144 + M_G2 * 1024;
        const int s0 = tok_slot[m * 4 + 0], s1 = tok_slot[m * 4 + 1], s2 = tok_slot[m * 4 + 2], s3 = tok_slot[m * 4 + 3];
        GAS f32x4* xr = (GAS f32x4*)(p.out + (size_t)m * D) + F.lane;
        f32x4 v[4]; float ss = 0.f;
#pragma unroll
        for (int j = 0; j < 4; ++j) {
            const u32x2 a = *(const u32x2*)(outa + (size_t)s0 * 1024 + 4 * F.lane + 256 * j), b = *(const u32x2*)(outa + (size_t)s1 * 1024 + 4 * F.lane + 256 * j),
                        c = *(const u32x2*)(outa + (size_t)s2 * 1024 + 4 * F.lane + 256 * j), d = *(const u32x2*)(outa + (size_t)s3 * 1024 + 4 * F.lane + 256 * j);
            f32x4 y; y.x = (bflo(a.x) + bflo(b.x)) + (bflo(c.x) + bflo(d.x)); y.y = (bfhi(a.x) + bfhi(b.x)) + (bfhi(c.x) + bfhi(d.x));
            y.z = (bflo(a.y) + bflo(b.y)) + (bflo(c.y) + bflo(d.y)); y.w = (bfhi(a.y) + bfhi(b.y)) + (bfhi(c.y) + bfhi(d.y));
            const f32x4 g = ((const f32x4*)g2)[F.lane + 64 * j];
            v[j] = xr[64 * j] + g * y; ss += (v[j].x * v[j].x + v[j].y * v[j].y) + (v[j].z * v[j].z + v[j].w * v[j].w); }
        const float rs = 1.0f / sqrtf(wave_sum(ss) * (1.f / D) + EPS);
#pragma unroll
        for (int j = 0; j < 4; ++j) { const f32x4 nf = ((const f32x4*)p.norm_f)[F.lane + 64 * j]; xr[64 * j] = v[j] * rs * nf; }
    }
}

constexpr int NPHASES = 15;
__global__ void __launch_bounds__(NTHREADS, 2) fwd_kernel(Params p) {
    extern __shared__ __attribute__((aligned(16))) unsigned char lds_raw[];
    Frame F; F.lds = (LAS unsigned char*)lds_raw; F.tid = threadIdx.x; F.lane = F.tid & 63; F.wave = __builtin_amdgcn_readfirstlane(F.tid >> 6); F.G = gridDim.x; F.bid = blockIdx.x;
    volatile LAS unsigned* misc = (volatile LAS unsigned*)(F.lds + LDS_MISC);
    if (F.tid < 64) misc[F.tid] = 0u;
    __syncthreads();
    unsigned char* ws = p.ws;
    unsigned* ctl = (unsigned*)(ws + WS_CTL);
    const int lo = p.ph_lo, hi = p.ph_hi;
    XcdBarrier bar; bar.bar = ctl + CW_BAR; bar.x = 0; bar.st = nullptr;
    if (hi - lo > 1) bar = xcd_barrier_post(ctl + CW_BAR, misc + 8);
#ifdef ONLY_PHASE
#define IN(k) ((k) == ONLY_PHASE && lo <= (k) && (k) < hi)
#else
#define IN(k) (lo <= (k) && (k) < hi)
#endif
#define SEAM(k) do { if (IN(k) && IN((k) + 1)) xcd_barrier(bar); } while (0)
#define PH() do { int t_ = threadIdx.x; asm volatile("" : "+v"(t_)); F.tid = t_; F.lane = t_ & 63; F.wave = __builtin_amdgcn_readfirstlane(t_ >> 6); ws = p.ws; asm volatile("" : "+s"(ws)); } while (0)

    if (IN(0)) { PH(); p0_ada(p, F); p0_weights(p, F); }
    SEAM(0);
    if (IN(1)) { PH(); p1_norm(p, F); }
    SEAM(1);
    if (IN(2)) { PH();
        Sched2 S{(const char*)(ws + WS_B0), (const char*)(ws + WS_WCAT), F.G, F.bid}; Epi2 E{ws};
        pg8::gemm_phase<Epi2, Sched2, false>(F.lds, S, E, 16, 2048u, 2048u);
    }
    SEAM(2);
    if (IN(3)) { PH();
        if (F.G > 128) { if (F.bid < 128) p3_rnn_naive(p, F); else p3_dftA_naive(p, F, F.bid - 128, F.G - 128); }
        else { p3_rnn_naive(p, F); p3_dftA_naive(p, F, F.bid, F.G); }
    }
    SEAM(3);
    if (IN(4)) { PH(); p4_dftB_naive(p, F); p4_yg_naive(p, F); }
    SEAM(4);
    if (IN(5)) { PH();
        { SchedPlain S{(const char*)(ws + WS_B2), (const char*)(ws + WS_WR), 2048, 2048, 256, 4, F.G, F.bid};
          EpiR E{(const bf16_t*)(ws + WS_B5), (bf16_t*)(ws + WS_B0)};
          pg8::gemm_phase<EpiR, SchedPlain, false>(F.lds, S, E, 16, 2048u, 2048u); }
        { SchedPlain S{(const char*)(ws + WS_B7), (const char*)(ws + WS_WF), 1024, 1024, 256, 4, F.G, F.bid};
          EpiF E{(const bf16_t*)(ws + WS_B4), (const bf16_t*)(ws + WS_B0), (bf16_t*)(ws + WS_B1)};
          pg8::gemm_phase<EpiF, SchedPlain, false>(F.lds, S, E, 8, 1024u, 1024u); }
    }
    SEAM(5);
    if (IN(6)) { PH();
        SchedPlain S{(const char*)(ws + WS_B1), (const char*)(ws + WS_WO), 2048, 2048, 256, 4, F.G, F.bid};
        EpiO E{p.x, MODP(ws), p.out};
        pg8::gemm_phase<EpiO, SchedPlain, false>(F.lds, S, E, 16, 2048u, 2048u);
    }
    SEAM(6);
    if (IN(7)) { PH(); p7_route(p, F); p_moe_weights(p, F); }
    SEAM(7);
    if (IN(8)) { PH(); p8_slots(p, F); }
    SEAM(8);
#pragma unroll 1
    for (int half = 0; half < 2; ++half) {
        const int pb = 9 + 3 * half;
        const int* slot_tok = (const int*)(ws + WS_ROUTE + RT_SLOTTOK) + (size_t)half * PHALF;
        const float* slot_w = (const float*)(ws + WS_ROUTE + RT_SLOTW) + (size_t)half * PHALF;
        const int* tile_exp = (const int*)(ws + WS_ROUTE + RT_TILEEXP) + half * 1024;
        if (IN(pb)) { PH();
            const int ntiles = (int)ctl[CW_NTILES + half];
            SchedG1 S{(const char*)(ws + WS_B0), (const char*)(ws + WS_WGU), slot_tok, tile_exp, ntiles, F.G, F.bid};
            EpiG1 E{p.b_gu, (bf16_t*)(ws + WS_ACT)};
            pg8::gemm_phase<EpiG1, SchedG1, true>(F.lds, S, E, 16, 2048u, 2048u);
        }
        SEAM(pb);
        if (IN(pb + 1)) { PH();
            const int ntiles = (int)ctl[CW_NTILES + half];
            SchedG2 S{(const char*)(ws + WS_ACT), (const char*)(ws + WS_WD), tile_exp, ntiles, F.G, F.bid};
            EpiG2 E{p.b_down, slot_w, (bf16_t*)(ws + WS_OUTA)};
            pg8::gemm_phase<EpiG2, SchedG2, false>(F.lds, S, E, 16, 2048u, 2048u);
        }
        SEAM(pb + 1);
        if (IN(pb + 2)) { PH(); p11_combine(p, F, half); }
        SEAM(pb + 2);
    }
#undef IN
#undef SEAM
}

extern "C" void kernel_launch(void* const* d_in, const int* in_sizes, int n_in, void* d_out, int out_size, void* d_ws, size_t ws_size, hipStream_t stream) {
    static int grid = 0;
    if (grid == 0) {
        if (n_in != 26 || out_size != T * D || ws_size < WS_END) { fprintf(stderr, "kernel_launch: unexpected shapes (n_in %d out %d ws %zu)\n", n_in, out_size, ws_size); grid = -1; return; }
        int dev = 0, cus = 0, per_cu = 0;
        if (hipGetDevice(&dev) != hipSuccess || hipDeviceGetAttribute(&cus, hipDeviceAttributeMultiprocessorCount, dev) != hipSuccess) { grid = -1; return; }
        if (hipFuncSetAttribute((const void*)fwd_kernel, hipFuncAttributeMaxDynamicSharedMemorySize, LDS_BYTES) != hipSuccess) { fprintf(stderr, "kernel_launch: hipFuncSetAttribute failed\n"); grid = -1; return; }
        if (hipOccupancyMaxActiveBlocksPerMultiprocessor(&per_cu, (const void*)fwd_kernel, NTHREADS, LDS_BYTES) != hipSuccess || per_cu < 1) { fprintf(stderr, "kernel_launch: occupancy query says %d\n", per_cu); }
        (void)hipGetLastError();
        grid = cus > 256 ? 256 : cus;
    }
    if (grid < 0) return;
    (void)hipMemsetAsync((char*)d_ws + WS_CTL, 0, CTL_BYTES, stream);
    Params p{};
    const float** f = (const float**)&p;
    for (int i = 0; i < 26; ++i) f[i] = (const float*)d_in[i];
    p.out = (float*)d_out; p.ws = (unsigned char*)d_ws;
#if SPLIT_LAUNCH
    for (int k = 0; k < NPHASES; ++k) { p.ph_lo = k; p.ph_hi = k + 1; hipLaunchKernelGGL(fwd_kernel, dim3(grid), dim3(NTHREADS), LDS_BYTES, stream, p); }
#else
    p.ph_lo = 0; p.ph_hi = NPHASES;
    hipLaunchKernelGGL(fwd_kernel, dim3(grid), dim3(NTHREADS), LDS_BYTES, stream, p);
#endif
}
```

```cpp
#include <hip/hip_runtime.h>
#include <cstdio>
#include <cstdint>

#ifndef SPLIT_LAUNCH
#define SPLIT_LAUNCH 0
#endif

#ifndef RNN_FAST
#define RNN_FAST 1
#endif
#ifndef DFT_FAST
#define DFT_FAST 1
#endif
#define GAS __attribute__((address_space(1)))
#define LAS __attribute__((address_space(3)))
typedef unsigned short bf16_t;
typedef short bf16x8 __attribute__((ext_vector_type(8)));
typedef float f32x4 __attribute__((ext_vector_type(4)));
typedef float f32x2 __attribute__((ext_vector_type(2)));
typedef unsigned u32x4 __attribute__((ext_vector_type(4)));
typedef unsigned u32x2 __attribute__((ext_vector_type(2)));

constexpr int D = 1024, NB = 8, SEQ = 8192, T = NB * SEQ, CTXL = 256, TC = NB * CTXL, MT = T + TC;
constexpr int DIN = 4608, NCAT = 5120;
constexpr int NE = 32, TOPK = 4, DE = 1024;
constexpr float EPS = 1e-6f;
constexpr int HALF_T = T / 2;
constexpr int PHALF = HALF_T * TOPK + NE * 256;

constexpr size_t MiB = 1u << 20;
constexpr size_t WS_CTL = 0, CTL_BYTES = 1 * MiB;
constexpr size_t WS_MOD = 1 * MiB;
constexpr size_t WS_WCAT = 2 * MiB;
constexpr size_t WS_WF = 12 * MiB;
constexpr size_t WS_WR = 13 * MiB;
constexpr size_t WS_WO = 15 * MiB;
constexpr size_t WS_GW = 17 * MiB;
constexpr size_t WS_WROUT = 18 * MiB;
constexpr size_t WS_AGG = 19 * MiB;
constexpr size_t WS_ROUTE = 26 * MiB;
constexpr size_t WS_B0 = 32 * MiB;
constexpr size_t WS_B1 = 164 * MiB;
constexpr size_t WS_B2 = 292 * MiB;
constexpr size_t WS_B3 = 424 * MiB;
constexpr size_t WS_B4 = 552 * MiB;
constexpr size_t WS_B5 = 680 * MiB;
constexpr size_t WS_B6 = 808 * MiB;
constexpr size_t WS_B7 = 936 * MiB;
constexpr size_t WS_WGU = WS_B1;
constexpr size_t WS_WD = WS_B2;
constexpr size_t WS_ACT = 356 * MiB;
constexpr size_t WS_OUTA = 628 * MiB;
constexpr size_t WS_END = 1000 * MiB;
static_assert((size_t)PHALF * 2048 <= 272 * MiB, "act capacity");
constexpr size_t RT_TOPI = 0;
constexpr size_t RT_TOPW = 256 * 1024;
constexpr size_t RT_RANK = RT_TOPW + 1 * MiB;
constexpr size_t RT_HIST = RT_RANK + 512 * 1024;
constexpr size_t RT_SLOTTOK = RT_HIST + 32 * 1024;
constexpr size_t RT_SLOTW = RT_SLOTTOK + 1152 * 1024;
constexpr size_t RT_TOKSLOT = RT_SLOTW + 1152 * 1024;
constexpr size_t RT_TILEEXP = RT_TOKSLOT + 1 * MiB;
constexpr size_t RT_END = RT_TILEEXP + 8192;
static_assert(RT_END <= 6 * MiB, "route tables");
constexpr int CW_NTILES = 16;
constexpr int CW_BAR = 4096;

constexpr int NWAVES = 8, NTHREADS = 512;
constexpr int LDS_BYTES = 155648;
constexpr int LDS_MISC = 151552;

__device__ __forceinline__ unsigned f2bf(float f) { unsigned u = __builtin_bit_cast(unsigned, f); return (u + 0x7fffu + ((u >> 16) & 1u)) >> 16; }
__device__ __forceinline__ unsigned pk2(float lo, float hi) { return f2bf(lo) | (f2bf(hi) << 16); }
__device__ __forceinline__ unsigned cvt_pk_bf16(float lo, float hi) { unsigned r; asm volatile("v_cvt_pk_bf16_f32 %0, %1, %2" : "=v"(r) : "v"(lo), "v"(hi)); return r; }
__device__ __forceinline__ float bf2f(unsigned short b) { return __builtin_bit_cast(float, (unsigned)b << 16); }
__device__ __forceinline__ float bflo(unsigned w) { return __builtin_bit_cast(float, w << 16); }
__device__ __forceinline__ float bfhi(unsigned w) { return __builtin_bit_cast(float, w & 0xffff0000u); }
__device__ __forceinline__ float fast_sigmoid(float x) { return __builtin_amdgcn_rcpf(1.0f + __builtin_amdgcn_exp2f(-1.44269504f * x)); }
__device__ __forceinline__ float wave_sum(float v) {
#pragma unroll
    for (int o = 1; o < 64; o <<= 1) v += __shfl_xor(v, o);
    return v;
}

namespace pg8 {
constexpr int BM = 256, BK = 64, HALF = 128, HTB = HALF * BK * 2, STAGE_BYTES = 8 * HTB, NXCD = 8, WGM = 8;
__host__ __device__ __forceinline__ int lds_byte(int r, int c) { const int st = (r >> 4) * 2 + (c >> 5), rr = r & 15, cc = c & 31, ob = rr * 64 + cc * 2; return st * 1024 + (ob ^ (((ob >> 9) & 1) << 5)); }
__host__ __device__ __forceinline__ void stage_rc(int b, int& R, int& C) { const int st = b / 1024, sb = b % 1024, swz = sb ^ (((sb >> 9) & 1) << 5); R = (st >> 1) * 16 + swz / 64; C = (st & 1) * 32 + (swz % 64) / 2; }
__host__ __device__ __forceinline__ int perm32(int rho) { const int n = rho >> 4, i = rho & 15; return 8 * (i >> 2) + 4 * n + (i & 3); }

struct Unit { int pm, pn, aux; const char* A; const char* B; };

__device__ __forceinline__ bool tile_order(long L, int nM, int nN, int& pm, int& pn) {
    const int nwg = nM * nN; if (L >= nwg) return false;
    int wgid = (int)L; { const int q = nwg / NXCD, r = nwg % NXCD, xcd = wgid % NXCD, off = wgid / NXCD; wgid = (xcd < r ? xcd * (q + 1) : r * (q + 1) + (xcd - r) * q) + off; }
    const int nig = WGM * nN, gid = wgid / nig, fm = gid * WGM, gsz = (nM - fm) < WGM ? (nM - fm) : WGM;
    pm = fm + ((wgid % nig) % gsz); pn = (wgid % nig) / gsz; return true;
}

template <class Epi, class Sched, bool GATHER>
__device__ __forceinline__ void gemm_phase(LAS unsigned char* lds, const Sched& S, const Epi& E, const int nt, const unsigned lda, const unsigned ldb) {
    int tid_ = threadIdx.x; asm volatile("" : "+v"(tid_));
    const int tid = tid_, wid = __builtin_amdgcn_readfirstlane(tid >> 6), lane = tid & 63, wr = wid >> 2, wc = wid & 3, fr = lane & 15, fq = lane >> 4;
    unsigned voffA[2][2], nvoffA[2][2], voffB[2]; int RA[2], CA[2];
#pragma unroll
    for (int i = 0; i < 2; ++i) { int R, C; stage_rc(tid * 16 + i * 8192, R, C); const int Rb = Epi::PERM ? ((R & ~31) + perm32(R & 31)) : R;
        RA[i] = R; CA[i] = C;
        voffA[0][i] = (unsigned)R * lda + (unsigned)C * 2u; voffA[1][i] = (unsigned)(R + HALF) * lda + (unsigned)C * 2u;
        nvoffA[0][i] = voffA[0][i]; nvoffA[1][i] = voffA[1][i];
        voffB[i] = (unsigned)Rb * ldb + (unsigned)C * 2u; }
    const size_t kstep = (size_t)(BK * 2);
    const size_t hstepB = (size_t)HALF * ldb;
    const unsigned ldsw = (unsigned)wid * 1024u;
    const int aoff = lds_byte(wr * 64 + fr, fq * 8), boff = lds_byte(wc * 32 + fr, fq * 8);
#define PG8_SA(b, h) (((b) * 2 + (h)) * HTB)
#define PG8_SB(b, h) ((4 + (b) * 2 + (h)) * HTB)
#define PG8_STAGE2(bufoff, gbase, o0, o1) do { \
        __builtin_amdgcn_global_load_lds((const unsigned*)((const char*)(gbase) + (o0)), (LAS unsigned*)(lds + (bufoff) + ldsw), 16, 0, 0); \
        __builtin_amdgcn_global_load_lds((const unsigned*)((const char*)(gbase) + (o1)), (LAS unsigned*)(lds + (bufoff) + ldsw + 8192), 16, 0, 0); } while (0)
#define PG8_STAGE_B(bufoff, gbase) PG8_STAGE2(bufoff, gbase, voffB[0], voffB[1])
#define PG8_STAGE_A(bufoff, gbase, hh) PG8_STAGE2(bufoff, gbase, voffA[hh][0], voffA[hh][1])
#define PG8_STAGE_AN(bufoff, gbase, hh, usenext) PG8_STAGE2(bufoff, gbase, ((usenext) ? nvoffA[hh][0] : voffA[hh][0]), ((usenext) ? nvoffA[hh][1] : voffA[hh][1]))
#define PG8_LDA(dst, b, h) do { _Pragma("unroll") for (int m = 0; m < 4; ++m) _Pragma("unroll") for (int k = 0; k < 2; ++k) dst[m][k] = *(const LAS bf16x8*)(lds + PG8_SA(b, h) + aoff + m * 2048 + k * 1024); } while (0)
#define PG8_LDB(dst, b, h) do { _Pragma("unroll") for (int n = 0; n < 2; ++n) _Pragma("unroll") for (int k = 0; k < 2; ++k) dst[n][k] = *(const LAS bf16x8*)(lds + PG8_SB(b, h) + boff + n * 2048 + k * 1024); } while (0)
#define PG8_MMA(ai, bj, At, Bt) do { __builtin_amdgcn_s_setprio(1); _Pragma("unroll") for (int m = 0; m < 4; ++m) _Pragma("unroll") for (int n = 0; n < 2; ++n) _Pragma("unroll") for (int k = 0; k < 2; ++k) \
        acc[ai][bj][m][n] = __builtin_amdgcn_mfma_f32_16x16x32_bf16(Bt[n][k], At[m][k], acc[ai][bj][m][n], 0, 0, 0); __builtin_amdgcn_s_setprio(0); } while (0)
#define PG8_WAIT_V(n) asm volatile("s_waitcnt vmcnt(" #n ")" ::: "memory")
#define PG8_WAIT_L(n) asm volatile("s_waitcnt lgkmcnt(" #n ")" ::: "memory")
#define PG8_BAR __builtin_amdgcn_s_barrier()
#define PG8_SCHED __builtin_amdgcn_sched_barrier(0)
    Unit cur, nxt; int ui = 0;
    if (!S.next(0, cur)) return;
    if constexpr (GATHER) {
#pragma unroll
        for (int hh = 0; hh < 2; ++hh)
#pragma unroll
            for (int i = 0; i < 2; ++i) voffA[hh][i] = (unsigned)S.row(cur, hh * HALF + RA[i]) * lda + (unsigned)CA[i] * 2u;
    }
    f32x4 acc[2][2][4][2];
#pragma unroll
    for (int a = 0; a < 2; ++a)
#pragma unroll
        for (int b = 0; b < 2; ++b)
#pragma unroll
            for (int m = 0; m < 4; ++m)
#pragma unroll
                for (int n = 0; n < 2; ++n) acc[a][b][m][n] = (f32x4){0.f, 0.f, 0.f, 0.f};
    bf16x8 At[4][2], B0[2][2], B1[2][2];
    const char* cA = cur.A; const char* cB = cur.B;
    PG8_STAGE_B(PG8_SB(0, 0), cB); PG8_STAGE_B(PG8_SB(0, 1), cB + hstepB); PG8_STAGE_A(PG8_SA(0, 0), cA, 0); PG8_STAGE_A(PG8_SA(0, 1), cA, 1);
    if (wr == 1) PG8_BAR;
    PG8_WAIT_V(2); PG8_BAR;
    PG8_STAGE_B(PG8_SB(1, 0), cB + kstep); PG8_STAGE_A(PG8_SA(1, 0), cA + kstep, 0); PG8_STAGE_B(PG8_SB(1, 1), cB + hstepB + kstep);
    PG8_WAIT_V(6); PG8_BAR;
    for (;;) {
        const bool has_next = S.next(ui + 1, nxt);
        const char* nA = has_next ? nxt.A : cA; const char* nB = has_next ? nxt.B : cB;
        if constexpr (GATHER) {
            if (has_next) {
#pragma unroll
                for (int hh = 0; hh < 2; ++hh)
#pragma unroll
                    for (int i = 0; i < 2; ++i) nvoffA[hh][i] = (unsigned)S.row(nxt, hh * HALF + RA[i]) * lda + (unsigned)CA[i] * 2u;
            } else {
#pragma unroll
                for (int hh = 0; hh < 2; ++hh)
#pragma unroll
                    for (int i = 0; i < 2; ++i) nvoffA[hh][i] = voffA[hh][i];
            }
        }
        for (int t = 0; t < nt; t += 2) {
            const bool last = (t == nt - 2);
            const char* a1 = cA + (size_t)(t + 1) * kstep;
            const char* a2 = last ? nA : cA + (size_t)(t + 2) * kstep; const char* b2 = last ? nB : cB + (size_t)(t + 2) * kstep;
            const char* a3 = a2 + kstep; const char* b3 = b2 + kstep;
            const bool un = GATHER && last;
            PG8_LDB(B0, 0, 0); PG8_LDB(B1, 0, 1); PG8_SCHED; PG8_LDA(At, 0, 0); PG8_STAGE_A(PG8_SA(1, 1), a1, 1);
            PG8_WAIT_V(8); PG8_WAIT_L(0); PG8_BAR; PG8_MMA(0, 0, At, B0); PG8_MMA(0, 1, At, B1); PG8_BAR; PG8_SCHED;
            PG8_LDA(At, 0, 1); PG8_STAGE_B(PG8_SB(0, 0), b2); PG8_STAGE_B(PG8_SB(0, 1), b2 + hstepB); PG8_STAGE_AN(PG8_SA(0, 0), a2, 0, un);
            PG8_WAIT_V(8); PG8_WAIT_L(0); PG8_BAR; PG8_MMA(1, 0, At, B0); PG8_MMA(1, 1, At, B1); PG8_BAR; PG8_SCHED;
            PG8_LDB(B0, 1, 0); PG8_LDB(B1, 1, 1); PG8_SCHED; PG8_LDA(At, 1, 0); PG8_STAGE_AN(PG8_SA(0, 1), a2, 1, un);
            PG8_WAIT_V(8); PG8_WAIT_L(0); PG8_BAR; PG8_MMA(0, 0, At, B0); PG8_MMA(0, 1, At, B1); PG8_BAR; PG8_SCHED;
            PG8_LDA(At, 1, 1); PG8_STAGE_B(PG8_SB(1, 0), b3); PG8_STAGE_B(PG8_SB(1, 1), b3 + hstepB); PG8_STAGE_AN(PG8_SA(1, 0), a3, 0, un);
            PG8_WAIT_V(8); PG8_WAIT_L(0); PG8_BAR; PG8_MMA(1, 0, At, B0); PG8_MMA(1, 1, At, B1); PG8_BAR; PG8_SCHED;
        }
        if (wr == 0) PG8_BAR;
        E(acc, cur, wr, wc, fr, fq);
        if (!has_next) break;
#pragma unroll
        for (int a = 0; a < 2; ++a)
#pragma unroll
            for (int b = 0; b < 2; ++b)
#pragma unroll
                for (int m = 0; m < 4; ++m)
#pragma unroll
                    for (int n = 0; n < 2; ++n) acc[a][b][m][n] = (f32x4){0.f, 0.f, 0.f, 0.f};
        cur = nxt; cA = nA; cB = nB; ++ui;
        if constexpr (GATHER) {
#pragma unroll
            for (int hh = 0; hh < 2; ++hh)
#pragma unroll
                for (int i = 0; i < 2; ++i) voffA[hh][i] = nvoffA[hh][i];
        }
        if (wr == 1) PG8_BAR;
    }
    PG8_WAIT_V(0);
    PG8_BAR;
#undef PG8_SA
#undef PG8_SB
#undef PG8_STAGE2
#undef PG8_STAGE_A
#undef PG8_STAGE_AN
#undef PG8_STAGE_B
#undef PG8_LDA
#undef PG8_LDB
#undef PG8_MMA
#undef PG8_WAIT_V
#undef PG8_WAIT_L
#undef PG8_BAR
#undef PG8_SCHED
}
}

#define XB_TMO      128
#define XB_XCNT(j)  (256  + 64 * (j))
#define XB_XSUB(j)  (1280 + 64 * (j))
#define XB_XGEN(j)  (2304 + 64 * (j))
#define XB_TOP      3328
#define XB_TOPGEN   3392
#define XCD_BAR_WORDS 3456
#define XB_SPIN_CAP (1u << 22)

__device__ __forceinline__ unsigned xb_ld(unsigned* p)              { return __hip_atomic_load(p, __ATOMIC_RELAXED, __HIP_MEMORY_SCOPE_AGENT); }
__device__ __forceinline__ unsigned xb_add(unsigned* p, unsigned v) { return __hip_atomic_fetch_add(p, v, __ATOMIC_RELAXED, __HIP_MEMORY_SCOPE_AGENT); }
__device__ __forceinline__ unsigned xb_xcc_id() { return (unsigned)__builtin_amdgcn_s_getreg((3 << 11) | 20) & 0xFu; }
#define XB_SPIN(cond, bar) do { unsigned _sp = 0; while (cond) { __builtin_amdgcn_s_sleep(1); \
    if ((++_sp & 255u) == 0u) { if (xb_ld(&(bar)[XB_TMO])) break; if (_sp > XB_SPIN_CAP) { atomicAdd(&(bar)[XB_TMO], 1u); break; } } } } while (0)

struct XcdBarrier { unsigned* bar; unsigned x; volatile LAS unsigned* st; };

__device__ __forceinline__ XcdBarrier xcd_barrier_post(unsigned* bar, volatile LAS unsigned* st) {
    XcdBarrier b; b.bar = bar; b.x = xb_xcc_id(); b.st = st;
    if (threadIdx.x == 0) (void)xb_add(&bar[XB_XCNT(b.x)], 1u);
    return b;
}
__device__ __forceinline__ void xcd_barrier_complete(unsigned* bar, unsigned x, unsigned& nloc, unsigned& nx) {
    const unsigned G = gridDim.x * gridDim.y * gridDim.z;
    unsigned sum, cnt, mine, sp = 0u;
    for (;;) {
        sum = 0u; cnt = 0u; mine = 0u;
#pragma unroll
        for (unsigned j = 0; j < 16; ++j) { const unsigned c = xb_ld(&bar[XB_XCNT(j)]); sum += c; cnt += (c > 0u) ? 1u : 0u; mine = (j == x) ? c : mine; }
        if (sum == G) break;
        __builtin_amdgcn_s_sleep(1);
        if ((++sp & 255u) == 0u) { if (xb_ld(&bar[XB_TMO])) break; if (sp > XB_SPIN_CAP) { atomicAdd(&bar[XB_TMO], 1u); break; } }
    }
    nloc = mine > 0u ? mine : 1u; nx = cnt > 0u ? cnt : 1u;
}
__device__ __forceinline__ void xcd_barrier(const XcdBarrier& b) {
    asm volatile("s_waitcnt vmcnt(0)" ::: "memory");
    __syncthreads();
    if (threadIdx.x == 0) {
        unsigned* bar = b.bar;
        __builtin_amdgcn_s_waitcnt(0);
        unsigned nloc = b.st[0], nx = b.st[1];
        if (nloc == 0u) { xcd_barrier_complete(bar, b.x, nloc, nx); b.st[0] = nloc; b.st[1] = nx; }
        const unsigned old = xb_add(&bar[XB_XSUB(b.x)], 1u);
        const unsigned gen = old / nloc;
        if (old + 1u == (gen + 1u) * nloc) {
            __builtin_amdgcn_fence(__ATOMIC_RELEASE, "agent");
            asm volatile("s_waitcnt vmcnt(0)" ::: "memory");
            const unsigned og = xb_add(&bar[XB_TOP], 1u);
            const unsigned tg = og / nx;
            if (og + 1u == (tg + 1u) * nx) xb_add(&bar[XB_TOPGEN], 1u);
            else XB_SPIN(xb_ld(&bar[XB_TOPGEN]) == tg, bar);
            __builtin_amdgcn_fence(__ATOMIC_ACQUIRE, "agent");
            xb_add(&bar[XB_XGEN(b.x)], 1u);
            asm volatile("s_waitcnt vmcnt(0)" ::: "memory");
        } else {
            XB_SPIN(xb_ld(&bar[XB_XGEN(b.x)]) == gen, bar);
            __builtin_amdgcn_fence(__ATOMIC_ACQUIRE, "agent");
            asm volatile("s_waitcnt vmcnt(0)" ::: "memory");
        }
    }
    __syncthreads();
}

struct Params {
    const float *x, *c, *ctx, *c_ctx, *w_ada, *b_ada, *norm1, *w_in, *conv_w, *conv_b, *gate_a_w, *gate_a_b, *gate_x_w, *gate_x_b, *lam,
                *w_f, *w_r, *w_o, *norm2, *w_router, *b_router, *w_gu, *b_gu, *w_down, *b_down, *norm_f;
    float* out; unsigned char* ws;
    int ph_lo, ph_hi;
};
struct Frame {
    LAS unsigned char* lds; int tid, lane, wave, G, bid;
};
#define MODP(ws) ((const float*)((ws) + WS_MOD))
enum { M_SH1 = 0, M_SC1 = 1, M_G1 = 2, M_SH2 = 3, M_SC2 = 4, M_G2 = 5 };

__device__ __forceinline__ void p0_ada(const Params& p, Frame& F) {
    LAS float* scond = (LAS float*)F.lds;
    LAS float* red = (LAS float*)(F.lds + 9 * 1024 * 4);
    for (int i = F.tid; i < 9 * 1024; i += NTHREADS) { const int r = i >> 10, k = i & 1023; const float v = r < 8 ? p.c[r * 1024 + k] : p.c_ctx[k]; scond[i] = v / (1.0f + __expf(-v)); }
    __syncthreads();
    float* mod = (float*)(p.ws + WS_MOD);
    for (int item = F.bid; item < 6144 / 32; item += F.G) {
        const int n = item * 32 + (F.lane & 31), sl = F.wave * 2 + (F.lane >> 5);
        float a[9];
#pragma unroll
        for (int r = 0; r < 9; ++r) a[r] = 0.f;
#pragma unroll 8
        for (int kk = 0; kk < 64; ++kk) { const int k = sl * 64 + kk; const float w = p.w_ada[(size_t)k * 6144 + n];
#pragma unroll
            for (int r = 0; r < 9; ++r) a[r] += scond[r * 1024 + k] * w; }
#pragma unroll
        for (int r = 0; r < 9; ++r) red[(sl * 9 + r) * 32 + (F.lane & 31)] = a[r];
        __syncthreads();
        if (F.tid < 9 * 32) { const int r = F.tid >> 5, nn = F.tid & 31; float s = p.b_ada[item * 32 + nn];
            for (int q = 0; q < 16; ++q) s += red[(q * 9 + r) * 32 + nn];
            mod[r * 6144 + item * 32 + nn] = s; }
        __syncthreads();
    }
}
__device__ __forceinline__ void transpose_item(const float* W, int ldw, int ncol0, int k0, bf16_t* WT, int ldt, int drow0, LAS float* scr, int lane) {
#pragma unroll 8
    for (int i = 0; i < 32; ++i) { const int kk = 2 * i + (lane >> 5); scr[kk * 33 + (lane & 31)] = W[(size_t)(k0 + kk) * ldw + ncol0 + (lane & 31)]; }
    asm volatile("s_waitcnt lgkmcnt(0)" ::: "memory");
    const int c = lane & 7;
#pragma unroll
    for (int j = 0; j < 4; ++j) { const int n = (lane >> 3) + 8 * j; const LAS float* s = scr + (8 * c) * 33 + n;
        u32x4 o; o.x = pk2(s[0 * 33], s[1 * 33]); o.y = pk2(s[2 * 33], s[3 * 33]); o.z = pk2(s[4 * 33], s[5 * 33]); o.w = pk2(s[6 * 33], s[7 * 33]);
        *(u32x4*)(WT + (size_t)(drow0 + n) * ldt + k0 + 8 * c) = o; }
    asm volatile("s_waitcnt lgkmcnt(0)" ::: "memory");
}
__device__ __forceinline__ void transpose_matrix(const float* W, int K, int ldw, int c0, int N, bf16_t* WT, int drow0, LAS float* scr, int gw, int ngw, int lane) {
    const int nb = N / 32, nitems = (K / 64) * nb;
    for (int it = gw; it < nitems; it += ngw) { const int kb = it / nb, b = it % nb; transpose_item(W, ldw, c0 + 32 * b, 64 * kb, WT, K, drow0 + 32 * b, scr, lane); }
}
__device__ __forceinline__ void p0_weights(const Params& p, Frame& F) {
    unsigned char* ws = p.ws;
    LAS float* scr = (LAS float*)(F.lds + 65536 + F.wave * 8704);
    LAS float* tab = (LAS float*)(F.lds + 65536 + 8 * 8704);
    if (F.tid < 128) tab[F.tid] = cospif((float)F.tid / 64.0f);
    __syncthreads();
    const int gw = F.bid * NWAVES + F.wave, ngw = F.G * NWAVES;
    bf16_t* wcat = (bf16_t*)(ws + WS_WCAT);
    for (int it = gw; it < 1024 * 4; it += ngw) {
        const int k = it >> 2, g = it & 3; const float* src = p.w_in + (size_t)k * DIN + g * 128;
        float re0 = 0.f, re1 = 0.f, im0 = 0.f, im1 = 0.f; const int m0 = F.lane, m1 = F.lane + 64;
        for (int c = 0; c < 128; ++c) { const float u = src[c];
            re0 += u * tab[(m0 * c) & 127]; im0 -= u * tab[(m0 * c + 96) & 127];
            re1 += u * tab[(m1 * c) & 127]; im1 -= u * tab[(m1 * c + 96) & 127]; }
        const float sc = 0.08838834764831845f;
        wcat[(size_t)(g * 128 + m0) * 1024 + k] = (bf16_t)f2bf(re0 * sc); wcat[(size_t)(g * 128 + m1) * 1024 + k] = (bf16_t)f2bf(re1 * sc);
        wcat[(size_t)(512 + g * 128 + m0) * 1024 + k] = (bf16_t)f2bf(im0 * sc); wcat[(size_t)(512 + g * 128 + m1) * 1024 + k] = (bf16_t)f2bf(im1 * sc);
    }
    transpose_matrix(p.w_in, 1024, DIN, 512, 4096, wcat, 1024, scr, gw, ngw, F.lane);
    transpose_matrix(p.w_f, 512, 1024, 0, 1024, (bf16_t*)(ws + WS_WF), 0, scr, gw, ngw, F.lane);
    transpose_matrix(p.w_r, 1024, 1024, 0, 1024, (bf16_t*)(ws + WS_WR), 0, scr, gw, ngw, F.lane);
    transpose_matrix(p.w_o, 1024, 1024, 0, 1024, (bf16_t*)(ws + WS_WO), 0, scr, gw, ngw, F.lane);
    transpose_matrix(p.w_router, 1024, 32, 0, 32, (bf16_t*)(ws + WS_WROUT), 0, scr, gw, ngw, F.lane);
    for (int it = gw; it < 256; it += ngw) { const int q = it >> 3, sub = it & 7, d = q >> 4, ax = (q >> 3) & 1, h = q & 7;
        transpose_item((ax ? p.gate_x_w : p.gate_a_w) + (size_t)(d * 8 + h) * 16384, 128, 32 * (sub & 3), 64 * (sub >> 2), (bf16_t*)(ws + WS_GW) + (size_t)((d * 2 + ax) * 8 + h) * 16384, 128, 32 * (sub & 3), scr, F.lane); }
}
__device__ __forceinline__ void p_moe_weights(const Params& p, Frame& F) {
    LAS float* scr = (LAS float*)(F.lds + 65536 + F.wave * 8704);
    const int gw = F.bid * NWAVES + F.wave, ngw = F.G * NWAVES;
    bf16_t* wgu = (bf16_t*)(p.ws + WS_WGU); bf16_t* wd = (bf16_t*)(p.ws + WS_WD);
    constexpr int IT_GU = 16 * 64, IT_D = 16 * 32;
    for (int it = gw; it < NE * (IT_GU + IT_D); it += ngw) {
        const int e = it / (IT_GU + IT_D); int r = it % (IT_GU + IT_D);
        if (r < IT_GU) { const int kb = r / 64, b = r % 64, n0 = 32 * b; const int j = n0 & 1023, up = n0 >> 10;
            const int drow = 256 * (j >> 7) + 128 * up + (j & 127);
            transpose_item(p.w_gu + (size_t)e * 1024 * 2048, 2048, n0, 64 * kb, wgu + (size_t)e * 2048 * 1024, 1024, drow, scr, F.lane);
        } else { r -= IT_GU; const int kb = r / 32, b = r % 32;
            transpose_item(p.w_down + (size_t)e * 1024 * 1024, 1024, 32 * b, 64 * kb, wd + (size_t)e * 1024 * 1024, 1024, 32 * b, scr, F.lane); }
    }
}

__device__ __forceinline__ void norm_row_bf16(const float* xrow, const float* gain, const float* sc, const float* sh, bf16_t* orow, int lane) {
    const GAS f32x4* xr = (const GAS f32x4*)xrow + lane;
    f32x4 v[4]; float s = 0.f;
#pragma unroll
    for (int j = 0; j < 4; ++j) { v[j] = xr[64 * j]; s += (v[j].x * v[j].x + v[j].y * v[j].y) + (v[j].z * v[j].z + v[j].w * v[j].w); }
    const float rs = 1.0f / sqrtf(wave_sum(s) * (1.f / D) + EPS);
    GAS unsigned long long* o8 = (GAS unsigned long long*)orow + lane;
#pragma unroll
    for (int j = 0; j < 4; ++j) { const f32x4 g = ((const f32x4*)gain)[lane + 64 * j], a = ((const f32x4*)sc)[lane + 64 * j], b = ((const f32x4*)sh)[lane + 64 * j];
        const float o0 = v[j].x * rs * g.x * (1.f + a.x) + b.x, o1 = v[j].y * rs * g.y * (1.f + a.y) + b.y, o2 = v[j].z * rs * g.z * (1.f + a.z) + b.z, o3 = v[j].w * rs * g.w * (1.f + a.w) + b.w;
        o8[64 * j] = (unsigned long long)pk2(o0, o1) | ((unsigned long long)pk2(o2, o3) << 32); }
}
__device__ __forceinline__ void p1_norm(const Params& p, Frame& F) {
    const float* mod = MODP(p.ws); bf16_t* hx = (bf16_t*)(p.ws + WS_B0);
    const int gw = F.bid * NWAVES + F.wave, ngw = F.G * NWAVES;
    for (int m = gw; m < MT; m += ngw) {
        const float* src; int r;
        if (m < T) { src = p.x + (size_t)m * D; r = m / SEQ; } else { src = p.ctx + (size_t)(m - T) * D; r = 8; }
        norm_row_bf16(src, p.norm1, mod + r * 6144 + M_SC1 * 1024, mod + r * 6144 + M_SH1 * 1024, hx + (size_t)m * D, F.lane);
    }
}

struct Sched2 {
    const char* hx; const char* wcat; int G, c;
    __device__ __forceinline__ bool next(int i, pg8::Unit& u) const {
        const long L = (long)i * G + c; int pm, pn;
        if (L < 256 * 20) { pg8::tile_order(L, 256, 20, pm, pn); }
        else if (L < 256 * 20 + 32) { const int j = (int)(L - 256 * 20); pm = 256 + (j >> 2); pn = 4 + (j & 3); }
        else return false;
        u.pm = pm; u.pn = pn; u.aux = 0; u.A = hx + (size_t)pm * 256 * 2048; u.B = wcat + (size_t)pn * 256 * 2048; return true;
    }
};
__device__ __forceinline__ f32x4 gelu_tanh4(f32x4 v) {
    f32x4 o;
#pragma unroll
    for (int j = 0; j < 4; ++j) { const float x = v[j]; o[j] = x * fast_sigmoid(1.59576912f * x * (1.0f + 0.044715f * x * x)); }
    return o;
}
__device__ __forceinline__ f32x4 sigmoid4(f32x4 v) { f32x4 o;
#pragma unroll
    for (int j = 0; j < 4; ++j) o[j] = fast_sigmoid(v[j]);
    return o; }
struct Epi2 {
    static constexpr bool PERM = true;
    unsigned char* ws;
    __device__ __forceinline__ void operator()(const f32x4 (&acc)[2][2][4][2], const pg8::Unit& u, int wr, int wc, int fr, int fq) const {
        const int t = u.pn >> 2; const size_t boff = t == 0 ? WS_B1 : t == 1 ? WS_B2 : t == 2 ? WS_B3 : t == 3 ? WS_B4 : WS_B5;
        bf16_t* base = (bf16_t*)(ws + boff);
        const int row0 = u.pm * 256 + wr * 64 + fr, col0 = (u.pn & 3) * 256 + wc * 32 + 8 * fq;
#pragma unroll
        for (int ai = 0; ai < 2; ++ai)
#pragma unroll
            for (int m = 0; m < 4; ++m) { bf16_t* rowp = base + (size_t)(row0 + ai * 128 + m * 16) * 1024 + col0;
#pragma unroll
                for (int bj = 0; bj < 2; ++bj) { f32x4 v0 = acc[ai][bj][m][0], v1 = acc[ai][bj][m][1];
                    if (t == 2) { v0 = gelu_tanh4(v0); v1 = gelu_tanh4(v1); }
                    else if (t >= 3) { v0 = sigmoid4(v0); v1 = sigmoid4(v1); }
                    u32x4 w; w.x = cvt_pk_bf16(v0[0], v0[1]); w.y = cvt_pk_bf16(v0[2], v0[3]); w.z = cvt_pk_bf16(v1[0], v1[1]); w.w = cvt_pk_bf16(v1[2], v1[3]);
                    *(u32x4*)(rowp + bj * 128) = w; } }
    }
};

__device__ __forceinline__ void p3_rnn_naive(const Params& p, Frame& F) {
    LAS float* wa = (LAS float*)F.lds;
    LAS float* wx = wa + 128 * 128;
    LAS float* urow = wx + 128 * 128;
    LAS float* part = urow + 128;
    const bf16_t* zr = (const bf16_t*)(p.ws + WS_B2);
    bf16_t* hf = (bf16_t*)(p.ws + WS_B0); bf16_t* hb = (bf16_t*)(p.ws + WS_B6);
    const int c = F.tid & 127, part_i = F.tid >> 7;
    for (int chain = F.bid; chain < 128; chain += F.G) {
        const int b = chain >> 4, d = (chain >> 3) & 1, h = chain & 7, ch = h * 128 + c;
        __syncthreads();
        for (int i = F.tid; i < 128 * 128; i += NTHREADS) { wa[i] = p.gate_a_w[((size_t)(d * 8 + h) * 128) * 128 + i]; wx[i] = p.gate_x_w[((size_t)(d * 8 + h) * 128) * 128 + i]; }
        const float ba = p.gate_a_b[d * 1024 + ch], bx = p.gate_x_b[d * 1024 + ch];
        const float lam = p.lam[d * 1024 + ch]; const float spl = 8.0f * log1pf(expf(-lam));
        const float cw0 = p.conv_w[0 * 1024 + ch], cw1 = p.conv_w[1 * 1024 + ch], cw2 = p.conv_w[2 * 1024 + ch], cw3 = p.conv_w[3 * 1024 + ch], cb = p.conv_b[ch];
        float hstate = 0.f;
        __syncthreads();
        for (int step = 0; step < CTXL + SEQ; ++step) {
            const bool isctx = step < CTXL; const int s = isctx ? step : step - CTXL; const int len = isctx ? CTXL : SEQ;
            const int t = d ? (len - 1 - s) : s;
            const size_t rbase = isctx ? (size_t)T + (size_t)b * CTXL : (size_t)b * SEQ;
            float u = 0.f;
            if (part_i == 0) {
                const int lo = isctx ? 0 : (t & ~63), hi = isctx ? CTXL : lo + 64;
                u = cb;
                if (t - 2 >= lo) u += cw0 * bf2f(zr[(rbase + t - 2) * 1024 + ch]);
                if (t - 1 >= lo) u += cw1 * bf2f(zr[(rbase + t - 1) * 1024 + ch]);
                u += cw2 * bf2f(zr[(rbase + t) * 1024 + ch]);
                if (t + 1 < hi) u += cw3 * bf2f(zr[(rbase + t + 1) * 1024 + ch]);
                urow[c] = u;
            }
            __syncthreads();
            float pa = 0.f, px = 0.f;
#pragma unroll 8
            for (int i = 0; i < 32; ++i) { const int ii = part_i * 32 + i; const float uv = urow[ii]; pa += uv * wa[ii * 128 + c]; px += uv * wx[ii * 128 + c]; }
            part[(0 * 4 + part_i) * 128 + c] = pa; part[(1 * 4 + part_i) * 128 + c] = px;
            __syncthreads();
            if (part_i == 0) {
                const float sa = ba + part[c] + part[128 + c] + part[256 + c] + part[384 + c];
                const float sx = bx + part[512 + c] + part[640 + c] + part[768 + c] + part[896 + c];
                const float r = 1.0f / (1.0f + expf(-sa)), ig = 1.0f / (1.0f + expf(-sx));
                const float la = -spl * r, a = expf(la), bt = sqrtf(-expm1f(2.0f * la)) * (ig * u);
                hstate = a * hstate + bt;
                if (!isctx) { bf16_t* o = d ? hb : hf; o[(rbase + t) * 1024 + ch] = (bf16_t)f2bf(hstate); }
            }
        }
    }
}
__device__ __forceinline__ void p3_dftA_naive(const Params& p, Frame& F, int myi, int nbl) {
    LAS float* c64 = (LAS float*)(F.lds + 140 * 1024); LAS float* s64 = c64 + 64;
    __syncthreads();
    if (F.tid < 64) { c64[F.tid] = cospif((float)F.tid / 32.0f); s64[F.tid] = sinpif((float)F.tid / 32.0f); }
    __syncthreads();
    const bf16_t* V = (const bf16_t*)(p.ws + WS_B1); bf16_t* Tb = (bf16_t*)(p.ws + WS_B1);
    const int m = F.tid;
    for (int item = myi; item < NB * 128; item += nbl) {
        const int b = item >> 7, l2 = item & 127;
        float xr[64], xi[64];
#pragma unroll
        for (int l1 = 0; l1 < 64; ++l1) { const size_t row = (size_t)b * SEQ + 128 * l1 + l2; xr[l1] = bf2f(V[row * 1024 + m]); xi[l1] = bf2f(V[row * 1024 + 512 + m]); }
        for (int k1 = 0; k1 < 64; ++k1) {
            float ar = 0.f, ai = 0.f;
#pragma unroll
            for (int l1 = 0; l1 < 64; ++l1) { const int q = (k1 * l1) & 63; const float cc = c64[q], ss = s64[q];
                ar += cc * xr[l1] + ss * xi[l1]; ai += cc * xi[l1] - ss * xr[l1]; }
            float tc, ts; sincospif((float)(k1 * l2) / 4096.0f, &ts, &tc);
            const float orr = (ar * tc + ai * ts) * 0.125f, oi = (ai * tc - ar * ts) * 0.125f;
            const size_t orow = (size_t)b * SEQ + 128 * k1 + l2;
            Tb[orow * 1024 + m] = (bf16_t)f2bf(orr); Tb[orow * 1024 + 512 + m] = (bf16_t)f2bf(oi);
        }
    }
}
__device__ __forceinline__ void p4_dftB_naive(const Params& p, Frame& F) {
    LAS bf16_t* tile = (LAS bf16_t*)F.lds;
    LAS float* c128 = (LAS float*)(F.lds + 140 * 1024); LAS float* s128 = c128 + 128;
    __syncthreads();
    if (F.tid < 128) { c128[F.tid] = cospif((float)F.tid / 64.0f); s128[F.tid] = sinpif((float)F.tid / 64.0f); }
    const bf16_t* Tb = (const bf16_t*)(p.ws + WS_B1); bf16_t* Y = (bf16_t*)(p.ws + WS_B7);
    for (int item = F.bid; item < NB * 64 * 2; item += F.G) {
        const int b = item >> 7, k1 = (item >> 1) & 63, chh = item & 1;
        __syncthreads();
        for (int i = F.tid; i < 128 * 64; i += NTHREADS) {
            const int l2 = i >> 6, pc = i & 63, im = pc >> 5, cc = (pc & 31) * 8;
            const size_t row = (size_t)b * SEQ + 128 * k1 + l2;
            *(LAS u32x4*)(tile + l2 * 512 + im * 256 + cc) = *(const u32x4*)(Tb + row * 1024 + im * 512 + chh * 256 + cc);
        }
        __syncthreads();
        const int m = F.tid & 255, kh = F.tid >> 8;
        for (int kk = 0; kk < 64; ++kk) { const int k2 = kh * 64 + kk; float s = 0.f;
#pragma unroll 8
            for (int l2 = 0; l2 < 128; ++l2) { const int q = (k2 * l2) & 127; s += c128[q] * bf2f(tile[l2 * 512 + m]) + s128[q] * bf2f(tile[l2 * 512 + 256 + m]); }
            Y[((size_t)b * SEQ + k1 + 64 * k2) * 512 + chh * 256 + m] = (bf16_t)f2bf(s * 0.08838834764831845f);
        }
    }
}
__device__ __forceinline__ void p4_yg_naive(const Params& p, Frame& F) {
    const u32x4* hf = (const u32x4*)(p.ws + WS_B0); const u32x4* hb = (const u32x4*)(p.ws + WS_B6); const u32x4* G = (const u32x4*)(p.ws + WS_B3); u32x4* yg = (u32x4*)(p.ws + WS_B2);
    const size_t n = (size_t)T * 1024 / 8;
    for (size_t i = (size_t)F.bid * NTHREADS + F.tid; i < n; i += (size_t)F.G * NTHREADS) {
        const u32x4 a = hf[i], b = hb[i], g = G[i]; u32x4 o;
        o.x = pk2((bflo(a.x) + bflo(b.x)) * bflo(g.x), (bfhi(a.x) + bfhi(b.x)) * bfhi(g.x));
        o.y = pk2((bflo(a.y) + bflo(b.y)) * bflo(g.y), (bfhi(a.y) + bfhi(b.y)) * bfhi(g.y));
        o.z = pk2((bflo(a.z) + bflo(b.z)) * bflo(g.z), (bfhi(a.z) + bfhi(b.z)) * bfhi(g.z));
        o.w = pk2((bflo(a.w) + bflo(b.w)) * bflo(g.w), (bfhi(a.w) + bfhi(b.w)) * bfhi(g.w));
        yg[i] = o;
    }
}

constexpr size_t AGG_CAR = 4608 * 1024;
constexpr int UP = 272;
template <int DIR> __device__ __forceinline__ void rnn_block(const f32x4 pa, const f32x4 px, const float (&u)[4], float ba, float bx, float spl2, float spl, int fq, int fr,
                                                             float& Pc, float& Lc, float (&hout)[4], float (&pout)[4]) {
    float a[4], b[4];
#pragma unroll
    for (int j = 0; j < 4; ++j) {
        const float r = __builtin_amdgcn_rcpf(1.0f + __builtin_amdgcn_exp2f(-1.44269504f * (pa[j] + ba)));
        const float ig = __builtin_amdgcn_rcpf(1.0f + __builtin_amdgcn_exp2f(-1.44269504f * (px[j] + bx)));
        a[j] = __builtin_amdgcn_exp2f(-spl2 * r);
        const float t = 2.0f * spl * r;
        const float om = t < 0.25f ? t * (1.0f - t * (0.5f - t * (0.16666667f - t * (0.041666668f - t * 0.0083333338f)))) : 1.0f - a[j] * a[j];
        b[j] = __builtin_amdgcn_sqrtf(om) * ig * u[j];
    }
    float P[4], L[4];
    if (DIR == 0) { P[0] = a[0]; L[0] = b[0];
#pragma unroll
        for (int j = 1; j < 4; ++j) { P[j] = a[j] * P[j - 1]; L[j] = a[j] * L[j - 1] + b[j]; } }
    else { P[3] = a[3]; L[3] = b[3];
#pragma unroll
        for (int j = 2; j >= 0; --j) { P[j] = a[j] * P[j + 1]; L[j] = a[j] * L[j + 1] + b[j]; } }
    float Pg = DIR == 0 ? P[3] : P[0], Lg = DIR == 0 ? L[3] : L[0];
    float Pp, Lp;
    if (DIR == 0) { Pp = __shfl_up(Pg, 16); Lp = __shfl_up(Lg, 16); if (fq >= 1) { Lg = Pg * Lp + Lg; Pg = Pg * Pp; }
                    Pp = __shfl_up(Pg, 32); Lp = __shfl_up(Lg, 32); if (fq >= 2) { Lg = Pg * Lp + Lg; Pg = Pg * Pp; } }
    else          { Pp = __shfl_down(Pg, 16); Lp = __shfl_down(Lg, 16); if (fq <= 2) { Lg = Pg * Lp + Lg; Pg = Pg * Pp; }
                    Pp = __shfl_down(Pg, 32); Lp = __shfl_down(Lg, 32); if (fq <= 1) { Lg = Pg * Lp + Lg; Pg = Pg * Pp; } }
    float Pe, Le;
    if (DIR == 0) { Pe = __shfl_up(Pg, 16); Le = __shfl_up(Lg, 16); if (fq == 0) { Pe = 1.f; Le = 0.f; } }
    else          { Pe = __shfl_down(Pg, 16); Le = __shfl_down(Lg, 16); if (fq == 3) { Pe = 1.f; Le = 0.f; } }
    const float Pin = Pe * Pc, Lin = Pe * Lc + Le;
#pragma unroll
    for (int j = 0; j < 4; ++j) { hout[j] = P[j] * Lin + L[j]; pout[j] = P[j] * Pin; }
    const float Pb = __shfl(Pg, DIR == 0 ? 48 + fr : fr), Lb = __shfl(Lg, DIR == 0 ? 48 + fr : fr);
    Lc = Pb * Lc + Lb; Pc = Pb * Pc;
}
__device__ __forceinline__ void p3_rnn_fast(const Params& p, Frame& F) {
    LAS unsigned char* Rt = F.lds;
    LAS unsigned char* Ut = F.lds + 65536;
    LAS unsigned char* Sl = F.lds + 135168;
    bf16_t* zr = (bf16_t*)(p.ws + WS_B2); bf16_t* pfb = (bf16_t*)(p.ws + WS_B0); bf16_t* pbb = (bf16_t*)(p.ws + WS_B6);
    const bf16_t* gw = (const bf16_t*)(p.ws + WS_GW);
    f32x2* agg = (f32x2*)(p.ws + WS_AGG);
    const int fr = F.lane & 15, fq = F.lane >> 4, chl = 16 * F.wave + fr;
    const int fl_r = (F.tid & 255) >> 4, fl_c = F.tid & 15, fl_a = F.tid >> 8;
    for (int unit = F.bid; unit < 264 * 8; unit += F.G) {
        const int pm = unit >> 3, h = unit & 7; const bool isctx = pm >= 256;
        const size_t row0 = (size_t)pm * 256; const int ch = h * 128 + chl;
        __syncthreads();
#pragma unroll
        for (int i = 0; i < 8; ++i) { const int pc = F.tid + i * NTHREADS, r = pc >> 4, c16 = pc & 15;
            *(LAS u32x4*)(Rt + r * 256 + c16 * 16) = *(const u32x4*)(zr + (row0 + r) * 1024 + h * 128 + c16 * 8); }
        __syncthreads();
        { const int cp = F.tid & 15, rg = F.tid >> 4, r8 = rg * 8; const int lo = isctx ? 0 : (r8 & ~63), hi = isctx ? 256 : lo + 64;
          float cw[4][8], cbv[8];
#pragma unroll
          for (int k = 0; k < 4; ++k)
#pragma unroll
              for (int c = 0; c < 8; ++c) cw[k][c] = p.conv_w[k * 1024 + h * 128 + cp * 8 + c];
#pragma unroll
          for (int c = 0; c < 8; ++c) cbv[c] = p.conv_b[h * 128 + cp * 8 + c];
          float in[11][8];
#pragma unroll
          for (int i = 0; i < 11; ++i) { const int r = r8 - 2 + i; u32x4 v = {0u, 0u, 0u, 0u}; if (r >= lo && r < hi) v = *(const LAS u32x4*)(Rt + r * 256 + cp * 16);
              in[i][0] = bflo(v.x); in[i][1] = bfhi(v.x); in[i][2] = bflo(v.y); in[i][3] = bfhi(v.y); in[i][4] = bflo(v.z); in[i][5] = bfhi(v.z); in[i][6] = bflo(v.w); in[i][7] = bfhi(v.w); }
#pragma unroll
          for (int i = 0; i < 8; ++i) { float o[8];
#pragma unroll
              for (int c = 0; c < 8; ++c) o[c] = cbv[c] + cw[0][c] * in[i][c] + cw[1][c] * in[i + 1][c] + cw[2][c] * in[i + 2][c] + cw[3][c] * in[i + 3][c];
              u32x4 w; w.x = pk2(o[0], o[1]); w.y = pk2(o[2], o[3]); w.z = pk2(o[4], o[5]); w.w = pk2(o[6], o[7]);
              *(LAS u32x4*)(Ut + (r8 + i) * UP + cp * 16) = w; }
        }
        __syncthreads();
        {
            const float ba = p.gate_a_b[ch], bx = p.gate_x_b[ch]; const float spl = 8.0f * log1pf(expf(-p.lam[ch])), spl2 = spl * 1.44269504f;
            bf16x8 bfa[4], bfx[4];
#pragma unroll
            for (int s = 0; s < 4; ++s) { bfa[s] = *(const bf16x8*)(gw + ((size_t)((0 * 2 + 0) * 8 + h) * 128 + chl) * 128 + 32 * s + 8 * fq);
                                          bfx[s] = *(const bf16x8*)(gw + ((size_t)((0 * 2 + 1) * 8 + h) * 128 + chl) * 128 + 32 * s + 8 * fq); }
            float Pc = 1.f, Lc = 0.f;
#pragma unroll 1
            for (int mb = 0; mb < 16; ++mb) {
                f32x4 pa = {0.f, 0.f, 0.f, 0.f}, px = {0.f, 0.f, 0.f, 0.f};
#pragma unroll
                for (int s = 0; s < 4; ++s) { const bf16x8 af = *(const LAS bf16x8*)(Ut + (16 * mb + fr) * UP + (32 * s + 8 * fq) * 2);
                    pa = __builtin_amdgcn_mfma_f32_16x16x32_bf16(af, bfa[s], pa, 0, 0, 0); px = __builtin_amdgcn_mfma_f32_16x16x32_bf16(af, bfx[s], px, 0, 0, 0); }
                float u[4];
#pragma unroll
                for (int j = 0; j < 4; ++j) u[j] = bf2f(*(const LAS bf16_t*)(Ut + (16 * mb + 4 * fq + j) * UP + chl * 2));
                float hout[4], pout[4];
                rnn_block<0>(pa, px, u, ba, bx, spl2, spl, fq, fr, Pc, Lc, hout, pout);
                LAS unsigned char* sl = Sl + (mb & 1) * 4096;
#pragma unroll
                for (int j = 0; j < 4; ++j) { *(LAS bf16_t*)(Rt + (16 * mb + 4 * fq + j) * 256 + chl * 2) = (bf16_t)f2bf(hout[j]);
                                              *(LAS bf16_t*)(sl + (4 * fq + j) * 256 + chl * 2) = (bf16_t)f2bf(pout[j]); }
                __syncthreads();
                if (!isctx && fl_a == 0) *(u32x4*)(pfb + (row0 + 16 * mb + fl_r) * 1024 + h * 128 + fl_c * 8) = *(const LAS u32x4*)(sl + fl_r * 256 + fl_c * 16);
            }
            if (fq == 0) agg[((size_t)0 * 264 + pm) * 1024 + ch] = (f32x2){Pc, Lc};
        }
        {
            const float ba = p.gate_a_b[1024 + ch], bx = p.gate_x_b[1024 + ch]; const float spl = 8.0f * log1pf(expf(-p.lam[1024 + ch])), spl2 = spl * 1.44269504f;
            bf16x8 bfa[4], bfx[4];
#pragma unroll
            for (int s = 0; s < 4; ++s) { bfa[s] = *(const bf16x8*)(gw + ((size_t)((1 * 2 + 0) * 8 + h) * 128 + chl) * 128 + 32 * s + 8 * fq);
                                          bfx[s] = *(const bf16x8*)(gw + ((size_t)((1 * 2 + 1) * 8 + h) * 128 + chl) * 128 + 32 * s + 8 * fq); }
            float Pc = 1.f, Lc = 0.f;
#pragma unroll 1
            for (int mb = 15; mb >= 0; --mb) {
                f32x4 pa = {0.f, 0.f, 0.f, 0.f}, px = {0.f, 0.f, 0.f, 0.f};
#pragma unroll
                for (int s = 0; s < 4; ++s) { const bf16x8 af = *(const LAS bf16x8*)(Ut + (16 * mb + fr) * UP + (32 * s + 8 * fq) * 2);
                    pa = __builtin_amdgcn_mfma_f32_16x16x32_bf16(af, bfa[s], pa, 0, 0, 0); px = __builtin_amdgcn_mfma_f32_16x16x32_bf16(af, bfx[s], px, 0, 0, 0); }
                float u[4];
#pragma unroll
                for (int j = 0; j < 4; ++j) u[j] = bf2f(*(const LAS bf16_t*)(Ut + (16 * mb + 4 * fq + j) * UP + chl * 2));
                float hout[4], pout[4];
                rnn_block<1>(pa, px, u, ba, bx, spl2, spl, fq, fr, Pc, Lc, hout, pout);
                LAS unsigned char* sl = Sl + (mb & 1) * 8192;
#pragma unroll
                for (int j = 0; j < 4; ++j) { const float hf = bf2f(*(const LAS bf16_t*)(Rt + (16 * mb + 4 * fq + j) * 256 + chl * 2));
                                              *(LAS bf16_t*)(sl + (4 * fq + j) * 256 + chl * 2) = (bf16_t)f2bf(hf + hout[j]);
                                              *(LAS bf16_t*)(sl + 4096 + (4 * fq + j) * 256 + chl * 2) = (bf16_t)f2bf(pout[j]); }
                __syncthreads();
                if (!isctx) { bf16_t* dst = fl_a ? pbb : zr;
                    *(u32x4*)(dst + (row0 + 16 * mb + fl_r) * 1024 + h * 128 + fl_c * 8) = *(const LAS u32x4*)(sl + fl_a * 4096 + fl_r * 256 + fl_c * 16); }
            }
            if (fq == 0) agg[((size_t)1 * 264 + pm) * 1024 + ch] = (f32x2){Pc, Lc};
        }
    }
}
__device__ __forceinline__ void p3c_carries(const Params& p, Frame& F) {
    const f32x2* agg = (const f32x2*)(p.ws + WS_AGG); float* car = (float*)(p.ws + WS_AGG + AGG_CAR);
    for (int i = F.bid * NTHREADS + F.tid; i < 2 * NB * 1024; i += F.G * NTHREADS) {
        const int d = i >> 13, b = (i >> 10) & 7, ch = i & 1023;
        float c = agg[((size_t)d * 264 + 256 + b) * 1024 + ch].y;
        for (int s = 0; s < 32; ++s) { const int j = d ? 31 - s : s; const size_t t = (size_t)b * 32 + j;
            car[((size_t)d * 256 + t) * 1024 + ch] = c; const f32x2 a = agg[((size_t)d * 264 + t) * 1024 + ch]; c = a.x * c + a.y; }
    }
}
__device__ __forceinline__ void p4_yg_fast(const Params& p, Frame& F) {
    bf16_t* S = (bf16_t*)(p.ws + WS_B2); const bf16_t* Pf = (const bf16_t*)(p.ws + WS_B0); const bf16_t* Pb = (const bf16_t*)(p.ws + WS_B6); const bf16_t* G = (const bf16_t*)(p.ws + WS_B3);
    const float* car = (const float*)(p.ws + WS_AGG + AGG_CAR);
    const int cg = F.tid & 127, ro = F.tid >> 7;
    for (int pm = F.bid; pm < 256; pm += F.G) {
        float cf[8], cb[8];
#pragma unroll
        for (int c = 0; c < 8; ++c) { cf[c] = car[((size_t)0 * 256 + pm) * 1024 + cg * 8 + c]; cb[c] = car[((size_t)1 * 256 + pm) * 1024 + cg * 8 + c]; }
#pragma unroll 4
        for (int rr = 0; rr < 64; ++rr) { const size_t off = ((size_t)pm * 256 + ro + 4 * rr) * 1024 + cg * 8;
            const u32x4 s = *(const u32x4*)(S + off), f = *(const u32x4*)(Pf + off), b = *(const u32x4*)(Pb + off), g = *(const u32x4*)(G + off);
            u32x4 o;
            o.x = pk2((bflo(s.x) + bflo(f.x) * cf[0] + bflo(b.x) * cb[0]) * bflo(g.x), (bfhi(s.x) + bfhi(f.x) * cf[1] + bfhi(b.x) * cb[1]) * bfhi(g.x));
            o.y = pk2((bflo(s.y) + bflo(f.y) * cf[2] + bflo(b.y) * cb[2]) * bflo(g.y), (bfhi(s.y) + bfhi(f.y) * cf[3] + bfhi(b.y) * cb[3]) * bfhi(g.y));
            o.z = pk2((bflo(s.z) + bflo(f.z) * cf[4] + bflo(b.z) * cb[4]) * bflo(g.z), (bfhi(s.z) + bfhi(f.z) * cf[5] + bfhi(b.z) * cb[5]) * bfhi(g.z));
            o.w = pk2((bflo(s.w) + bflo(f.w) * cf[6] + bflo(b.w) * cb[6]) * bflo(g.w), (bfhi(s.w) + bfhi(f.w) * cf[7] + bfhi(b.w) * cb[7]) * bfhi(g.w));
            *(u32x4*)(S + off) = o; }
    }
}

typedef short s16x4 __attribute__((ext_vector_type(4)));
__device__ __forceinline__ unsigned dft_offb(unsigned row, unsigned ch) { return 256u * row + 16u * (ch ^ (((row & 3u) << 2) | ((row >> 2) & 3u))); }
__device__ __forceinline__ unsigned dft_tr_addr(unsigned lane, unsigned c, unsigned ks, unsigned t) {
    const unsigned g = lane >> 4, q = (lane & 15u) >> 2, p = lane & 3u;
    return dft_offb(32u * ks + 8u * g + 4u * t + q, 2u * c + (p >> 1)) + 8u * (p & 1u);
}
template <int STAGE, int NIMG> __device__ __forceinline__ void dft_fast(const Params& p, Frame& F) {
    constexpr int NK = STAGE == 0 ? 128 : 256, NKS = NK / 32, IMG = NK * 256, MBW = NIMG * 4, NPC = 16 * NIMG  , DSP = NIMG * 256 + 16  ;
    constexpr int STG = (NK * 256 * NIMG + 128 * DSP <= 147456) ? NK * 256 * NIMG : 0;
    LAS unsigned char* X = F.lds; LAS unsigned char* St = F.lds + STG;
    bf16_t* V = (bf16_t*)(p.ws + WS_B1); bf16_t* Y = (bf16_t*)(p.ws + WS_B7);
    const int fr = F.lane & 15, fq = F.lane >> 4, q = F.wave & 3, mb0 = (F.wave >> 2) * MBW;
    bf16x8 bfr[2][NKS];
#pragma unroll
    for (int o = 0; o < 2; ++o)
#pragma unroll
        for (int ks = 0; ks < NKS; ++ks) { float v[8];
#pragma unroll
            for (int jj = 0; jj < 8; ++jj) { const int kk = o * 64 + 16 * q + fr, k = 32 * ks + 8 * fq + jj;
                if (STAGE == 0) { const int k1 = kk & 63, l1 = k & 63, oi = kk >> 6, ii = k >> 6; const float a = (float)((k1 * l1) & 63) / 32.0f; const float c = cospif(a), sn = sinpif(a);
                    v[jj] = 0.125f * (oi == ii ? c : (oi ? -sn : sn)); }
                else { const int l2 = k & 127, ii = k >> 7; const float a = (float)((kk * l2) & 127) / 64.0f; v[jj] = 0.08838834764831845f * (ii ? sinpif(a) : cospif(a)); } }
            u32x4 w; w.x = pk2(v[0], v[1]); w.y = pk2(v[2], v[3]); w.z = pk2(v[4], v[5]); w.w = pk2(v[6], v[7]); bfr[o][ks] = __builtin_bit_cast(bf16x8, w); }
    unsigned tra[2], xe[2];
#pragma unroll
    for (int t = 0; t < 2; ++t) { const unsigned g = (unsigned)F.lane >> 4, qq = ((unsigned)F.lane & 15u) >> 2, pp = (unsigned)F.lane & 3u, row = 8u * g + 4u * t + qq;
        const unsigned x = ((row & 3u) << 2) | ((row >> 2) & 3u); xe[t] = x & 14u; tra[t] = 256u * row + 16u * ((pp >> 1) ^ (x & 1u)) + 8u * (pp & 1u); }
    constexpr int NS = 512 / (128 * NIMG);
    const int nunits = (STAGE == 0 ? NB * 128 : NB * 64) * NS;
    for (int unit = F.bid; unit < nunits; unit += F.G) {
        const int slab = unit % NS, rest = unit / NS; int b, a1;
        if (STAGE == 0) { b = rest >> 7; a1 = rest & 127; } else { b = rest >> 6; a1 = rest & 63; }
        __syncthreads();
#pragma unroll
        for (int i = 0; i < NK * NPC / NTHREADS; ++i) { const int pc = F.tid + i * NTHREADS, k = pc / NPC, c32 = pc % NPC, ri = k / (NK / 2), idx = k % (NK / 2);
            const size_t srow = (size_t)b * SEQ + (STAGE == 0 ? 128 * idx + a1 : 128 * a1 + idx);
            *(LAS u32x4*)(X + (c32 >> 4) * IMG + dft_offb((unsigned)k, (unsigned)(c32 & 15))) = *(const u32x4*)(V + srow * 1024 + ri * 512 + slab * (128 * NIMG) + c32 * 8); }
        __syncthreads();
        f32x4 acc[MBW][2];
#pragma unroll
        for (int mb = 0; mb < MBW; ++mb) { acc[mb][0] = (f32x4){0.f, 0.f, 0.f, 0.f}; acc[mb][1] = (f32x4){0.f, 0.f, 0.f, 0.f}; }
        LAS unsigned char* Xi = X + ((mb0 * 16) >> 7) * IMG; const unsigned c0 = (unsigned)(mb0 & 7);
#pragma unroll
        for (int ks = 0; ks < NKS; ++ks) {
#pragma unroll
            for (int mb = 0; mb < MBW; ++mb) {
                const s16x4 lo = __builtin_amdgcn_ds_read_tr16_b64_v4i16((LAS s16x4*)(Xi + ks * 8192 + tra[0] + 16u * ((2u * (c0 + mb)) ^ xe[0])));
                const s16x4 hi = __builtin_amdgcn_ds_read_tr16_b64_v4i16((LAS s16x4*)(Xi + ks * 8192 + tra[1] + 16u * ((2u * (c0 + mb)) ^ xe[1])));
                const bf16x8 af = {lo[0], lo[1], lo[2], lo[3], hi[0], hi[1], hi[2], hi[3]};
                acc[mb][0] = __builtin_amdgcn_mfma_f32_16x16x32_bf16(af, bfr[0][ks], acc[mb][0], 0, 0, 0);
                acc[mb][1] = __builtin_amdgcn_mfma_f32_16x16x32_bf16(af, bfr[1][ks], acc[mb][1], 0, 0, 0);
            }
            __builtin_amdgcn_sched_barrier(0);
        }
        if (STG == 0) __syncthreads();
        float tc = 1.f, ts = 0.f;
        if (STAGE == 0) sincospif((float)((16 * q + fr) * a1) / 4096.0f, &ts, &tc);
#pragma unroll
        for (int mb = 0; mb < MBW; ++mb) { f32x4 r0 = acc[mb][0], r1 = acc[mb][1];
            if (STAGE == 0) { const f32x4 tr = r0, ti = r1; r0 = tr * tc + ti * ts; r1 = ti * tc - tr * ts; }
            u32x2 w0, w1; w0.x = pk2(r0[0], r0[1]); w0.y = pk2(r0[2], r0[3]); w1.x = pk2(r1[0], r1[1]); w1.y = pk2(r1[2], r1[3]);
            *(LAS u32x2*)(St + (16 * q + fr) * DSP + (16 * (mb0 + mb) + 4 * fq) * 2) = w0;
            *(LAS u32x2*)(St + (64 + 16 * q + fr) * DSP + (16 * (mb0 + mb) + 4 * fq) * 2) = w1; }
        __syncthreads();
#pragma unroll
        for (int i = 0; i < 128 * NPC / NTHREADS; ++i) { const int pc = F.tid + i * NTHREADS, row = pc / NPC, c32 = pc % NPC;
            const u32x4 v = *(const LAS u32x4*)(St + row * DSP + c32 * 16);
            if (STAGE == 0) { const int ri = row >> 6, k1 = row & 63; *(u32x4*)(V + ((size_t)b * SEQ + 128 * k1 + a1) * 1024 + ri * 512 + slab * (128 * NIMG) + c32 * 8) = v; }
            else *(u32x4*)(Y + ((size_t)b * SEQ + a1 + 64 * row) * 512 + slab * (128 * NIMG) + c32 * 8) = v; }
    }
}

struct SchedPlain {
    const char* A; const char* B; size_t lda, ldb; int nM, nN, G, c;
    __device__ __forceinline__ bool next(int i, pg8::Unit& u) const {
        const long L = (long)i * G + c; int pm, pn; if (!pg8::tile_order(L, nM, nN, pm, pn)) return false;
        u.pm = pm; u.pn = pn; u.aux = 0; u.A = A + (size_t)pm * 256 * lda; u.B = B + (size_t)pn * 256 * ldb; return true;
    }
};
struct EpiR {
    static constexpr bool PERM = true;
    const bf16_t* gate; bf16_t* out;
    __device__ __forceinline__ void operator()(const f32x4 (&acc)[2][2][4][2], const pg8::Unit& u, int wr, int wc, int fr, int fq) const {
        const int row0 = u.pm * 256 + wr * 64 + fr, col0 = u.pn * 256 + wc * 32 + 8 * fq;
#pragma unroll
        for (int ai = 0; ai < 2; ++ai)
#pragma unroll
            for (int m = 0; m < 4; ++m) { const size_t off = (size_t)(row0 + ai * 128 + m * 16) * 1024 + col0;
#pragma unroll
                for (int bj = 0; bj < 2; ++bj) { const f32x4 v0 = acc[ai][bj][m][0], v1 = acc[ai][bj][m][1];
                    const u32x4 g = *(const u32x4*)(gate + off + bj * 128);
                    u32x4 w; w.x = cvt_pk_bf16(v0[0] * bflo(g.x), v0[1] * bfhi(g.x)); w.y = cvt_pk_bf16(v0[2] * bflo(g.y), v0[3] * bfhi(g.y));
                    w.z = cvt_pk_bf16(v1[0] * bflo(g.z), v1[1] * bfhi(g.z)); w.w = cvt_pk_bf16(v1[2] * bflo(g.w), v1[3] * bfhi(g.w));
                    *(u32x4*)(out + off + bj * 128) = w; } }
    }
};
struct EpiF {
    static constexpr bool PERM = true;
    const bf16_t* gate; const bf16_t* rp; bf16_t* out;
    __device__ __forceinline__ void operator()(const f32x4 (&acc)[2][2][4][2], const pg8::Unit& u, int wr, int wc, int fr, int fq) const {
        const int row0 = u.pm * 256 + wr * 64 + fr, col0 = u.pn * 256 + wc * 32 + 8 * fq;
#pragma unroll
        for (int ai = 0; ai < 2; ++ai)
#pragma unroll
            for (int m = 0; m < 4; ++m) { const size_t off = (size_t)(row0 + ai * 128 + m * 16) * 1024 + col0;
#pragma unroll
                for (int bj = 0; bj < 2; ++bj) { const f32x4 v0 = acc[ai][bj][m][0], v1 = acc[ai][bj][m][1];
                    const u32x4 g = *(const u32x4*)(gate + off + bj * 128), r = *(const u32x4*)(rp + off + bj * 128);
                    u32x4 w; w.x = cvt_pk_bf16(v0[0] * bflo(g.x) + bflo(r.x), v0[1] * bfhi(g.x) + bfhi(r.x)); w.y = cvt_pk_bf16(v0[2] * bflo(g.y) + bflo(r.y), v0[3] * bfhi(g.y) + bfhi(r.y));
                    w.z = cvt_pk_bf16(v1[0] * bflo(g.z) + bflo(r.z), v1[1] * bfhi(g.z) + bfhi(r.z)); w.w = cvt_pk_bf16(v1[2] * bflo(g.w) + bflo(r.w), v1[3] * bfhi(g.w) + bfhi(r.w));
                    *(u32x4*)(out + off + bj * 128) = w; } }
    }
};
struct EpiO {
    static constexpr bool PERM = false;
    const float* x; const float* mod; float* out;
    __device__ __forceinline__ void operator()(const f32x4 (&acc)[2][2][4][2], const pg8::Unit& u, int wr, int wc, int fr, int fq) const {
        const int row0 = u.pm * 256 + wr * 64 + fr, col0 = u.pn * 256 + wc * 32 + 4 * fq;
        const float* g1 = mod + (size_t)(u.pm >> 5) * 6144 + M_G1 * 1024;
        f32x4 gv[2][2];
#pragma unroll
        for (int bj = 0; bj < 2; ++bj)
#pragma unroll
            for (int n = 0; n < 2; ++n) gv[bj][n] = *(const f32x4*)(g1 + col0 + bj * 128 + n * 16);
#pragma unroll
        for (int ai = 0; ai < 2; ++ai)
#pragma unroll
            for (int m = 0; m < 4; ++m) { const size_t off = (size_t)(row0 + ai * 128 + m * 16) * 1024 + col0;
#pragma unroll
                for (int bj = 0; bj < 2; ++bj)
#pragma unroll
                    for (int n = 0; n < 2; ++n) { const f32x4 xs = *(const f32x4*)(x + off + bj * 128 + n * 16);
                        *(f32x4*)(out + off + bj * 128 + n * 16) = xs + gv[bj][n] * acc[ai][bj][m][n]; } }
    }
};

__device__ __forceinline__ void p7_route(const Params& p, Frame& F) {
    LAS bf16_t* At = (LAS bf16_t*)F.lds;
    LAS float* red = (LAS float*)(F.lds + 33792);
    LAS float* lg = (LAS float*)(F.lds + 33792 + 16384);
    LAS int* etop = (LAS int*)(F.lds + 33792 + 16384 + 2048);
    LAS int* wcnt = etop + 1024;
    const float* mod = MODP(p.ws);
    bf16_t* hn = (bf16_t*)(p.ws + WS_B0);
    const bf16_t* wr = (const bf16_t*)(p.ws + WS_WROUT);
    unsigned char* rt = p.ws + WS_ROUTE;
    unsigned char* topi = rt + RT_TOPI; float* topw = (float*)(rt + RT_TOPW); unsigned short* rankl = (unsigned short*)(rt + RT_RANK); unsigned* hist = (unsigned*)(rt + RT_HIST);
    const int fr = F.lane & 15, fq = F.lane >> 4;
    bf16x8 breg[4][2];
#pragma unroll
    for (int s = 0; s < 4; ++s)
#pragma unroll
        for (int h2 = 0; h2 < 2; ++h2) breg[s][h2] = *(const bf16x8*)(wr + (size_t)(16 * h2 + fr) * 1024 + 128 * F.wave + 32 * s + 8 * fq);
    for (int blk = F.bid; blk < T / 256; blk += F.G) {
        const int t0 = blk * 256, b = t0 / SEQ;
        const float* sc = mod + b * 6144 + M_SC2 * 1024; const float* sh = mod + b * 6144 + M_SH2 * 1024;
        for (int it = 0; it < 16; ++it) {
            const int r0 = t0 + 16 * it;
#pragma unroll
            for (int j2 = 0; j2 < 2; ++j2) {
                const int lr = 2 * F.wave + j2; const size_t row = (size_t)(r0 + lr);
                const GAS f32x4* xr = (const GAS f32x4*)(p.out + row * D) + F.lane;
                f32x4 v[4]; float s = 0.f;
#pragma unroll
                for (int j = 0; j < 4; ++j) { v[j] = xr[64 * j]; s += (v[j].x * v[j].x + v[j].y * v[j].y) + (v[j].z * v[j].z + v[j].w * v[j].w); }
                const float rs = 1.0f / sqrtf(wave_sum(s) * (1.f / D) + EPS);
                GAS unsigned long long* o8 = (GAS unsigned long long*)(hn + row * D) + F.lane;
#pragma unroll
                for (int j = 0; j < 4; ++j) { const f32x4 g = ((const f32x4*)p.norm2)[F.lane + 64 * j], a = ((const f32x4*)sc)[F.lane + 64 * j], bb = ((const f32x4*)sh)[F.lane + 64 * j];
                    const float o0 = v[j].x * rs * g.x * (1.f + a.x) + bb.x, o1 = v[j].y * rs * g.y * (1.f + a.y) + bb.y, o2 = v[j].z * rs * g.z * (1.f + a.z) + bb.z, o3 = v[j].w * rs * g.w * (1.f + a.w) + bb.w;
                    const unsigned long long w = (unsigned long long)pk2(o0, o1) | ((unsigned long long)pk2(o2, o3) << 32);
                    o8[64 * j] = w; *(LAS unsigned long long*)(At + lr * 1032 + 4 * F.lane + 256 * j) = w; }
            }
            __syncthreads();
            f32x4 a0 = {0.f, 0.f, 0.f, 0.f}, a1 = {0.f, 0.f, 0.f, 0.f};
#pragma unroll
            for (int s = 0; s < 4; ++s) { const bf16x8 af = *(const LAS bf16x8*)(At + fr * 1032 + 128 * F.wave + 32 * s + 8 * fq);
                a0 = __builtin_amdgcn_mfma_f32_16x16x32_bf16(af, breg[s][0], a0, 0, 0, 0); a1 = __builtin_amdgcn_mfma_f32_16x16x32_bf16(af, breg[s][1], a1, 0, 0, 0); }
#pragma unroll
            for (int j = 0; j < 4; ++j) { red[(F.wave * 16 + 4 * fq + j) * 32 + fr] = a0[j]; red[(F.wave * 16 + 4 * fq + j) * 32 + 16 + fr] = a1[j]; }
            __syncthreads();
            { const int row = F.tid >> 5, e = F.tid & 31; float s = p.b_router[e];
#pragma unroll
              for (int w = 0; w < 8; ++w) s += red[(w * 16 + row) * 32 + e];
              lg[row * 32 + e] = s; }
            __syncthreads();
            if (F.tid < 16) {
                const int row = F.tid; float v[4]; int ix[4]; unsigned used = 0u;
#pragma unroll
                for (int k = 0; k < 4; ++k) { float best = -3.0e38f; int bi = 0;
                    for (int e = 0; e < 32; ++e) { const float x = lg[row * 32 + e]; if (!((used >> e) & 1u) && x > best) { best = x; bi = e; } }
                    used |= 1u << bi; v[k] = best; ix[k] = bi; }
                const float e1 = __expf(v[1] - v[0]), e2 = __expf(v[2] - v[0]), e3 = __expf(v[3] - v[0]); const float inv = 1.0f / (1.0f + e1 + e2 + e3);
                const float w4[4] = {inv, e1 * inv, e2 * inv, e3 * inv};
                const size_t tok = (size_t)(r0 + row);
#pragma unroll
                for (int k = 0; k < 4; ++k) { topi[tok * 4 + k] = (unsigned char)ix[k]; topw[tok * 4 + k] = w4[k]; etop[(16 * it + row) * 4 + k] = ix[k]; }
            }
        }
        __syncthreads();
        const int a0i = 128 * F.wave + F.lane, a1i = a0i + 64; const int e0 = etop[a0i], e1 = etop[a1i]; int r0 = 0, r1 = 0;
        const unsigned long long lt = (1ull << F.lane) - 1ull;
#pragma unroll 1
        for (int e = 0; e < 32; ++e) { const unsigned long long m0 = __ballot(e0 == e), m1 = __ballot(e1 == e);
            if (e0 == e) r0 = __popcll(m0 & lt); if (e1 == e) r1 = __popcll(m0) + __popcll(m1 & lt);
            if (F.lane == 0) wcnt[F.wave * 32 + e] = __popcll(m0) + __popcll(m1); }
        __syncthreads();
        int b0 = 0, b1 = 0;
        for (int w = 0; w < F.wave; ++w) { b0 += wcnt[w * 32 + e0]; b1 += wcnt[w * 32 + e1]; }
        rankl[(size_t)t0 * 4 + a0i] = (unsigned short)(b0 + r0); rankl[(size_t)t0 * 4 + a1i] = (unsigned short)(b1 + r1);
        if (F.tid < 32) { int s = 0; for (int w = 0; w < 8; ++w) s += wcnt[w * 32 + F.tid]; hist[blk * 32 + F.tid] = (unsigned)s; }
        __syncthreads();
    }
}
__device__ __forceinline__ void p8_slots(const Params& p, Frame& F) {
    LAS int* tot = (LAS int*)F.lds; LAS int* base = tot + 32; LAS int* rup = tot + 64; LAS int* sp = tot + 96;
    unsigned char* rt = p.ws + WS_ROUTE;
    const unsigned char* topi = rt + RT_TOPI; const float* topw = (const float*)(rt + RT_TOPW); const unsigned short* rankl = (const unsigned short*)(rt + RT_RANK); const unsigned* hist = (const unsigned*)(rt + RT_HIST);
    int* slot_tok = (int*)(rt + RT_SLOTTOK); float* slot_w = (float*)(rt + RT_SLOTW); int* tok_slot = (int*)(rt + RT_TOKSLOT); int* tile_exp = (int*)(rt + RT_TILEEXP);
    unsigned* ctl = (unsigned*)(p.ws + WS_CTL);
    for (int blk = F.bid; blk < T / 256; blk += F.G) {
        const int half = blk >> 7;
        __syncthreads();
        if (F.tid < 32) { int t = 0, bs = 0; for (int b2 = half * 128; b2 < half * 128 + 128; ++b2) { const int h = (int)hist[b2 * 32 + F.tid]; if (b2 < blk) bs += h; t += h; }
            tot[F.tid] = t; base[F.tid] = bs; rup[F.tid] = (t + 255) & ~255; }
        __syncthreads();
        if (F.tid == 0) { int s = 0; for (int e = 0; e < 32; ++e) { sp[e] = s; s += rup[e]; } sp[32] = s; }
        __syncthreads();
        int* st = slot_tok + (size_t)half * PHALF; float* sw = slot_w + (size_t)half * PHALF;
#pragma unroll
        for (int q = 0; q < 2; ++q) { const int a = F.tid * 2 + q; const size_t ga = (size_t)blk * 1024 + a; const int e = topi[ga];
            const int slot = sp[e] + base[e] + (int)rankl[ga];
            st[slot] = (int)(ga >> 2); sw[slot] = topw[ga]; tok_slot[ga] = slot; }
        if ((blk & 127) == 0) {
            if (F.tid == 0) ctl[CW_NTILES + half] = (unsigned)(sp[32] >> 8);
            for (int e = 0; e < 32; ++e) {
                for (int s = sp[e] + tot[e] + F.tid; s < sp[e] + rup[e]; s += NTHREADS) { st[s] = half * HALF_T; sw[s] = 0.f; }
                for (int t = (sp[e] >> 8) + F.tid; t < ((sp[e] + rup[e]) >> 8); t += NTHREADS) tile_exp[half * 1024 + t] = e;
            }
        }
    }
}
struct SchedG1 {
    const char* hn; const char* wgu; const int* slot_tok; const int* tile_exp; int ntiles, G, c;
    __device__ __forceinline__ bool next(int i, pg8::Unit& u) const {
        const long L = (long)i * G + c; int pm, pn; if (!pg8::tile_order(L, ntiles, 8, pm, pn)) return false;
        const int e = tile_exp[pm]; u.pm = pm; u.pn = pn; u.aux = e; u.A = hn; u.B = wgu + ((size_t)e * 2048 + (size_t)pn * 256) * 2048; return true;
    }
    __device__ __forceinline__ int row(const pg8::Unit& u, int r) const { return slot_tok[u.pm * 256 + r]; }
};
struct EpiG1 {
    static constexpr bool PERM = true;
    const float* b_gu; bf16_t* act;
    __device__ __forceinline__ void operator()(const f32x4 (&acc)[2][2][4][2], const pg8::Unit& u, int wr, int wc, int fr, int fq) const {
        const int row0 = u.pm * 256 + wr * 64 + fr, col0 = u.pn * 128 + wc * 32 + 8 * fq;
        const float* bg = b_gu + (size_t)u.aux * 2048 + col0;
        const f32x4 bg0 = *(const f32x4*)bg, bg1 = *(const f32x4*)(bg + 4), bu0 = *(const f32x4*)(bg + 1024), bu1 = *(const f32x4*)(bg + 1028);
#pragma unroll
        for (int ai = 0; ai < 2; ++ai)
#pragma unroll
            for (int m = 0; m < 4; ++m) {
                const f32x4 g0 = acc[ai][0][m][0] + bg0, g1 = acc[ai][0][m][1] + bg1, u0 = acc[ai][1][m][0] + bu0, u1 = acc[ai][1][m][1] + bu1;
                float o[8];
#pragma unroll
                for (int j = 0; j < 4; ++j) { const float ga = fminf(g0[j], 7.0f), gb = fminf(g1[j], 7.0f); const float ua = fminf(fmaxf(u0[j], -7.0f), 7.0f), ub = fminf(fmaxf(u1[j], -7.0f), 7.0f);
                    o[j] = (ua + 1.0f) * ga * fast_sigmoid(1.702f * ga); o[4 + j] = (ub + 1.0f) * gb * fast_sigmoid(1.702f * gb); }
                u32x4 w; w.x = cvt_pk_bf16(o[0], o[1]); w.y = cvt_pk_bf16(o[2], o[3]); w.z = cvt_pk_bf16(o[4], o[5]); w.w = cvt_pk_bf16(o[6], o[7]);
                *(u32x4*)(act + (size_t)(row0 + ai * 128 + m * 16) * 1024 + col0) = w; }
    }
};
struct SchedG2 {
    const char* act; const char* wd; const int* tile_exp; int ntiles, G, c;
    __device__ __forceinline__ bool next(int i, pg8::Unit& u) const {
        const long L = (long)i * G + c; int pm, pn; if (!pg8::tile_order(L, ntiles, 4, pm, pn)) return false;
        const int e = tile_exp[pm]; u.pm = pm; u.pn = pn; u.aux = e; u.A = act + (size_t)pm * 256 * 2048; u.B = wd + ((size_t)e * 1024 + (size_t)pn * 256) * 2048; return true;
    }
};
struct EpiG2 {
    static constexpr bool PERM = true;
    const float* b_down; const float* slot_w; bf16_t* outa;
    __device__ __forceinline__ void operator()(const f32x4 (&acc)[2][2][4][2], const pg8::Unit& u, int wr, int wc, int fr, int fq) const {
        const int row0 = u.pm * 256 + wr * 64 + fr, col0 = u.pn * 256 + wc * 32 + 8 * fq;
        const float* bd = b_down + (size_t)u.aux * 1024 + col0;
        f32x4 bv[2][2];
#pragma unroll
        for (int bj = 0; bj < 2; ++bj) { bv[bj][0] = *(const f32x4*)(bd + bj * 128); bv[bj][1] = *(const f32x4*)(bd + bj * 128 + 4); }
#pragma unroll
        for (int ai = 0; ai < 2; ++ai)
#pragma unroll
            for (int m = 0; m < 4; ++m) { const int row = row0 + ai * 128 + m * 16; const float sw = slot_w[row];
#pragma unroll
                for (int bj = 0; bj < 2; ++bj) { const f32x4 v0 = (acc[ai][bj][m][0] + bv[bj][0]) * sw, v1 = (acc[ai][bj][m][1] + bv[bj][1]) * sw;
                    u32x4 w; w.x = cvt_pk_bf16(v0[0], v0[1]); w.y = cvt_pk_bf16(v0[2], v0[3]); w.z = cvt_pk_bf16(v1[0], v1[1]); w.w = cvt_pk_bf16(v1[2], v1[3]);
                    *(u32x4*)(outa + (size_t)row * 1024 + col0 + bj * 128) = w; } }
    }
};
__device__ __forceinline__ void p11_combine(const Params& p, Frame& F, int half) {
    const float* mod = MODP(p.ws); const int* tok_slot = (const int*)(p.ws + WS_ROUTE + RT_TOKSLOT); const bf16_t* outa = (const bf16_t*)(p.ws + WS_OUTA);
    const int gw = F.bid * NWAVES + F.wave, ngw = F.G * NWAVES;
    for (int m = half * HALF_T + gw; m < (half + 1) * HALF_T; m += ngw) {
        const float* g2 = mod + (size_t)(m / SEQ) * 6144 + M_G2 * 1024;
        const int s0 = tok_slot[m * 4 + 0], s1 = tok_slot[m * 4 + 1], s2 = tok_slot[m * 4 + 2], s3 = tok_slot[m * 4 + 3];
        GAS f32x4* xr = (GAS f32x4*)(p.out + (size_t)m * D) + F.lane;
        f32x4 v[4]; float ss = 0.f;
#pragma unroll
        for (int j = 0; j < 4; ++j) {
            const u32x2 a = *(const u32x2*)(outa + (size_t)s0 * 1024 + 4 * F.lane + 256 * j), b = *(const u32x2*)(outa + (size_t)s1 * 1024 + 4 * F.lane + 256 * j),
                        c = *(const u32x2*)(outa + (size_t)s2 * 1024 + 4 * F.lane + 256 * j), d = *(const u32x2*)(outa + (size_t)s3 * 1024 + 4 * F.lane + 256 * j);
            f32x4 y; y.x = (bflo(a.x) + bflo(b.x)) + (bflo(c.x) + bflo(d.x)); y.y = (bfhi(a.x) + bfhi(b.x)) + (bfhi(c.x) + bfhi(d.x));
            y.z = (bflo(a.y) + bflo(b.y)) + (bflo(c.y) + bflo(d.y)); y.w = (bfhi(a.y) + bfhi(b.y)) + (bfhi(c.y) + bfhi(d.y));
            const f32x4 g = ((const f32x4*)g2)[F.lane + 64 * j];
            v[j] = xr[64 * j] + g * y; ss += (v[j].x * v[j].x + v[j].y * v[j].y) + (v[j].z * v[j].z + v[j].w * v[j].w); }
        const float rs = 1.0f / sqrtf(wave_sum(ss) * (1.f / D) + EPS);
#pragma unroll
        for (int j = 0; j < 4; ++j) { const f32x4 nf = ((const f32x4*)p.norm_f)[F.lane + 64 * j]; xr[64 * j] = v[j] * rs * nf; }
    }
}

constexpr int NPHASES = 16;
__global__ void __launch_bounds__(NTHREADS, 2) fwd_kernel(Params p) {
    extern __shared__ __attribute__((aligned(16))) unsigned char lds_raw[];
    Frame F; F.lds = (LAS unsigned char*)lds_raw; F.tid = threadIdx.x; F.lane = F.tid & 63; F.wave = __builtin_amdgcn_readfirstlane(F.tid >> 6); F.G = gridDim.x; F.bid = blockIdx.x;
    volatile LAS unsigned* misc = (volatile LAS unsigned*)(F.lds + LDS_MISC);
    if (F.tid < 64) misc[F.tid] = 0u;
    __syncthreads();
    unsigned char* ws = p.ws;
    unsigned* ctl = (unsigned*)(ws + WS_CTL);
    const int lo = p.ph_lo, hi = p.ph_hi;
    XcdBarrier bar; bar.bar = ctl + CW_BAR; bar.x = 0; bar.st = nullptr;
    if (hi - lo > 1) bar = xcd_barrier_post(ctl + CW_BAR, misc + 8);
#ifdef ONLY_PHASE
#define IN(k) ((k) == ONLY_PHASE && lo <= (k) && (k) < hi)
#else
#define IN(k) (lo <= (k) && (k) < hi)
#endif
#define SEAM(k) do { if (IN(k) && IN((k) + 1)) xcd_barrier(bar); } while (0)
#define PH() do { int t_ = threadIdx.x; asm volatile("" : "+v"(t_)); F.tid = t_; F.lane = t_ & 63; F.wave = __builtin_amdgcn_readfirstlane(t_ >> 6); ws = p.ws; asm volatile("" : "+s"(ws)); } while (0)

    if (IN(0)) { PH(); p0_ada(p, F); p0_weights(p, F); }
    SEAM(0);
    if (IN(1)) { PH(); p1_norm(p, F); }
    SEAM(1);
    if (IN(2)) { PH();
        Sched2 S{(const char*)(ws + WS_B0), (const char*)(ws + WS_WCAT), F.G, F.bid}; Epi2 E{ws};
        pg8::gemm_phase<Epi2, Sched2, false>(F.lds, S, E, 16, 2048u, 2048u);
    }
    SEAM(2);
    if (IN(3)) { PH();
#if RNN_FAST
        p3_rnn_fast(p, F);
#if DFT_FAST
        dft_fast<0, 1>(p, F);
#else
        p3_dftA_naive(p, F, F.bid, F.G);
#endif
#else
        if (F.G > 128) { if (F.bid < 128) p3_rnn_naive(p, F); else p3_dftA_naive(p, F, F.bid - 128, F.G - 128); }
        else { p3_rnn_naive(p, F); p3_dftA_naive(p, F, F.bid, F.G); }
#endif
    }
    SEAM(3);
    if (IN(4)) { PH();
#if RNN_FAST
        p3c_carries(p, F);
#endif
    }
    SEAM(4);
    if (IN(5)) { PH();
#if DFT_FAST
        dft_fast<1, 1>(p, F);
#else
        p4_dftB_naive(p, F);
#endif
#if RNN_FAST
        p4_yg_fast(p, F);
#else
        p4_yg_naive(p, F);
#endif
    }
    SEAM(5);
    if (IN(6)) { PH();
        { SchedPlain S{(const char*)(ws + WS_B2), (const char*)(ws + WS_WR), 2048, 2048, 256, 4, F.G, F.bid};
          EpiR E{(const bf16_t*)(ws + WS_B5), (bf16_t*)(ws + WS_B0)};
          pg8::gemm_phase<EpiR, SchedPlain, false>(F.lds, S, E, 16, 2048u, 2048u); }
        { SchedPlain S{(const char*)(ws + WS_B7), (const char*)(ws + WS_WF), 1024, 1024, 256, 4, F.G, F.bid};
          EpiF E{(const bf16_t*)(ws + WS_B4), (const bf16_t*)(ws + WS_B0), (bf16_t*)(ws + WS_B1)};
          pg8::gemm_phase<EpiF, SchedPlain, false>(F.lds, S, E, 8, 1024u, 1024u); }
    }
    SEAM(6);
    if (IN(7)) { PH();
        SchedPlain S{(const char*)(ws + WS_B1), (const char*)(ws + WS_WO), 2048, 2048, 256, 4, F.G, F.bid};
        EpiO E{p.x, MODP(ws), p.out};
        pg8::gemm_phase<EpiO, SchedPlain, false>(F.lds, S, E, 16, 2048u, 2048u);
    }
    SEAM(7);
    if (IN(8)) { PH(); p7_route(p, F); p_moe_weights(p, F); }
    SEAM(8);
    if (IN(9)) { PH(); p8_slots(p, F); }
    SEAM(9);
#pragma unroll 1
    for (int half = 0; half < 2; ++half) {
        const int pb = 10 + 3 * half;
        const int* slot_tok = (const int*)(ws + WS_ROUTE + RT_SLOTTOK) + (size_t)half * PHALF;
        const float* slot_w = (const float*)(ws + WS_ROUTE + RT_SLOTW) + (size_t)half * PHALF;
        const int* tile_exp = (const int*)(ws + WS_ROUTE + RT_TILEEXP) + half * 1024;
        if (IN(pb)) { PH();
            const int ntiles = (int)ctl[CW_NTILES + half];
            SchedG1 S{(const char*)(ws + WS_B0), (const char*)(ws + WS_WGU), slot_tok, tile_exp, ntiles, F.G, F.bid};
            EpiG1 E{p.b_gu, (bf16_t*)(ws + WS_ACT)};
            pg8::gemm_phase<EpiG1, SchedG1, true>(F.lds, S, E, 16, 2048u, 2048u);
        }
        SEAM(pb);
        if (IN(pb + 1)) { PH();
            const int ntiles = (int)ctl[CW_NTILES + half];
            SchedG2 S{(const char*)(ws + WS_ACT), (const char*)(ws + WS_WD), tile_exp, ntiles, F.G, F.bid};
            EpiG2 E{p.b_down, slot_w, (bf16_t*)(ws + WS_OUTA)};
            pg8::gemm_phase<EpiG2, SchedG2, false>(F.lds, S, E, 16, 2048u, 2048u);
        }
        SEAM(pb + 1);
        if (IN(pb + 2)) { PH(); p11_combine(p, F, half); }
        SEAM(pb + 2);
    }
#undef IN
#undef SEAM
}

extern "C" void kernel_launch(void* const* d_in, const int* in_sizes, int n_in, void* d_out, int out_size, void* d_ws, size_t ws_size, hipStream_t stream) {
    static int grid = 0;
    if (grid == 0) {
        if (n_in != 26 || out_size != T * D || ws_size < WS_END) { fprintf(stderr, "kernel_launch: unexpected shapes (n_in %d out %d ws %zu)\n", n_in, out_size, ws_size); grid = -1; return; }
        int dev = 0, cus = 0, per_cu = 0;
        if (hipGetDevice(&dev) != hipSuccess || hipDeviceGetAttribute(&cus, hipDeviceAttributeMultiprocessorCount, dev) != hipSuccess) { grid = -1; return; }
        if (hipFuncSetAttribute((const void*)fwd_kernel, hipFuncAttributeMaxDynamicSharedMemorySize, LDS_BYTES) != hipSuccess) { fprintf(stderr, "kernel_launch: hipFuncSetAttribute failed\n"); grid = -1; return; }
        if (hipOccupancyMaxActiveBlocksPerMultiprocessor(&per_cu, (const void*)fwd_kernel, NTHREADS, LDS_BYTES) != hipSuccess || per_cu < 1) { fprintf(stderr, "kernel_launch: occupancy query says %d\n", per_cu); }
        (void)hipGetLastError();
        grid = cus > 256 ? 256 : cus;
    }
    if (grid < 0) return;
    (void)hipMemsetAsync((char*)d_ws + WS_CTL, 0, CTL_BYTES, stream);
    Params p{};
    const float** f = (const float**)&p;
    for (int i = 0; i < 26; ++i) f[i] = (const float*)d_in[i];
    p.out = (float*)d_out; p.ws = (unsigned char*)d_ws;
#if SPLIT_LAUNCH
    for (int k = 0; k < NPHASES; ++k) { p.ph_lo = k; p.ph_hi = k + 1; hipLaunchKernelGGL(fwd_kernel, dim3(grid), dim3(NTHREADS), LDS_BYTES, stream, p); }
#else
    p.ph_lo = 0; p.ph_hi = NPHASES;
    hipLaunchKernelGGL(fwd_kernel, dim3(grid), dim3(NTHREADS), LDS_BYTES, stream, p);
#endif
}
```

```cpp
#include <hip/hip_runtime.h>
#include <cstdio>
#include <cstdint>

#ifndef SPLIT_LAUNCH
#define SPLIT_LAUNCH 0
#endif

#define SPLIT_P3 1
#ifndef PROBE_MULT
#define PROBE_MULT 4
#endif
#ifdef PROBE_SEL
#define PT_LDS ((volatile LAS unsigned long long*)((LAS unsigned char*)0 + LDS_MISC + 96))
#define PT_BEGIN() do { if (threadIdx.x == 0) PT_LDS[0] = __builtin_amdgcn_s_memrealtime(); } while (0)
#define PT_END(sel) do { if ((sel) == PROBE_SEL && threadIdx.x == 0) PT_LDS[1] += __builtin_amdgcn_s_memrealtime() - PT_LDS[0]; } while (0)
#else
#define PT_BEGIN() do { } while (0)
#define PT_END(sel) do { } while (0)
#endif
#ifdef PROBE_SEL
#define PSTAMP(sel, expr) do { const unsigned long long t_ = __builtin_amdgcn_s_memrealtime(); expr; if ((sel) == PROBE_SEL) F.pacc += __builtin_amdgcn_s_memrealtime() - t_; } while (0)
#else
#define PSTAMP(sel, expr) do { expr; } while (0)
#endif
#ifndef GATES_F8
#define GATES_F8 1
#endif
#ifndef UNFOLD_CH
#define UNFOLD_CH 1
#endif
#ifndef RNN_FAST
#define RNN_FAST 1
#endif
#ifndef DFT_FAST
#define DFT_FAST 1
#endif
#define GAS __attribute__((address_space(1)))
#define LAS __attribute__((address_space(3)))
typedef unsigned short bf16_t;
typedef short bf16x8 __attribute__((ext_vector_type(8)));
typedef float f32x4 __attribute__((ext_vector_type(4)));
typedef float f32x2 __attribute__((ext_vector_type(2)));
typedef unsigned u32x4 __attribute__((ext_vector_type(4)));
typedef unsigned u32x2 __attribute__((ext_vector_type(2)));

constexpr int D = 1024, NB = 8, SEQ = 8192, T = NB * SEQ, CTXL = 256, TC = NB * CTXL, MT = T + TC;
constexpr int DIN = 4608, NCAT = 5120;
constexpr int NE = 32, TOPK = 4, DE = 1024;
constexpr float EPS = 1e-6f;
constexpr int HALF_T = T / 2;
constexpr int PHALF = HALF_T * TOPK + NE * 256;

constexpr size_t MiB = 1u << 20;
constexpr size_t WS_CTL = 0, CTL_BYTES = 1 * MiB;
constexpr size_t WS_MOD = 1 * MiB;
constexpr size_t WS_SPL = 1 * MiB + 256 * 1024;
constexpr size_t WS_DFTM = 1 * MiB + 512 * 1024;
constexpr size_t WS_WCAT = 2 * MiB;
constexpr size_t WS_WF = 12 * MiB;
constexpr size_t WS_WR = 13 * MiB;
constexpr size_t WS_WO = 15 * MiB;
constexpr size_t WS_GW = 17 * MiB;
constexpr size_t WS_WROUT = 18 * MiB;
constexpr size_t WS_AGG = 19 * MiB;
constexpr size_t WS_ROUTE = 26 * MiB;
constexpr size_t WS_B0 = 32 * MiB;
constexpr size_t WS_B1 = 164 * MiB;
constexpr size_t WS_B2 = 292 * MiB;
constexpr size_t WS_B3 = 424 * MiB;
constexpr size_t WS_B4 = 552 * MiB;
constexpr size_t WS_B5 = 680 * MiB;
constexpr size_t WS_B6 = 808 * MiB;
constexpr size_t WS_B7 = 936 * MiB;
constexpr size_t WS_WGU = 164 * MiB;
constexpr size_t WS_WD = 228 * MiB;
constexpr size_t WS_HN8S = 260 * MiB;
constexpr size_t WS_ACT = 532 * MiB;
constexpr size_t WS_OUTA = 668 * MiB;
constexpr size_t WS_END = 1000 * MiB;
static_assert((size_t)PHALF * 2048 <= 272 * MiB, "act capacity");
static_assert(WS_HN8S + (size_t)2 * PHALF * 1024 == WS_ACT && WS_ACT + (size_t)PHALF * 1024 == WS_OUTA, "half-1 overlays: act(1) = HN8S half 0, outa(1) = [HN8S half 1 | ACT]");
constexpr size_t RT_TOPI = 0;
constexpr size_t RT_TOPW = 256 * 1024;
constexpr size_t RT_RANK = RT_TOPW + 1 * MiB;
constexpr size_t RT_HIST = RT_RANK + 512 * 1024;
constexpr size_t RT_SLOTTOK = RT_HIST + 32 * 1024;
constexpr size_t RT_SLOTW = RT_SLOTTOK + 1152 * 1024;
constexpr size_t RT_TOKSLOT = RT_SLOTW + 1152 * 1024;
constexpr size_t RT_TILEEXP = RT_TOKSLOT + 1 * MiB;
constexpr size_t RT_END = RT_TILEEXP + 8192;
static_assert(RT_END <= 6 * MiB, "route tables");
constexpr int CW_NTILES = 16;
constexpr int CW_BAR = 4096;

constexpr int NWAVES = 8, NTHREADS = 512;
constexpr int LDS_BYTES = 155648;
constexpr int LDS_MISC = 151552;

__device__ __forceinline__ unsigned f2bf(float f) { unsigned u = __builtin_bit_cast(unsigned, f); return (u + 0x7fffu + ((u >> 16) & 1u)) >> 16; }
typedef __bf16 bf16x2_t __attribute__((ext_vector_type(2)));
__device__ __forceinline__ unsigned cvt_pk_bf16(float lo, float hi) { const f32x2 v = {lo, hi}; return __builtin_bit_cast(unsigned, __builtin_convertvector(v, bf16x2_t)); }
__device__ __forceinline__ unsigned pk2(float lo, float hi) { return cvt_pk_bf16(lo, hi); }
__device__ __forceinline__ float bf2f(unsigned short b) { return __builtin_bit_cast(float, (unsigned)b << 16); }
__device__ __forceinline__ float bflo(unsigned w) { return __builtin_bit_cast(float, w << 16); }
__device__ __forceinline__ float bfhi(unsigned w) { return __builtin_bit_cast(float, w & 0xffff0000u); }
__device__ __forceinline__ float fast_sigmoid(float x) { return __builtin_amdgcn_rcpf(1.0f + __builtin_amdgcn_exp2f(-1.44269504f * x)); }
__device__ __forceinline__ float wave_sum(float v, int lane) {
#pragma unroll
    for (int o = 1; o < 64; o <<= 1) v += __builtin_bit_cast(float, __builtin_amdgcn_ds_bpermute((lane ^ o) << 2, __builtin_bit_cast(int, v)));
    return v;
}

namespace pg8 {
constexpr int BM = 256, BK = 64, HALF = 128, HTB = HALF * BK * 2, STAGE_BYTES = 8 * HTB, NXCD = 8, WGM = 8;
__host__ __device__ __forceinline__ int lds_byte(int r, int chunk) { return r * 128 + ((chunk ^ ((r >> 1) & 7)) << 4); }
__host__ __device__ __forceinline__ void stage_rc(int b, int& R, int& C) { R = b >> 7; C = ((((b >> 4) & 7) ^ ((R >> 1) & 7))) * 8; }
__host__ __device__ __forceinline__ int perm32(int rho) { const int n = rho >> 4, i = rho & 15; return 8 * (i >> 2) + 4 * n + (i & 3); }

struct Unit { int pm, pn, aux; unsigned A; unsigned B; };

__device__ __forceinline__ bool tile_order(long L, int nM, int nN, int& pm, int& pn) {
    const int nwg = nM * nN; if (L >= nwg) return false;
    int wgid = (int)L; { const int q = nwg / NXCD, r = nwg % NXCD, xcd = wgid % NXCD, off = wgid / NXCD; wgid = (xcd < r ? xcd * (q + 1) : r * (q + 1) + (xcd - r) * q) + off; }
    const int nig = WGM * nN, gid = wgid / nig, fm = gid * WGM, gsz = (nM - fm) < WGM ? (nM - fm) : WGM;
    pm = fm + ((wgid % nig) % gsz); pn = (wgid % nig) / gsz; return true;
}

typedef int v8i32 __attribute__((ext_vector_type(8)));
typedef unsigned u32x8 __attribute__((ext_vector_type(8)));
template <bool F8> struct FragT { typedef bf16x8 type; };
template <> struct FragT<true> { typedef u32x8 type; };
template <class Epi, class Sched, bool GATHER, bool F8 = false, int DRY = 0>
__device__ __forceinline__ void gemm_phase(LAS unsigned char* lds, int tid_, const Sched& S, const Epi& E, const int nt, const unsigned lda, const unsigned ldb, const void* baseA, const void* baseB) {
    asm volatile("" : "+v"(tid_));
    const int tid = tid_, wid = __builtin_amdgcn_readfirstlane(tid >> 6), lane = tid & 63, wr = wid >> 2, wc = wid & 3, fr = lane & 15, fq = lane >> 4;
    const __amdgpu_buffer_rsrc_t rsA = __builtin_amdgcn_make_buffer_rsrc(const_cast<void*>(baseA), 0, -1, 0x00020000);
    const __amdgpu_buffer_rsrc_t rsB = __builtin_amdgcn_make_buffer_rsrc(const_cast<void*>(baseB), 0, -1, 0x00020000);
    unsigned voffA0, voffB0; int RA0;
    { int R, C; stage_rc(tid * 16, R, C); const int Rb = Epi::PERM ? ((R & ~31) + perm32(R & 31)) : R; RA0 = R;
      voffB0 = (unsigned)Rb * ldb + (unsigned)C * 2u; voffA0 = GATHER ? (unsigned)C * 2u : (unsigned)R * lda + (unsigned)C * 2u; }
    const unsigned p1A = GATHER ? 0u : 64u * lda, p1B = 64u * ldb;
    LAS unsigned* gtab = (LAS unsigned*)(lds + STAGE_BYTES);
    LAS float* etab = (LAS float*)(lds + STAGE_BYTES + 2048);
    const unsigned kstep = (unsigned)(BK * 2);
    const unsigned hstepB = (unsigned)HALF * ldb, hstepA = GATHER ? 0u : (unsigned)HALF * lda;
    const unsigned ldsw = (unsigned)wid * 1024u;
    int aoffk[2], boffk[2];
#pragma unroll
    for (int k = 0; k < 2; ++k) { aoffk[k] = lds_byte(wr * 64 + fr, 4 * k + fq); boffk[k] = lds_byte(wc * 32 + fr, 4 * k + fq); }
    constexpr int NKF = F8 ? 1 : 2;
    using Frag = typename FragT<F8>::type;
#define PG8_SA(b, h) (((b) * 2 + (h)) * HTB)
#define PG8_SB(b, h) ((4 + (b) * 2 + (h)) * HTB)
#define PG8_STAGE2(rs, bufoff, soff, o0, o1, p1) do { if constexpr (!(DRY & 4)) { \
        __builtin_amdgcn_raw_ptr_buffer_load_lds(rs, (LAS void*)(lds + (bufoff) + ldsw), 16, (int)(o0), (int)(soff), 0, 0); \
        __builtin_amdgcn_raw_ptr_buffer_load_lds(rs, (LAS void*)(lds + (bufoff) + ldsw + 8192), 16, (int)(o1), (int)((soff) + (p1)), 0, 0); } } while (0)
#define PG8_STAGE_B(bufoff, soff) PG8_STAGE2(rsB, bufoff, soff, voffB0, voffB0, p1B)
#define PG8_GO(par, hh, i) (gtab[(par) * 256 + (hh) * HALF + RA0 + 64 * (i)] + voffA0)
#define PG8_STAGE_A(bufoff, soff, hh) do { if constexpr (GATHER) PG8_STAGE2(rsA, bufoff, soff, PG8_GO(ui & 1, hh, 0), PG8_GO(ui & 1, hh, 1), 0u); \
        else PG8_STAGE2(rsA, bufoff, (soff) + (hh) * hstepA, voffA0, voffA0, p1A); } while (0)
#define PG8_STAGE_AN(bufoff, soff, hh, usenext) do { if constexpr (GATHER) { const int par_ = ((usenext) ? ui + 1 : ui) & 1; PG8_STAGE2(rsA, bufoff, soff, PG8_GO(par_, hh, 0), PG8_GO(par_, hh, 1), 0u); } \
        else PG8_STAGE2(rsA, bufoff, (soff) + (hh) * hstepA, voffA0, voffA0, p1A); } while (0)
#define PG8_RD(addr) (*(const LAS bf16x8*)(addr))
#define PG8_RD8(a0, a1) __builtin_bit_cast(Frag, __builtin_shufflevector(*(const LAS u32x4*)(a0), *(const LAS u32x4*)(a1), 0, 1, 2, 3, 4, 5, 6, 7))
#define PG8_LDA(dst, b, h) do { if constexpr (!(DRY & 1)) _Pragma("unroll") for (int m = 0; m < 4; ++m) _Pragma("unroll") for (int k = 0; k < NKF; ++k) { \
        if constexpr (F8) dst[m][k] = PG8_RD8(lds + PG8_SA(b, h) + aoffk[0] + m * 2048, lds + PG8_SA(b, h) + aoffk[1] + m * 2048); else dst[m][k] = __builtin_bit_cast(Frag, PG8_RD(lds + PG8_SA(b, h) + aoffk[k] + m * 2048)); } } while (0)
#define PG8_LDB(dst, b, h) do { if constexpr (!(DRY & 1)) _Pragma("unroll") for (int n = 0; n < 2; ++n) _Pragma("unroll") for (int k = 0; k < NKF; ++k) { \
        if constexpr (F8) dst[n][k] = PG8_RD8(lds + PG8_SB(b, h) + boffk[0] + n * 2048, lds + PG8_SB(b, h) + boffk[1] + n * 2048); else dst[n][k] = __builtin_bit_cast(Frag, PG8_RD(lds + PG8_SB(b, h) + boffk[k] + n * 2048)); } } while (0)
#define PG8_MMA(ai, bj, At, Bt) do { __builtin_amdgcn_s_setprio(1); if constexpr (!(DRY & 2)) _Pragma("unroll") for (int m = 0; m < 4; ++m) _Pragma("unroll") for (int n = 0; n < 2; ++n) _Pragma("unroll") for (int k = 0; k < NKF; ++k) { \
        if constexpr (F8) acc[ai][bj][m][n] = __builtin_amdgcn_mfma_scale_f32_16x16x128_f8f6f4(__builtin_bit_cast(v8i32, Bt[n][k]), __builtin_bit_cast(v8i32, At[m][k]), acc[ai][bj][m][n], 0, 0, 0, 127, 0, 127); \
        else acc[ai][bj][m][n] = __builtin_amdgcn_mfma_f32_16x16x32_bf16(__builtin_bit_cast(bf16x8, Bt[n][k]), __builtin_bit_cast(bf16x8, At[m][k]), acc[ai][bj][m][n], 0, 0, 0); } __builtin_amdgcn_s_setprio(0); } while (0)
#define PG8_WAIT_V(n) asm volatile("s_waitcnt vmcnt(" #n ")" ::: "memory")
#define PG8_WAIT_L(n) asm volatile("s_waitcnt lgkmcnt(" #n ")" ::: "memory")
#define PG8_BAR __builtin_amdgcn_s_barrier()
#define PG8_SCHED __builtin_amdgcn_sched_barrier(0)
    Unit cur, nxt; int ui = 0;
    if (!S.next(0, cur)) return;
    if constexpr (GATHER) {
        if (tid < 256) gtab[tid] = (unsigned)S.row(cur, tid) * lda;
        asm volatile("s_waitcnt lgkmcnt(0)" ::: "memory"); __builtin_amdgcn_s_barrier();
    }
    f32x4 acc[2][2][4][2];
#pragma unroll
    for (int a = 0; a < 2; ++a)
#pragma unroll
        for (int b = 0; b < 2; ++b)
#pragma unroll
            for (int m = 0; m < 4; ++m)
#pragma unroll
                for (int n = 0; n < 2; ++n) acc[a][b][m][n] = (f32x4){0.f, 0.f, 0.f, 0.f};
    Frag At[4][NKF], B0[2][NKF], B1[2][NKF];
    if constexpr (DRY & 1) { _Pragma("unroll") for (int m = 0; m < 4; ++m) _Pragma("unroll") for (int k = 0; k < NKF; ++k) { At[m][k] = Frag{}; if (m < 2) { B0[m][k] = Frag{}; B1[m][k] = Frag{}; } } }
    unsigned cA = cur.A, cB = cur.B;
    PG8_STAGE_B(PG8_SB(0, 0), cB); PG8_STAGE_B(PG8_SB(0, 1), cB + hstepB); PG8_STAGE_A(PG8_SA(0, 0), cA, 0); PG8_STAGE_A(PG8_SA(0, 1), cA, 1);
    if (wr == 1) PG8_BAR;
    PG8_WAIT_V(2); PG8_BAR;
    PG8_STAGE_B(PG8_SB(1, 0), cB + kstep); PG8_STAGE_A(PG8_SA(1, 0), cA + kstep, 0); PG8_STAGE_B(PG8_SB(1, 1), cB + hstepB + kstep);
    PG8_WAIT_V(6); PG8_BAR;
    for (;;) {
        const bool has_next = S.next(ui + 1, nxt);
        const unsigned nA = has_next ? nxt.A : cA, nB = has_next ? nxt.B : cB;
        if constexpr (Sched::EVEC) { int ti = tid; asm volatile("" : "+v"(ti)); etab[(ui & 1) * 512 + ti] = S.evec(cur, ti); }
        if constexpr (GATHER) {
            if (tid < 256) gtab[((ui + 1) & 1) * 256 + tid] = has_next ? (unsigned)S.row(nxt, tid) * lda : gtab[(ui & 1) * 256 + tid];
        }
        if constexpr (!F8) PT_BEGIN();
#pragma unroll 1
        for (int t = 0; t < nt; t += 2) {
            const bool last = (t == nt - 2);
            const unsigned a1 = cA + (unsigned)(t + 1) * kstep;
            const unsigned a2 = last ? nA : cA + (unsigned)(t + 2) * kstep, b2 = last ? nB : cB + (unsigned)(t + 2) * kstep;
            const unsigned a3 = a2 + kstep, b3 = b2 + kstep;
            const bool un = GATHER && last;
            PG8_LDB(B0, 0, 0); PG8_LDB(B1, 0, 1); PG8_SCHED; PG8_LDA(At, 0, 0); PG8_STAGE_A(PG8_SA(1, 1), a1, 1);
            PG8_WAIT_V(8); PG8_WAIT_L(0); PG8_BAR; PG8_MMA(0, 0, At, B0); PG8_MMA(0, 1, At, B1); PG8_BAR; PG8_SCHED;
            PG8_LDA(At, 0, 1); PG8_STAGE_B(PG8_SB(0, 0), b2); PG8_STAGE_B(PG8_SB(0, 1), b2 + hstepB); PG8_STAGE_AN(PG8_SA(0, 0), a2, 0, un);
            PG8_WAIT_V(8); PG8_WAIT_L(0); PG8_BAR; PG8_MMA(1, 0, At, B0); PG8_MMA(1, 1, At, B1); PG8_BAR; PG8_SCHED;
            PG8_LDB(B0, 1, 0); PG8_LDB(B1, 1, 1); PG8_SCHED; PG8_LDA(At, 1, 0); PG8_STAGE_AN(PG8_SA(0, 1), a2, 1, un);
            PG8_WAIT_V(8); PG8_WAIT_L(0); PG8_BAR; PG8_MMA(0, 0, At, B0); PG8_MMA(0, 1, At, B1); PG8_BAR; PG8_SCHED;
            PG8_LDA(At, 1, 1); PG8_STAGE_B(PG8_SB(1, 0), b3); PG8_STAGE_B(PG8_SB(1, 1), b3 + hstepB); PG8_STAGE_AN(PG8_SA(1, 0), a3, 0, un);
            PG8_WAIT_V(8); PG8_WAIT_L(0); PG8_BAR; PG8_MMA(1, 0, At, B0); PG8_MMA(1, 1, At, B1); PG8_BAR; PG8_SCHED;
        }
        if constexpr (!F8) PT_END(10);
        if (wr == 0) PG8_BAR;
        { int t2 = tid; asm volatile("" : "+v"(t2));
          E(acc, cur, wr, wc, t2 & 15, (t2 & 63) >> 4, etab + (ui & 1) * 512); }
        if (!has_next) break;
#pragma unroll
        for (int a = 0; a < 2; ++a)
#pragma unroll
            for (int b = 0; b < 2; ++b)
#pragma unroll
                for (int m = 0; m < 4; ++m)
#pragma unroll
                    for (int n = 0; n < 2; ++n) acc[a][b][m][n] = (f32x4){0.f, 0.f, 0.f, 0.f};
        cur = nxt; cA = nA; cB = nB; ++ui;
        if (wr == 1) PG8_BAR;
    }
    PG8_WAIT_V(0);
    PG8_BAR;
#undef PG8_SA
#undef PG8_SB
#undef PG8_STAGE2
#undef PG8_STAGE_A
#undef PG8_STAGE_AN
#undef PG8_GO
#undef PG8_STAGE_B
#undef PG8_LDA
#undef PG8_LDB
#undef PG8_MMA
#undef PG8_RD
#undef PG8_RD8
#undef PG8_WAIT_V
#undef PG8_WAIT_L
#undef PG8_BAR
#undef PG8_SCHED
}
}

#define XB_TMO      128
#define XB_XCNT(j)  (256  + 64 * (j))
#define XB_XSUB(j)  (1280 + 64 * (j))
#define XB_XGEN(j)  (2304 + 64 * (j))
#define XB_TOP      3328
#define XB_TOPGEN   3392
#define XCD_BAR_WORDS 3456
#define XB_SPIN_CAP (1u << 22)

__device__ __forceinline__ unsigned xb_ld(unsigned* p)              { return __hip_atomic_load(p, __ATOMIC_RELAXED, __HIP_MEMORY_SCOPE_AGENT); }
__device__ __forceinline__ unsigned xb_add(unsigned* p, unsigned v) { return __hip_atomic_fetch_add(p, v, __ATOMIC_RELAXED, __HIP_MEMORY_SCOPE_AGENT); }
__device__ __forceinline__ unsigned xb_xcc_id() { return (unsigned)__builtin_amdgcn_s_getreg((3 << 11) | 20) & 0xFu; }
#define XB_SPIN(cond, bar) do { unsigned _sp = 0; while (cond) { __builtin_amdgcn_s_sleep(1); \
    if ((++_sp & 255u) == 0u) { if (xb_ld(&(bar)[XB_TMO])) break; if (_sp > XB_SPIN_CAP) { atomicAdd(&(bar)[XB_TMO], 1u); break; } } } } while (0)

struct XcdBarrier { unsigned* bar; unsigned x; volatile LAS unsigned* st; };

__device__ __forceinline__ XcdBarrier xcd_barrier_post(unsigned* bar, volatile LAS unsigned* st) {
    XcdBarrier b; b.bar = bar; b.x = xb_xcc_id(); b.st = st;
    if (threadIdx.x == 0) (void)xb_add(&bar[XB_XCNT(b.x)], 1u);
    return b;
}
__device__ __forceinline__ void xcd_barrier_complete(unsigned* bar, unsigned x, unsigned& nloc, unsigned& nx) {
    const unsigned G = gridDim.x * gridDim.y * gridDim.z;
    unsigned sum, cnt, mine, sp = 0u;
    for (;;) {
        sum = 0u; cnt = 0u; mine = 0u;
#pragma unroll
        for (unsigned j = 0; j < 16; ++j) { const unsigned c = xb_ld(&bar[XB_XCNT(j)]); sum += c; cnt += (c > 0u) ? 1u : 0u; mine = (j == x) ? c : mine; }
        if (sum == G) break;
        __builtin_amdgcn_s_sleep(1);
        if ((++sp & 255u) == 0u) { if (xb_ld(&bar[XB_TMO])) break; if (sp > XB_SPIN_CAP) { atomicAdd(&bar[XB_TMO], 1u); break; } }
    }
    nloc = mine > 0u ? mine : 1u; nx = cnt > 0u ? cnt : 1u;
}
__device__ __forceinline__ void xcd_barrier(const XcdBarrier& b) {
    asm volatile("s_waitcnt vmcnt(0)" ::: "memory");
    __syncthreads();
    if (threadIdx.x == 0) {
        unsigned* bar = b.bar;
        __builtin_amdgcn_s_waitcnt(0);
        unsigned nloc = b.st[0], nx = b.st[1];
        if (nloc == 0u) { xcd_barrier_complete(bar, b.x, nloc, nx); b.st[0] = nloc; b.st[1] = nx; }
        const unsigned old = xb_add(&bar[XB_XSUB(b.x)], 1u);
        const unsigned gen = old / nloc;
        if (old + 1u == (gen + 1u) * nloc) {
            __builtin_amdgcn_fence(__ATOMIC_RELEASE, "agent");
            asm volatile("s_waitcnt vmcnt(0)" ::: "memory");
            const unsigned og = xb_add(&bar[XB_TOP], 1u);
            const unsigned tg = og / nx;
            if (og + 1u == (tg + 1u) * nx) xb_add(&bar[XB_TOPGEN], 1u);
            else XB_SPIN(xb_ld(&bar[XB_TOPGEN]) == tg, bar);
            __builtin_amdgcn_fence(__ATOMIC_ACQUIRE, "agent");
            xb_add(&bar[XB_XGEN(b.x)], 1u);
            asm volatile("s_waitcnt vmcnt(0)" ::: "memory");
        } else {
            XB_SPIN(xb_ld(&bar[XB_XGEN(b.x)]) == gen, bar);
            __builtin_amdgcn_fence(__ATOMIC_ACQUIRE, "agent");
            asm volatile("s_waitcnt vmcnt(0)" ::: "memory");
        }
    }
    __syncthreads();
}

struct Params {
    const float *x, *c, *ctx, *c_ctx, *w_ada, *b_ada, *norm1, *w_in, *conv_w, *conv_b, *gate_a_w, *gate_a_b, *gate_x_w, *gate_x_b, *lam,
                *w_f, *w_r, *w_o, *norm2, *w_router, *b_router, *w_gu, *b_gu, *w_down, *b_down, *norm_f;
    float* out; unsigned char* ws;
    int ph_lo, ph_hi;
};
struct Frame {
    LAS unsigned char* lds; int tid, lane, wave, G, bid; unsigned long long pacc;
};
#define MODP(ws) ((const float*)((ws) + WS_MOD))
enum { M_SH1 = 0, M_SC1 = 1, M_G1 = 2, M_SH2 = 3, M_SC2 = 4, M_G2 = 5 };

__device__ __forceinline__ void p0_ada(const Params& p, Frame& F) {
    LAS float* scond = (LAS float*)F.lds;
    LAS float* red = (LAS float*)(F.lds + 9 * 1024 * 4);
    for (int i = F.tid; i < 9 * 1024; i += NTHREADS) { const int r = i >> 10, k = i & 1023; const float v = r < 8 ? p.c[r * 1024 + k] : p.c_ctx[k]; scond[i] = v / (1.0f + __expf(-v)); }
    __syncthreads();
    float* mod = (float*)(p.ws + WS_MOD);
    for (int i = F.bid * NTHREADS + F.tid; i < 2048; i += F.G * NTHREADS) ((float*)(p.ws + WS_SPL))[i] = 8.0f * log1pf(expf(-p.lam[i]));
    for (int item = F.bid; item < 6144 / 32; item += F.G) {
        const int n = item * 32 + (F.lane & 31), sl = F.wave * 2 + (F.lane >> 5);
        float a[9];
#pragma unroll
        for (int r = 0; r < 9; ++r) a[r] = 0.f;
#pragma unroll 8
        for (int kk = 0; kk < 64; ++kk) { const int k = sl * 64 + kk; const float w = p.w_ada[(size_t)k * 6144 + n];
#pragma unroll
            for (int r = 0; r < 9; ++r) a[r] += scond[r * 1024 + k] * w; }
#pragma unroll
        for (int r = 0; r < 9; ++r) red[(sl * 9 + r) * 32 + (F.lane & 31)] = a[r];
        __syncthreads();
        if (F.tid < 9 * 32) { const int r = F.tid >> 5, nn = F.tid & 31; float s = p.b_ada[item * 32 + nn];
            for (int q = 0; q < 16; ++q) s += red[(q * 9 + r) * 32 + nn];
            mod[r * 6144 + item * 32 + nn] = s; }
        __syncthreads();
    }
}
__device__ __forceinline__ void transpose_item(const float* W, int ldw, int ncol0, int k0, bf16_t* WT, int ldt, int drow0, LAS float* scr, int lane) {
#pragma unroll 8
    for (int i = 0; i < 32; ++i) { const int kk = 2 * i + (lane >> 5); scr[kk * 33 + (lane & 31)] = W[(size_t)(k0 + kk) * ldw + ncol0 + (lane & 31)]; }
    asm volatile("s_waitcnt lgkmcnt(0)" ::: "memory");
    const int c = lane & 7;
#pragma unroll
    for (int j = 0; j < 4; ++j) { const int n = (lane >> 3) + 8 * j; const LAS float* s = scr + (8 * c) * 33 + n;
        u32x4 o; o.x = pk2(s[0 * 33], s[1 * 33]); o.y = pk2(s[2 * 33], s[3 * 33]); o.z = pk2(s[4 * 33], s[5 * 33]); o.w = pk2(s[6 * 33], s[7 * 33]);
        *(u32x4*)(WT + (size_t)(drow0 + n) * ldt + k0 + 8 * c) = o; }
    asm volatile("s_waitcnt lgkmcnt(0)" ::: "memory");
}
__device__ __forceinline__ void transpose_item64(const float* W, int ldw, int ncol0, int k0, bf16_t* WT, int ldt, int drow0, LAS float* scr, int lane) {
    f32x4 v[16];
#pragma unroll
    for (int i = 0; i < 16; ++i) v[i] = *(const f32x4*)(W + (size_t)(k0 + 4 * i + (lane >> 4)) * ldw + ncol0 + 4 * (lane & 15));
#pragma unroll
    for (int i = 0; i < 16; ++i) { LAS float* d = scr + (4 * i + (lane >> 4)) * 65 + 4 * (lane & 15); d[0] = v[i].x; d[1] = v[i].y; d[2] = v[i].z; d[3] = v[i].w; }
    asm volatile("s_waitcnt lgkmcnt(0)" ::: "memory");
    const int c = lane & 7;
#pragma unroll
    for (int j = 0; j < 8; ++j) { const int n = (lane >> 3) + 8 * j; const LAS float* s = scr + (8 * c) * 65 + n;
        u32x4 o; o.x = pk2(s[0 * 65], s[1 * 65]); o.y = pk2(s[2 * 65], s[3 * 65]); o.z = pk2(s[4 * 65], s[5 * 65]); o.w = pk2(s[6 * 65], s[7 * 65]);
        *(u32x4*)(WT + (size_t)(drow0 + n) * ldt + k0 + 8 * c) = o; }
    asm volatile("s_waitcnt lgkmcnt(0)" ::: "memory");
}
__device__ __forceinline__ void transpose_item64_f8(const float* W, int ldw, int ncol0, int k0, unsigned char* WT, int ldt, int drow0, LAS float* scr, int lane) {
    f32x4 v[16];
#pragma unroll
    for (int i = 0; i < 16; ++i) v[i] = *(const f32x4*)(W + (size_t)(k0 + 4 * i + (lane >> 4)) * ldw + ncol0 + 4 * (lane & 15));
#pragma unroll
    for (int i = 0; i < 16; ++i) { LAS float* d = scr + (4 * i + (lane >> 4)) * 65 + 4 * (lane & 15); d[0] = v[i].x; d[1] = v[i].y; d[2] = v[i].z; d[3] = v[i].w; }
    asm volatile("s_waitcnt lgkmcnt(0)" ::: "memory");
    const int c = lane & 3;
#pragma unroll
    for (int j = 0; j < 4; ++j) { const int n = (lane >> 2) + 16 * j; const LAS float* s = scr + (16 * c) * 65 + n; unsigned w[4];
#pragma unroll
        for (int q = 0; q < 4; ++q) { int t = 0; t = __builtin_amdgcn_cvt_pk_fp8_f32(64.0f * s[(4 * q) * 65], 64.0f * s[(4 * q + 1) * 65], t, false);
            t = __builtin_amdgcn_cvt_pk_fp8_f32(64.0f * s[(4 * q + 2) * 65], 64.0f * s[(4 * q + 3) * 65], t, true); w[q] = (unsigned)t; }
        *(u32x4*)(WT + (size_t)(drow0 + n) * ldt + k0 + 16 * c) = (u32x4){w[0], w[1], w[2], w[3]}; }
    asm volatile("s_waitcnt lgkmcnt(0)" ::: "memory");
}
__device__ __forceinline__ void transpose_matrix(const float* W, int K, int ldw, int c0, int N, bf16_t* WT, int drow0, LAS float* scr, int gw, int ngw, int lane) {
    const int nb = N / 32, nitems = (K / 64) * nb;
    for (int it = gw; it < nitems; it += ngw) { const int kb = it / nb, b = it % nb; transpose_item(W, ldw, c0 + 32 * b, 64 * kb, WT, K, drow0 + 32 * b, scr, lane); }
}
__device__ __forceinline__ void p0_weights(const Params& p, Frame& F) {
    unsigned char* ws = p.ws;
    LAS float* scr = (LAS float*)(F.lds + 65536 + F.wave * 8704);
    LAS float* tab = (LAS float*)(F.lds + 65536 + 8 * 8704);
    if (F.tid < 128) tab[F.tid] = cospif((float)F.tid / 64.0f);
    __syncthreads();
    { bf16_t* m1 = (bf16_t*)(ws + WS_DFTM); bf16_t* m2 = m1 + 128 * 128;
      for (int i = F.bid * NTHREADS + F.tid; i < 256 * 128; i += F.G * NTHREADS) {
          const int n = i >> 7, c = i & 127, m = n & 127; const float a = (float)((m * c) & 127) / 64.0f;
          (m2 + 128 * 256)[i] = (bf16_t)f2bf(0.08838834764831845f * ((n >> 7) ? -sinpif(a) : cospif(a))); }
      for (int i = F.bid * NTHREADS + F.tid; i < 128 * 128 + 128 * 256; i += F.G * NTHREADS) {
          if (i < 128 * 128) { const int kk = i >> 7, k = i & 127, k1 = kk & 63, l1 = k & 63, oi = kk >> 6, ii = k >> 6; const float a = (float)((k1 * l1) & 63) / 32.0f; const float c = cospif(a), sn = sinpif(a);
              m1[i] = (bf16_t)f2bf(0.125f * (oi == ii ? c : (oi ? -sn : sn))); }
          else { const int j = i - 128 * 128, kk = j >> 8, k = j & 255, l2 = k & 127, ii = k >> 7; const float a = (float)((kk * l2) & 127) / 64.0f;
              m2[j] = (bf16_t)f2bf(0.08838834764831845f * (ii ? sinpif(a) : cospif(a))); } } }
    const int gw = F.bid * NWAVES + F.wave, ngw = F.G * NWAVES;
    bf16_t* wcat = (bf16_t*)(ws + WS_WCAT);
    for (int it = gw; it < (UNFOLD_CH ? 0 : 1024 * 4); it += ngw) {
        const int k = it >> 2, g = it & 3; const float* src = p.w_in + (size_t)k * DIN + g * 128;
        float re0 = 0.f, re1 = 0.f, im0 = 0.f, im1 = 0.f; const int m0 = F.lane, m1 = F.lane + 64;
        for (int c = 0; c < 128; ++c) { const float u = src[c];
            re0 += u * tab[(m0 * c) & 127]; im0 -= u * tab[(m0 * c + 96) & 127];
            re1 += u * tab[(m1 * c) & 127]; im1 -= u * tab[(m1 * c + 96) & 127]; }
        const float sc = 0.08838834764831845f;
        wcat[(size_t)(g * 128 + m0) * 1024 + k] = (bf16_t)f2bf(re0 * sc); wcat[(size_t)(g * 128 + m1) * 1024 + k] = (bf16_t)f2bf(re1 * sc);
        wcat[(size_t)(512 + g * 128 + m0) * 1024 + k] = (bf16_t)f2bf(im0 * sc); wcat[(size_t)(512 + g * 128 + m1) * 1024 + k] = (bf16_t)f2bf(im1 * sc);
    }
#if UNFOLD_CH
    {
        __syncthreads();
        LAS float* scr8 = (LAS float*)(F.lds + F.wave * 16640);
        constexpr int I_IN = 16 * 72, I_F = 8 * 16, I_R = 16 * 16, I_O = 16 * 16;
        for (int it = gw; it < I_IN + I_F + I_R + I_O; it += ngw) { int r = it;
            if (r < I_IN) { const int cb = r % 72;
                if (GATES_F8 && cb >= 40) transpose_item64_f8(p.w_in, DIN, 64 * cb, 64 * (r / 72), ws + WS_ROUTE, 1024, 64 * (cb - 40), scr8, F.lane);
                else transpose_item64(p.w_in, DIN, 64 * cb, 64 * (r / 72), wcat, 1024, 64 * cb, scr8, F.lane);
                continue; } r -= I_IN;
            if (r < I_F) { transpose_item64(p.w_f, 1024, 64 * (r % 16), 64 * (r / 16), (bf16_t*)(ws + WS_WF), 512, 64 * (r % 16), scr8, F.lane); continue; } r -= I_F;
            if (r < I_R) { transpose_item64(p.w_r, 1024, 64 * (r % 16), 64 * (r / 16), (bf16_t*)(ws + WS_WR), 1024, 64 * (r % 16), scr8, F.lane); continue; } r -= I_R;
            transpose_item64(p.w_o, 1024, 64 * (r % 16), 64 * (r / 16), (bf16_t*)(ws + WS_WO), 1024, 64 * (r % 16), scr8, F.lane); }
        __syncthreads();
    }
#else
    transpose_matrix(p.w_in, 1024, DIN, 512, 4096, wcat, 1024, scr, gw, ngw, F.lane);
    transpose_matrix(p.w_f, 512, 1024, 0, 1024, (bf16_t*)(ws + WS_WF), 0, scr, gw, ngw, F.lane);
    transpose_matrix(p.w_r, 1024, 1024, 0, 1024, (bf16_t*)(ws + WS_WR), 0, scr, gw, ngw, F.lane);
    transpose_matrix(p.w_o, 1024, 1024, 0, 1024, (bf16_t*)(ws + WS_WO), 0, scr, gw, ngw, F.lane);
#endif
    transpose_matrix(p.w_router, 1024, 32, 0, 32, (bf16_t*)(ws + WS_WROUT), 0, scr, gw, ngw, F.lane);
    for (int it = gw; it < 256; it += ngw) { const int q = it >> 3, sub = it & 7, d = q >> 4, ax = (q >> 3) & 1, h = q & 7;
        transpose_item((ax ? p.gate_x_w : p.gate_a_w) + (size_t)(d * 8 + h) * 16384, 128, 32 * (sub & 3), 64 * (sub >> 2), (bf16_t*)(ws + WS_GW) + (size_t)((d * 2 + ax) * 8 + h) * 16384, 128, 32 * (sub & 3), scr, F.lane); }
}
__device__ __forceinline__ void p_moe_weights(const Params& p, Frame& F) {
    LAS float* scr = (LAS float*)(F.lds + F.wave * 16640);
    const int gw = F.bid * NWAVES + F.wave, ngw = F.G * NWAVES;
    unsigned char* wgu = p.ws + WS_WGU; unsigned char* wd = p.ws + WS_WD;
    constexpr int IT_GU = 16 * 32, IT_D = 16 * 16;
    for (int it = gw; it < NE * (IT_GU + IT_D); it += ngw) {
        const int e = it / (IT_GU + IT_D); int r = it % (IT_GU + IT_D);
        if (r < IT_GU) { const int kb = r / 32, b = r % 32, n0 = 64 * b; const int j = n0 & 1023, up = n0 >> 10;
            const int drow = 256 * (j >> 7) + 128 * up + (j & 127);
            transpose_item64_f8(p.w_gu + (size_t)e * 1024 * 2048, 2048, n0, 64 * kb, wgu + (size_t)e * 2048 * 1024, 1024, drow, scr, F.lane);
        } else { r -= IT_GU; const int kb = r / 16, b = r % 16;
            transpose_item64_f8(p.w_down + (size_t)e * 1024 * 1024, 1024, 64 * b, 64 * kb, wd + (size_t)e * 1024 * 1024, 1024, 64 * b, scr, F.lane); }
    }
}

__device__ __forceinline__ void norm_row_bf16(const float* xrow, const float* gain, const float* sc, const float* sh, bf16_t* orow, int lane) {
    const GAS f32x4* xr = (const GAS f32x4*)xrow + lane;
    f32x4 v[4]; float s = 0.f;
#pragma unroll
    for (int j = 0; j < 4; ++j) { v[j] = xr[64 * j]; s += (v[j].x * v[j].x + v[j].y * v[j].y) + (v[j].z * v[j].z + v[j].w * v[j].w); }
    const float rs = 1.0f / sqrtf(wave_sum(s, lane) * (1.f / D) + EPS);
    GAS unsigned long long* o8 = (GAS unsigned long long*)orow + lane;
#pragma unroll
    for (int j = 0; j < 4; ++j) { const f32x4 g = ((const f32x4*)gain)[lane + 64 * j], a = ((const f32x4*)sc)[lane + 64 * j], b = ((const f32x4*)sh)[lane + 64 * j];
        const float o0 = v[j].x * rs * g.x * (1.f + a.x) + b.x, o1 = v[j].y * rs * g.y * (1.f + a.y) + b.y, o2 = v[j].z * rs * g.z * (1.f + a.z) + b.z, o3 = v[j].w * rs * g.w * (1.f + a.w) + b.w;
        o8[64 * j] = (unsigned long long)pk2(o0, o1) | ((unsigned long long)pk2(o2, o3) << 32); }
}
__device__ __forceinline__ void p1_norm(const Params& p, Frame& F) {
    const float* mod = MODP(p.ws); bf16_t* hx = (bf16_t*)(p.ws + WS_B0);
    const int gw = F.bid * NWAVES + F.wave, ngw = F.G * NWAVES;
    for (int chunk = gw; chunk < T / 32; chunk += ngw) {
        const int m0 = chunk * 32, r = m0 / SEQ;
        const float* sc = mod + r * 6144 + M_SC1 * 1024; const float* sh = mod + r * 6144 + M_SH1 * 1024;
        f32x4 gm[4], bsh[4];
#pragma unroll
        for (int j = 0; j < 4; ++j) { const f32x4 g = ((const f32x4*)p.norm1)[F.lane + 64 * j], a = ((const f32x4*)sc)[F.lane + 64 * j]; gm[j] = g * (1.0f + a); bsh[j] = ((const f32x4*)sh)[F.lane + 64 * j]; }
        f32x4 nx[3][4];
#pragma unroll
        for (int q = 0; q < 3; ++q)
#pragma unroll
            for (int j = 0; j < 4; ++j) nx[q][j] = ((const GAS f32x4*)(p.x + (size_t)(m0 + q) * D) + F.lane)[64 * j];
#pragma unroll 1
        for (int i3 = 0; i3 < 33; i3 += 3) {
#pragma unroll
            for (int q = 0; q < 3; ++q) { const int i = i3 + q; if (i < 32) { const int m = m0 + i; f32x4 v[4]; float s = 0.f;
#pragma unroll
                for (int j = 0; j < 4; ++j) { v[j] = nx[q][j]; if (i + 3 < 32) nx[q][j] = ((const GAS f32x4*)(p.x + (size_t)(m + 3) * D) + F.lane)[64 * j];
                    s += (v[j].x * v[j].x + v[j].y * v[j].y) + (v[j].z * v[j].z + v[j].w * v[j].w); }
                const float rs = 1.0f / sqrtf(wave_sum(s, F.lane) * (1.f / D) + EPS);
                GAS unsigned long long* o8 = (GAS unsigned long long*)(hx + (size_t)m * D) + F.lane;
#pragma unroll
                for (int j = 0; j < 4; ++j) { const f32x4 o = v[j] * rs * gm[j] + bsh[j]; o8[64 * j] = (unsigned long long)pk2(o.x, o.y) | ((unsigned long long)pk2(o.z, o.w) << 32);
                    if (GATES_F8) { int q8 = 0; q8 = __builtin_amdgcn_cvt_pk_fp8_f32(o.x, o.y, q8, false); q8 = __builtin_amdgcn_cvt_pk_fp8_f32(o.z, o.w, q8, true);
                        ((GAS unsigned*)(p.ws + WS_B1 + (size_t)m * D) + F.lane)[64 * j] = (unsigned)q8; } } } }
        }
    }
    for (int m = T + gw; m < MT; m += ngw)
        norm_row_bf16(p.ctx + (size_t)(m - T) * D, p.norm1, mod + 8 * 6144 + M_SC1 * 1024, mod + 8 * 6144 + M_SH1 * 1024, hx + (size_t)m * D, F.lane);
}

struct Sched2 {
    static constexpr bool EVEC = false;
    int G, c;
    __device__ __forceinline__ bool next(int i, pg8::Unit& u) const {
        const long L = (long)i * G + c; int pm, pn;
        constexpr int NNT = UNFOLD_CH ? (GATES_F8 ? 10 : 18) : 20, PZR = UNFOLD_CH ? 2 : 4;
        if (L < 256 * NNT) { pg8::tile_order(L, 256, NNT, pm, pn); }
        else if (L < 256 * NNT + 32) { const int j = (int)(L - 256 * NNT); pm = 256 + (j >> 2); pn = PZR + (j & 3); }
        else return false;
        u.pm = pm; u.pn = pn; u.aux = 0; u.A = (unsigned)pm * 256u * 2048u; u.B = (unsigned)pn * 256u * 2048u; return true;
    }
};
struct Sched2G {
    static constexpr bool EVEC = false;
    int G, c;
    __device__ __forceinline__ bool next(int i, pg8::Unit& u) const {
        long L; if (G == 256) { if (c < 32) { if (i >= 6) return false; L = 1856 + i * 32 + c; } else { L = (long)i * 224 + (c - 32); if (L >= 1856) return false; } }
        else L = (long)i * G + (c + G - (256 * 10 + 32) % G) % G;
        int pm, pn; if (!pg8::tile_order(L, 256, 8, pm, pn)) return false;
        u.pm = pm; u.pn = 10 + pn; u.aux = 0; u.A = (unsigned)pm * 256u * 1024u; u.B = (unsigned)pn * 256u * 1024u; return true;
    }
};
__device__ __forceinline__ f32x4 gelu_tanh4(f32x4 v) {
    f32x4 o;
#pragma unroll
    for (int j = 0; j < 4; ++j) { const float x = v[j]; o[j] = x * fast_sigmoid(1.59576912f * x * (1.0f + 0.044715f * x * x)); }
    return o;
}
__device__ __forceinline__ f32x4 sigmoid4(f32x4 v) { f32x4 o;
#pragma unroll
    for (int j = 0; j < 4; ++j) o[j] = fast_sigmoid(v[j]);
    return o; }
struct Epi2 {
    static constexpr bool PERM = true;
    unsigned char* ws; float gscale;
    __device__ __forceinline__ void operator()(const f32x4 (&acc)[2][2][4][2], const pg8::Unit& u, int wr, int wc, int fr, int fq, const LAS float* ev) const {
#if UNFOLD_CH
        const int t = u.pn < 2 ? 0 : ((u.pn + 2) >> 2), pq = u.pn < 2 ? u.pn : ((u.pn - 2) & 3); const int ld0 = t == 0 ? 512 : 1024;
        const size_t boff = t == 0 ? WS_B7 : t == 1 ? WS_B2 : t == 2 ? WS_B3 : t == 3 ? WS_B4 : WS_B5;
#else
        const int t = u.pn >> 2, pq = u.pn & 3; const int ld0 = 1024; const size_t boff = t == 0 ? WS_B1 : t == 1 ? WS_B2 : t == 2 ? WS_B3 : t == 3 ? WS_B4 : WS_B5;
#endif
        bf16_t* base = (bf16_t*)(ws + boff);
        const int row0 = u.pm * 256 + wr * 64 + fr, col0 = pq * 256 + wc * 32 + 8 * fq;
        const bool hm = (t == 1) || (t == 2); const size_t hstride = (t == 1 ? (size_t)MT : (size_t)T) * 128;
#pragma unroll
        for (int ai = 0; ai < 2; ++ai)
#pragma unroll
            for (int m = 0; m < 4; ++m) { const size_t r = (size_t)(row0 + ai * 128 + m * 16);
                bf16_t* rowp = hm ? base + (size_t)(pq * 2) * hstride + r * 128 + wc * 32 + 8 * fq : base + r * ld0 + col0;
                const size_t bjs = hm ? hstride : (size_t)128;
#pragma unroll
                for (int bj = 0; bj < 2; ++bj) { f32x4 v0 = acc[ai][bj][m][0], v1 = acc[ai][bj][m][1];
                    if (t == 2) { v0 = gelu_tanh4(v0); v1 = gelu_tanh4(v1); }
                    else if (t >= 3) { v0 = sigmoid4(v0 * gscale); v1 = sigmoid4(v1 * gscale); }
                    u32x4 w; w.x = cvt_pk_bf16(v0[0], v0[1]); w.y = cvt_pk_bf16(v0[2], v0[3]); w.z = cvt_pk_bf16(v1[0], v1[1]); w.w = cvt_pk_bf16(v1[2], v1[3]);
                    *(u32x4*)(rowp + bj * bjs) = w; } }
    }
};

struct EpiNull {
    static constexpr bool PERM = true;
    float* sink;
    __device__ __forceinline__ void operator()(const f32x4 (&acc)[2][2][4][2], const pg8::Unit& u, int wr, int wc, int fr, int fq, const LAS float* ev) const {
        float s = 0.f;
#pragma unroll
        for (int ai = 0; ai < 2; ++ai)
#pragma unroll
            for (int bj = 0; bj < 2; ++bj)
#pragma unroll
                for (int m = 0; m < 4; ++m)
#pragma unroll
                    for (int n = 0; n < 2; ++n) s += acc[ai][bj][m][n][0] + acc[ai][bj][m][n][1] + acc[ai][bj][m][n][2] + acc[ai][bj][m][n][3];
        if (s == 123456.789f) sink[u.pm] = s;
    }
};
__device__ __forceinline__ void p3_rnn_naive(const Params& p, Frame& F) {
    LAS float* wa = (LAS float*)F.lds;
    LAS float* wx = wa + 128 * 128;
    LAS float* urow = wx + 128 * 128;
    LAS float* part = urow + 128;
    const bf16_t* zr = (const bf16_t*)(p.ws + WS_B2);
    bf16_t* hf = (bf16_t*)(p.ws + WS_B0); bf16_t* hb = (bf16_t*)(p.ws + WS_B6);
    const int c = F.tid & 127, part_i = F.tid >> 7;
    for (int chain = F.bid; chain < 128; chain += F.G) {
        const int b = chain >> 4, d = (chain >> 3) & 1, h = chain & 7, ch = h * 128 + c;
        __syncthreads();
        for (int i = F.tid; i < 128 * 128; i += NTHREADS) { wa[i] = p.gate_a_w[((size_t)(d * 8 + h) * 128) * 128 + i]; wx[i] = p.gate_x_w[((size_t)(d * 8 + h) * 128) * 128 + i]; }
        const float ba = p.gate_a_b[d * 1024 + ch], bx = p.gate_x_b[d * 1024 + ch];
        const float lam = p.lam[d * 1024 + ch]; const float spl = 8.0f * log1pf(expf(-lam));
        const float cw0 = p.conv_w[0 * 1024 + ch], cw1 = p.conv_w[1 * 1024 + ch], cw2 = p.conv_w[2 * 1024 + ch], cw3 = p.conv_w[3 * 1024 + ch], cb = p.conv_b[ch];
        float hstate = 0.f;
        __syncthreads();
        for (int step = 0; step < CTXL + SEQ; ++step) {
            const bool isctx = step < CTXL; const int s = isctx ? step : step - CTXL; const int len = isctx ? CTXL : SEQ;
            const int t = d ? (len - 1 - s) : s;
            const size_t rbase = isctx ? (size_t)T + (size_t)b * CTXL : (size_t)b * SEQ;
            float u = 0.f;
            if (part_i == 0) {
                const int lo = isctx ? 0 : (t & ~63), hi = isctx ? CTXL : lo + 64;
                u = cb;
                if (t - 2 >= lo) u += cw0 * bf2f(zr[(rbase + t - 2) * 1024 + ch]);
                if (t - 1 >= lo) u += cw1 * bf2f(zr[(rbase + t - 1) * 1024 + ch]);
                u += cw2 * bf2f(zr[(rbase + t) * 1024 + ch]);
                if (t + 1 < hi) u += cw3 * bf2f(zr[(rbase + t + 1) * 1024 + ch]);
                urow[c] = u;
            }
            __syncthreads();
            float pa = 0.f, px = 0.f;
#pragma unroll 8
            for (int i = 0; i < 32; ++i) { const int ii = part_i * 32 + i; const float uv = urow[ii]; pa += uv * wa[ii * 128 + c]; px += uv * wx[ii * 128 + c]; }
            part[(0 * 4 + part_i) * 128 + c] = pa; part[(1 * 4 + part_i) * 128 + c] = px;
            __syncthreads();
            if (part_i == 0) {
                const float sa = ba + part[c] + part[128 + c] + part[256 + c] + part[384 + c];
                const float sx = bx + part[512 + c] + part[640 + c] + part[768 + c] + part[896 + c];
                const float r = 1.0f / (1.0f + expf(-sa)), ig = 1.0f / (1.0f + expf(-sx));
                const float la = -spl * r, a = expf(la), bt = sqrtf(-expm1f(2.0f * la)) * (ig * u);
                hstate = a * hstate + bt;
                if (!isctx) { bf16_t* o = d ? hb : hf; o[(rbase + t) * 1024 + ch] = (bf16_t)f2bf(hstate); }
            }
        }
    }
}
__device__ __forceinline__ void p3_dftA_naive(const Params& p, Frame& F, int myi, int nbl) {
    LAS float* c64 = (LAS float*)(F.lds + 140 * 1024); LAS float* s64 = c64 + 64;
    __syncthreads();
    if (F.tid < 64) { c64[F.tid] = cospif((float)F.tid / 32.0f); s64[F.tid] = sinpif((float)F.tid / 32.0f); }
    __syncthreads();
    const bf16_t* V = (const bf16_t*)(p.ws + WS_B1); bf16_t* Tb = (bf16_t*)(p.ws + WS_B1);
    const int m = F.tid;
    for (int item = myi; item < NB * 128; item += nbl) {
        const int b = item >> 7, l2 = item & 127;
        float xr[64], xi[64];
#pragma unroll
        for (int l1 = 0; l1 < 64; ++l1) { const size_t row = (size_t)b * SEQ + 128 * l1 + l2; xr[l1] = bf2f(V[row * 1024 + m]); xi[l1] = bf2f(V[row * 1024 + 512 + m]); }
        for (int k1 = 0; k1 < 64; ++k1) {
            float ar = 0.f, ai = 0.f;
#pragma unroll
            for (int l1 = 0; l1 < 64; ++l1) { const int q = (k1 * l1) & 63; const float cc = c64[q], ss = s64[q];
                ar += cc * xr[l1] + ss * xi[l1]; ai += cc * xi[l1] - ss * xr[l1]; }
            float tc, ts; sincospif((float)(k1 * l2) / 4096.0f, &ts, &tc);
            const float orr = (ar * tc + ai * ts) * 0.125f, oi = (ai * tc - ar * ts) * 0.125f;
            const size_t orow = (size_t)b * SEQ + 128 * k1 + l2;
            Tb[orow * 1024 + m] = (bf16_t)f2bf(orr); Tb[orow * 1024 + 512 + m] = (bf16_t)f2bf(oi);
        }
    }
}
__device__ __forceinline__ void p4_dftB_naive(const Params& p, Frame& F) {
    LAS bf16_t* tile = (LAS bf16_t*)F.lds;
    LAS float* c128 = (LAS float*)(F.lds + 140 * 1024); LAS float* s128 = c128 + 128;
    __syncthreads();
    if (F.tid < 128) { c128[F.tid] = cospif((float)F.tid / 64.0f); s128[F.tid] = sinpif((float)F.tid / 64.0f); }
    const bf16_t* Tb = (const bf16_t*)(p.ws + WS_B1); bf16_t* Y = (bf16_t*)(p.ws + WS_B7);
    for (int item = F.bid; item < NB * 64 * 2; item += F.G) {
        const int b = item >> 7, k1 = (item >> 1) & 63, chh = item & 1;
        __syncthreads();
        for (int i = F.tid; i < 128 * 64; i += NTHREADS) {
            const int l2 = i >> 6, pc = i & 63, im = pc >> 5, cc = (pc & 31) * 8;
            const size_t row = (size_t)b * SEQ + 128 * k1 + l2;
            *(LAS u32x4*)(tile + l2 * 512 + im * 256 + cc) = *(const u32x4*)(Tb + row * 1024 + im * 512 + chh * 256 + cc);
        }
        __syncthreads();
        const int m = F.tid & 255, kh = F.tid >> 8;
        for (int kk = 0; kk < 64; ++kk) { const int k2 = kh * 64 + kk; float s = 0.f;
#pragma unroll 8
            for (int l2 = 0; l2 < 128; ++l2) { const int q = (k2 * l2) & 127; s += c128[q] * bf2f(tile[l2 * 512 + m]) + s128[q] * bf2f(tile[l2 * 512 + 256 + m]); }
            Y[((size_t)b * SEQ + k1 + 64 * k2) * 512 + chh * 256 + m] = (bf16_t)f2bf(s * 0.08838834764831845f);
        }
    }
}
__device__ __forceinline__ void p4_yg_naive(const Params& p, Frame& F) {
    const u32x4* hf = (const u32x4*)(p.ws + WS_B0); const u32x4* hb = (const u32x4*)(p.ws + WS_B6); const u32x4* G = (const u32x4*)(p.ws + WS_B3); u32x4* yg = (u32x4*)(p.ws + WS_B2);
    const size_t n = (size_t)T * 1024 / 8;
    for (size_t i = (size_t)F.bid * NTHREADS + F.tid; i < n; i += (size_t)F.G * NTHREADS) {
        const u32x4 a = hf[i], b = hb[i], g = G[i]; u32x4 o;
        o.x = pk2((bflo(a.x) + bflo(b.x)) * bflo(g.x), (bfhi(a.x) + bfhi(b.x)) * bfhi(g.x));
        o.y = pk2((bflo(a.y) + bflo(b.y)) * bflo(g.y), (bfhi(a.y) + bfhi(b.y)) * bfhi(g.y));
        o.z = pk2((bflo(a.z) + bflo(b.z)) * bflo(g.z), (bfhi(a.z) + bfhi(b.z)) * bfhi(g.z));
        o.w = pk2((bflo(a.w) + bflo(b.w)) * bflo(g.w), (bfhi(a.w) + bfhi(b.w)) * bfhi(g.w));
        yg[i] = o;
    }
}

constexpr size_t AGG_CAR = 4608 * 1024;
constexpr int UP = 272;
template <int DIR> __device__ __forceinline__ void rnn_block(const f32x4 pa, const f32x4 px, const float (&u)[4], float ba, float bx, float spl2, float spl, int fq, int fr,
                                                             float& Pc, float& Lc, float (&hout)[4], float (&pout)[4]) {
    float a[4], b[4];
#pragma unroll
    for (int j = 0; j < 4; ++j) {
        const float r = __builtin_amdgcn_rcpf(1.0f + __builtin_amdgcn_exp2f(-1.44269504f * (pa[j] + ba)));
        const float ig = __builtin_amdgcn_rcpf(1.0f + __builtin_amdgcn_exp2f(-1.44269504f * (px[j] + bx)));
        a[j] = __builtin_amdgcn_exp2f(-spl2 * r);
        const float t = 2.0f * spl * r;
        const float om = t < 0.25f ? t * (1.0f - t * (0.5f - t * (0.16666667f - t * (0.041666668f - t * 0.0083333338f)))) : 1.0f - a[j] * a[j];
        b[j] = __builtin_amdgcn_sqrtf(om) * ig * u[j];
    }
    float P[4], L[4];
    if (DIR == 0) { P[0] = a[0]; L[0] = b[0];
#pragma unroll
        for (int j = 1; j < 4; ++j) { P[j] = a[j] * P[j - 1]; L[j] = a[j] * L[j - 1] + b[j]; } }
    else { P[3] = a[3]; L[3] = b[3];
#pragma unroll
        for (int j = 2; j >= 0; --j) { P[j] = a[j] * P[j + 1]; L[j] = a[j] * L[j + 1] + b[j]; } }
    float Pg = DIR == 0 ? P[3] : P[0], Lg = DIR == 0 ? L[3] : L[0];
    float Pp, Lp;
    if (DIR == 0) { Pp = __shfl_up(Pg, 16); Lp = __shfl_up(Lg, 16); if (fq >= 1) { Lg = Pg * Lp + Lg; Pg = Pg * Pp; }
                    Pp = __shfl_up(Pg, 32); Lp = __shfl_up(Lg, 32); if (fq >= 2) { Lg = Pg * Lp + Lg; Pg = Pg * Pp; } }
    else          { Pp = __shfl_down(Pg, 16); Lp = __shfl_down(Lg, 16); if (fq <= 2) { Lg = Pg * Lp + Lg; Pg = Pg * Pp; }
                    Pp = __shfl_down(Pg, 32); Lp = __shfl_down(Lg, 32); if (fq <= 1) { Lg = Pg * Lp + Lg; Pg = Pg * Pp; } }
    float Pe, Le;
    if (DIR == 0) { Pe = __shfl_up(Pg, 16); Le = __shfl_up(Lg, 16); if (fq == 0) { Pe = 1.f; Le = 0.f; } }
    else          { Pe = __shfl_down(Pg, 16); Le = __shfl_down(Lg, 16); if (fq == 3) { Pe = 1.f; Le = 0.f; } }
    const float Pin = Pe * Pc, Lin = Pe * Lc + Le;
#pragma unroll
    for (int j = 0; j < 4; ++j) { hout[j] = P[j] * Lin + L[j]; pout[j] = P[j] * Pin; }
    const float Pb = __shfl(Pg, DIR == 0 ? 48 + fr : fr), Lb = __shfl(Lg, DIR == 0 ? 48 + fr : fr);
    Lc = Pb * Lc + Lb; Pc = Pb * Pc;
}
template <int CTRL> __device__ __forceinline__ float dpp_mov(float old, float src) {
    return __builtin_bit_cast(float, __builtin_amdgcn_update_dpp(__builtin_bit_cast(int, old), __builtin_bit_cast(int, src), CTRL, 0xF, 0xF, false)); }
template <int DIR> __device__ __forceinline__ void rnn_block_t(const f32x4 pa, const f32x4 px, const float (&u)[4], const f32x4 ba, const f32x4 bx, const f32x4 spl, int fr,
                                                               float (&prevP)[4], float (&prevL)[4], float (&hout)[4], float (&pout)[4]) {
    float P[4], L[4];
#pragma unroll
    for (int h2 = 0; h2 < 2; ++h2) {
        const f32x2 xa = (h2 ? (f32x2){pa.z, pa.w} : (f32x2){pa.x, pa.y}) + (h2 ? (f32x2){ba.z, ba.w} : (f32x2){ba.x, ba.y});
        const f32x2 xx = (h2 ? (f32x2){px.z, px.w} : (f32x2){px.x, px.y}) + (h2 ? (f32x2){bx.z, bx.w} : (f32x2){bx.x, bx.y});
        const f32x2 sp = h2 ? (f32x2){spl.z, spl.w} : (f32x2){spl.x, spl.y};
        f32x2 ea = xa * (-1.44269504f), ex = xx * (-1.44269504f);
        ea.x = __builtin_amdgcn_exp2f(ea.x); ea.y = __builtin_amdgcn_exp2f(ea.y); ex.x = __builtin_amdgcn_exp2f(ex.x); ex.y = __builtin_amdgcn_exp2f(ex.y);
        f32x2 r = ea + 1.0f, ig = ex + 1.0f;
        r.x = __builtin_amdgcn_rcpf(r.x); r.y = __builtin_amdgcn_rcpf(r.y); ig.x = __builtin_amdgcn_rcpf(ig.x); ig.y = __builtin_amdgcn_rcpf(ig.y);
        const f32x2 sr = sp * r;
        f32x2 Pv = sr * (-1.44269504f); Pv.x = __builtin_amdgcn_exp2f(Pv.x); Pv.y = __builtin_amdgcn_exp2f(Pv.y);
        f32x2 om = Pv * (-Pv) + 1.0f;
        om.x = __builtin_amdgcn_sqrtf(om.x); om.y = __builtin_amdgcn_sqrtf(om.y);
        const f32x2 uu = {u[2 * h2], u[2 * h2 + 1]};
        const f32x2 Lv = om * ig * uu;
        P[2 * h2] = Pv.x; P[2 * h2 + 1] = Pv.y; L[2 * h2] = Lv.x; L[2 * h2 + 1] = Lv.y;
    }
#define RNN_EDGE(SH) \
        "v_fmac_f32_dpp %0, %8, %4 " SH " row_mask:0xf bank_mask:0xf\n\t" "v_fmac_f32_dpp %1, %9, %5 " SH " row_mask:0xf bank_mask:0xf\n\t" \
        "v_fmac_f32_dpp %2, %10, %6 " SH " row_mask:0xf bank_mask:0xf\n\t" "v_fmac_f32_dpp %3, %11, %7 " SH " row_mask:0xf bank_mask:0xf\n\t" \
        "v_mul_f32_dpp %4, %12, %4 " SH " row_mask:0xf bank_mask:0xf\n\t" "v_mul_f32_dpp %5, %13, %5 " SH " row_mask:0xf bank_mask:0xf\n\t" \
        "v_mul_f32_dpp %6, %14, %6 " SH " row_mask:0xf bank_mask:0xf\n\t" "v_mul_f32_dpp %7, %15, %7 " SH " row_mask:0xf bank_mask:0xf\n\t"
#define RNN_STEP(SH) \
        "v_fmac_f32_dpp %0, %0, %4 " SH " row_mask:0xf bank_mask:0xf\n\t" "v_fmac_f32_dpp %1, %1, %5 " SH " row_mask:0xf bank_mask:0xf\n\t" \
        "v_fmac_f32_dpp %2, %2, %6 " SH " row_mask:0xf bank_mask:0xf\n\t" "v_fmac_f32_dpp %3, %3, %7 " SH " row_mask:0xf bank_mask:0xf\n\t" \
        "v_mul_f32_dpp %4, %4, %4 " SH " row_mask:0xf bank_mask:0xf\n\t" "v_mul_f32_dpp %5, %5, %5 " SH " row_mask:0xf bank_mask:0xf\n\t" \
        "v_mul_f32_dpp %6, %6, %6 " SH " row_mask:0xf bank_mask:0xf\n\t" "v_mul_f32_dpp %7, %7, %7 " SH " row_mask:0xf bank_mask:0xf\n\t"
    if (DIR == 0) asm volatile("s_nop 1\n\t" RNN_EDGE("row_shl:15") RNN_STEP("row_shr:1") RNN_STEP("row_shr:2") RNN_STEP("row_shr:4") RNN_STEP("row_shr:8")
                               : "+v"(L[0]), "+v"(L[1]), "+v"(L[2]), "+v"(L[3]), "+v"(P[0]), "+v"(P[1]), "+v"(P[2]), "+v"(P[3])
                               : "v"(prevL[0]), "v"(prevL[1]), "v"(prevL[2]), "v"(prevL[3]), "v"(prevP[0]), "v"(prevP[1]), "v"(prevP[2]), "v"(prevP[3]));
    else          asm volatile("s_nop 1\n\t" RNN_EDGE("row_shr:15") RNN_STEP("row_shl:1") RNN_STEP("row_shl:2") RNN_STEP("row_shl:4") RNN_STEP("row_shl:8")
                               : "+v"(L[0]), "+v"(L[1]), "+v"(L[2]), "+v"(L[3]), "+v"(P[0]), "+v"(P[1]), "+v"(P[2]), "+v"(P[3])
                               : "v"(prevL[0]), "v"(prevL[1]), "v"(prevL[2]), "v"(prevL[3]), "v"(prevP[0]), "v"(prevP[1]), "v"(prevP[2]), "v"(prevP[3]));
#undef RNN_STEP
#undef RNN_EDGE
#pragma unroll
    for (int j = 0; j < 4; ++j) { hout[j] = L[j]; pout[j] = P[j]; prevP[j] = P[j]; prevL[j] = L[j]; }
}
__device__ __forceinline__ void p3_rnn_fast(const Params& p, Frame& F) {
    LAS unsigned char* Rt = F.lds;
    LAS unsigned char* Ut = F.lds + 65536;
    bf16_t* zr = (bf16_t*)(p.ws + WS_B2); bf16_t* pfb = (bf16_t*)(p.ws + WS_B0); bf16_t* pbb = (bf16_t*)(p.ws + WS_B6);
    const bf16_t* gw = (const bf16_t*)(p.ws + WS_GW);
    f32x2* agg = (f32x2*)(p.ws + WS_AGG);
    const int fr = F.lane & 15, fq = F.lane >> 4, chl = 16 * F.wave + fr;
    const __amdgpu_buffer_rsrc_t rsPf = __builtin_amdgcn_make_buffer_rsrc(pfb, 0, -1, 0x00020000), rsS = __builtin_amdgcn_make_buffer_rsrc(zr, 0, -1, 0x00020000), rsPb = __builtin_amdgcn_make_buffer_rsrc(pbb, 0, -1, 0x00020000);
    const unsigned lane_off = (unsigned)(fr * 256 + (16 * F.wave + 4 * fq) * 2);
#define RNN_UNIT(ui_, pm_, h_, ok_) do { ok_ = true; \
        if (F.G == 256) { if ((ui_) < 8) { pm_ = F.bid; h_ = (ui_); } else if ((ui_) == 8 && F.bid < 64) { pm_ = 256 + (F.bid >> 3); h_ = F.bid & 7; } else ok_ = false; } \
        else { const int unit_ = F.bid + (ui_) * F.G; if (unit_ >= 264 * 8) ok_ = false; pm_ = unit_ >> 3; h_ = unit_ & 7; } } while (0)
    u32x4 pre[8];
    { int pm0, h0; bool ok0; RNN_UNIT(0, pm0, h0, ok0);
      if (ok0) {
#pragma unroll
          for (int i = 0; i < 8; ++i) { const int pc = F.tid + i * NTHREADS, r = pc >> 4, c16 = pc & 15; pre[i] = *(const GAS u32x4*)(zr + ((size_t)h0 * MT + (size_t)pm0 * 256 + r) * 128 + c16 * 8); } } }
    LAS float* cwt = (LAS float*)(F.lds + 135168);
    { int pm0, h0; bool ok0; RNN_UNIT(0, pm0, h0, ok0);
      if (ok0 && F.tid < 160) { const int k = F.tid >> 5, c = (F.tid & 31) * 4;
          *(LAS f32x4*)(cwt + k * 128 + c) = k < 4 ? *(const GAS f32x4*)(p.conv_w + k * 1024 + h0 * 128 + c) : *(const GAS f32x4*)(p.conv_b + h0 * 128 + c); } }
    for (int ui = 0;; ++ui) {
        int pm, h; bool ok; RNN_UNIT(ui, pm, h, ok); if (!ok) break;
        const bool isctx = pm >= 256;
        const size_t row0 = (size_t)pm * 256;
        const unsigned tile_mt = (unsigned)(((size_t)h * MT + row0) * 256), tile_t = (unsigned)(((size_t)h * T + row0) * 256);
        const int chl4 = 16 * F.wave + 4 * fq, ch4 = h * 128 + chl4;
        __syncthreads();
#pragma unroll
        for (int i = 0; i < 8; ++i) { const int pc = F.tid + i * NTHREADS, r = pc >> 4, c16 = pc & 15; *(LAS u32x4*)(Rt + r * 256 + c16 * 16) = pre[i]; }
        f32x4 ba = *(const GAS f32x4*)(p.gate_a_b + ch4), bx = *(const GAS f32x4*)(p.gate_x_b + ch4), spl = *(const GAS f32x4*)((const float*)(p.ws + WS_SPL) + ch4);
        bf16x8 bfa[4], bfx[4];
#pragma unroll
        for (int s = 0; s < 4; ++s) { bfa[s] = *(const GAS bf16x8*)(gw + ((size_t)((0 * 2 + 0) * 8 + h) * 128 + chl) * 128 + 32 * s + 8 * fq);
                                      bfx[s] = *(const GAS bf16x8*)(gw + ((size_t)((0 * 2 + 1) * 8 + h) * 128 + chl) * 128 + 32 * s + 8 * fq); }
        __syncthreads();
        { const int cp = F.tid & 15, rg = F.tid >> 4, r8 = rg * 8; const int lo = isctx ? 0 : (r8 & ~63), hi = isctx ? 256 : lo + 64;
#pragma unroll 1
          for (int c4 = 0; c4 < 2; ++c4) {
              const LAS float* cw = cwt + (ui & 1) * 640 + cp * 8 + c4 * 4;
              const f32x4 w0 = *(const LAS f32x4*)(cw), w1 = *(const LAS f32x4*)(cw + 128), w2 = *(const LAS f32x4*)(cw + 256), w3 = *(const LAS f32x4*)(cw + 384), cb4 = *(const LAS f32x4*)(cw + 512);
              f32x4 in[11];
#pragma unroll
              for (int i = 0; i < 11; ++i) { const int r = r8 - 2 + i; u32x2 v = {0u, 0u}; if (r >= lo && r < hi) v = *(const LAS u32x2*)(Rt + r * 256 + cp * 16 + c4 * 8);
                  in[i] = (f32x4){bflo(v.x), bfhi(v.x), bflo(v.y), bfhi(v.y)}; }
#pragma unroll
              for (int i = 0; i < 8; ++i) { const f32x4 o = cb4 + w0 * in[i] + w1 * in[i + 1] + w2 * in[i + 2] + w3 * in[i + 3];
                  *(LAS u32x2*)(Ut + (r8 + i) * UP + cp * 16 + c4 * 8) = (u32x2){pk2(o[0], o[1]), pk2(o[2], o[3])}; }
          }
        }
        __syncthreads();
        f32x4 ba1 = *(const GAS f32x4*)(p.gate_a_b + 1024 + ch4), bx1 = *(const GAS f32x4*)(p.gate_x_b + 1024 + ch4), spl1 = *(const GAS f32x4*)((const float*)(p.ws + WS_SPL) + 1024 + ch4);
        bf16x8 bfa1[4], bfx1[4];
#pragma unroll
        for (int s = 0; s < 4; ++s) { bfa1[s] = *(const GAS bf16x8*)(gw + ((size_t)((1 * 2 + 0) * 8 + h) * 128 + chl) * 128 + 32 * s + 8 * fq);
                                      bfx1[s] = *(const GAS bf16x8*)(gw + ((size_t)((1 * 2 + 1) * 8 + h) * 128 + chl) * 128 + 32 * s + 8 * fq); }
        {
#pragma unroll
            for (int j = 0; j < 4; ++j) asm volatile("" : "+v"(ba[j]), "+v"(bx[j]), "+v"(spl[j]));
            float prevP[4] = {1.f, 1.f, 1.f, 1.f}, prevL[4] = {0.f, 0.f, 0.f, 0.f};
#pragma unroll 1
            for (int mb = 0; mb < 16; ++mb) {
                f32x4 pa = {0.f, 0.f, 0.f, 0.f}, px = {0.f, 0.f, 0.f, 0.f};
#pragma unroll
                for (int s = 0; s < 4; ++s) { const bf16x8 af = *(const LAS bf16x8*)(Ut + (16 * mb + fr) * UP + (32 * s + 8 * fq) * 2);
                    pa = __builtin_amdgcn_mfma_f32_16x16x32_bf16(bfa[s], af, pa, 0, 0, 0); px = __builtin_amdgcn_mfma_f32_16x16x32_bf16(bfx[s], af, px, 0, 0, 0); }
                const u32x2 uw = *(const LAS u32x2*)(Ut + (16 * mb + fr) * UP + chl4 * 2);
                const float u[4] = {bflo(uw.x), bfhi(uw.x), bflo(uw.y), bfhi(uw.y)};
                float hout[4], pout[4];
                rnn_block_t<0>(pa, px, u, ba, bx, spl, fr, prevP, prevL, hout, pout);
                *(LAS u32x2*)(Rt + (16 * mb + fr) * 256 + chl4 * 2) = (u32x2){pk2(hout[0], hout[1]), pk2(hout[2], hout[3])};
                if (!isctx) __builtin_amdgcn_raw_buffer_store_b64((u32x2){pk2(pout[0], pout[1]), pk2(pout[2], pout[3])}, rsPf, (int)lane_off, (int)(tile_mt + (unsigned)mb * 4096u), 0);
            }
            if (fr == 15) {
#pragma unroll
                for (int j = 0; j < 4; ++j) agg[((size_t)0 * 264 + pm) * 1024 + ch4 + j] = (f32x2){prevP[j], prevL[j]}; }
        }
        f32x4 cwn = {0.f, 0.f, 0.f, 0.f}; bool havecw = false;
        { int pmn, hn2; bool okn; RNN_UNIT(ui + 1, pmn, hn2, okn);
          if (okn) {
#pragma unroll
              for (int i = 0; i < 8; ++i) { const int pc = F.tid + i * NTHREADS, r = pc >> 4, c16 = pc & 15; pre[i] = *(const GAS u32x4*)(zr + ((size_t)hn2 * MT + (size_t)pmn * 256 + r) * 128 + c16 * 8); }
              if (F.tid < 160) { const int k = F.tid >> 5, c = (F.tid & 31) * 4; havecw = true;
                  cwn = k < 4 ? *(const GAS f32x4*)(p.conv_w + k * 1024 + hn2 * 128 + c) : *(const GAS f32x4*)(p.conv_b + hn2 * 128 + c); } } }
        {
#pragma unroll
            for (int j = 0; j < 4; ++j) asm volatile("" : "+v"(ba1[j]), "+v"(bx1[j]), "+v"(spl1[j]));
            float prevP[4] = {1.f, 1.f, 1.f, 1.f}, prevL[4] = {0.f, 0.f, 0.f, 0.f};
#pragma unroll 1
            for (int mb = 15; mb >= 0; --mb) {
                f32x4 pa = {0.f, 0.f, 0.f, 0.f}, px = {0.f, 0.f, 0.f, 0.f};
#pragma unroll
                for (int s = 0; s < 4; ++s) { const bf16x8 af = *(const LAS bf16x8*)(Ut + (16 * mb + fr) * UP + (32 * s + 8 * fq) * 2);
                    pa = __builtin_amdgcn_mfma_f32_16x16x32_bf16(bfa1[s], af, pa, 0, 0, 0); px = __builtin_amdgcn_mfma_f32_16x16x32_bf16(bfx1[s], af, px, 0, 0, 0); }
                const u32x2 uw = *(const LAS u32x2*)(Ut + (16 * mb + fr) * UP + chl4 * 2);
                const float u[4] = {bflo(uw.x), bfhi(uw.x), bflo(uw.y), bfhi(uw.y)};
                float hout[4], pout[4];
                rnn_block_t<1>(pa, px, u, ba1, bx1, spl1, fr, prevP, prevL, hout, pout);
                const u32x2 hw = *(const LAS u32x2*)(Rt + (16 * mb + fr) * 256 + chl4 * 2);
                if (!isctx) {
                    __builtin_amdgcn_raw_buffer_store_b64((u32x2){pk2(bflo(hw.x) + hout[0], bfhi(hw.x) + hout[1]), pk2(bflo(hw.y) + hout[2], bfhi(hw.y) + hout[3])}, rsS, (int)lane_off, (int)(tile_mt + (unsigned)mb * 4096u), 0);
                    __builtin_amdgcn_raw_buffer_store_b64((u32x2){pk2(pout[0], pout[1]), pk2(pout[2], pout[3])}, rsPb, (int)lane_off, (int)(tile_t + (unsigned)mb * 4096u), 0); }
            }
            if (fr == 0) {
#pragma unroll
                for (int j = 0; j < 4; ++j) agg[((size_t)1 * 264 + pm) * 1024 + ch4 + j] = (f32x2){prevP[j], prevL[j]}; }
        }
        if (havecw) *(LAS f32x4*)(cwt + ((ui + 1) & 1) * 640 + (F.tid >> 5) * 128 + (F.tid & 31) * 4) = cwn;
    }
#undef RNN_UNIT
}
__device__ __forceinline__ void p3c_carries(const Params& p, Frame& F) {
    const f32x2* agg = (const f32x2*)(p.ws + WS_AGG); float* car = (float*)(p.ws + WS_AGG + AGG_CAR);
    for (int i = F.bid * NTHREADS + F.tid; i < 2 * NB * 1024; i += F.G * NTHREADS) {
        const int d = i >> 13, b = (i >> 10) & 7, ch = i & 1023;
        float c = agg[((size_t)d * 264 + 256 + b) * 1024 + ch].y;
        for (int s = 0; s < 32; ++s) { const int j = d ? 31 - s : s; const size_t t = (size_t)b * 32 + j;
            car[((size_t)d * 256 + t) * 1024 + ch] = c; const f32x2 a = agg[((size_t)d * 264 + t) * 1024 + ch]; c = a.x * c + a.y; }
    }
}
__device__ __forceinline__ void p4_yg_fast(const Params& p, Frame& F) {
    const bf16_t* S = (const bf16_t*)(p.ws + WS_B2); const bf16_t* Pf = (const bf16_t*)(p.ws + WS_B0); const bf16_t* Pb = (const bf16_t*)(p.ws + WS_B6); const bf16_t* G = (const bf16_t*)(p.ws + WS_B3);
    bf16_t* yg = (bf16_t*)(p.ws + WS_B1);
    const float* car = (const float*)(p.ws + WS_AGG + AGG_CAR);
    const int cg = F.tid & 127, ro = F.tid >> 7, hh = cg >> 4, cw = (cg & 15) * 8;
    for (int pm = F.bid; pm < 256; pm += F.G) {
        float cf[8], cb[8];
#pragma unroll
        for (int c = 0; c < 8; ++c) { cf[c] = car[((size_t)0 * 256 + pm) * 1024 + cg * 8 + c]; cb[c] = car[((size_t)1 * 256 + pm) * 1024 + cg * 8 + c]; }
#pragma unroll 4
        for (int rr = 0; rr < 64; ++rr) { const size_t row = (size_t)pm * 256 + ro + 4 * rr;
            const size_t om = ((size_t)hh * MT + row) * 128 + cw, ot = ((size_t)hh * T + row) * 128 + cw;
            const u32x4 s = *(const GAS u32x4*)(S + om), f = *(const GAS u32x4*)(Pf + om), b = *(const GAS u32x4*)(Pb + ot), g = *(const GAS u32x4*)(G + ot);
            u32x4 o;
            o.x = pk2((bflo(s.x) + bflo(f.x) * cf[0] + bflo(b.x) * cb[0]) * bflo(g.x), (bfhi(s.x) + bfhi(f.x) * cf[1] + bfhi(b.x) * cb[1]) * bfhi(g.x));
            o.y = pk2((bflo(s.y) + bflo(f.y) * cf[2] + bflo(b.y) * cb[2]) * bflo(g.y), (bfhi(s.y) + bfhi(f.y) * cf[3] + bfhi(b.y) * cb[3]) * bfhi(g.y));
            o.z = pk2((bflo(s.z) + bflo(f.z) * cf[4] + bflo(b.z) * cb[4]) * bflo(g.z), (bfhi(s.z) + bfhi(f.z) * cf[5] + bfhi(b.z) * cb[5]) * bfhi(g.z));
            o.w = pk2((bflo(s.w) + bflo(f.w) * cf[6] + bflo(b.w) * cb[6]) * bflo(g.w), (bfhi(s.w) + bfhi(f.w) * cf[7] + bfhi(b.w) * cb[7]) * bfhi(g.w));
            *(GAS u32x4*)(yg + row * 1024 + cg * 8) = o; }
    }
}

typedef short s16x4 __attribute__((ext_vector_type(4)));
__device__ __forceinline__ unsigned dft_offb(unsigned row, unsigned ch) { return 256u * row + 16u * (ch ^ (((row & 3u) << 2) | ((row >> 2) & 3u))); }
__device__ __forceinline__ unsigned dft_tr_addr(unsigned lane, unsigned c, unsigned ks, unsigned t) {
    const unsigned g = lane >> 4, q = (lane & 15u) >> 2, p = lane & 3u;
    return dft_offb(32u * ks + 8u * g + 4u * t + q, 2u * c + (p >> 1)) + 8u * (p & 1u);
}
template <int STAGE, int NIMG> __device__ __forceinline__ void dft_fast(const Params& p, Frame& F) {
    constexpr int NK = STAGE == 0 ? 128 : 256, NKS = NK / 32, IMG = NK * 256, MBW = NIMG * 4, NPC = 16 * NIMG  , DSP = NIMG * 256 + 16  ;
    constexpr int STG = (NK * 256 * NIMG + 128 * DSP <= 147456) ? NK * 256 * NIMG : 0;
    LAS unsigned char* X = F.lds; LAS unsigned char* St = F.lds + STG;
    bf16_t* V = (bf16_t*)(p.ws + WS_B1); bf16_t* Y = (bf16_t*)(p.ws + WS_B7);
    const int fr = F.lane & 15, fq = F.lane >> 4, q = F.wave & 3, mb0 = (F.wave >> 2) * MBW;
    bf16x8 bfr[2][NKS];
    { const bf16_t* mm = (const bf16_t*)(p.ws + WS_DFTM) + (STAGE == 0 ? 0 : 128 * 128);
#pragma unroll
      for (int o = 0; o < 2; ++o)
#pragma unroll
          for (int ks = 0; ks < NKS; ++ks) bfr[o][ks] = *(const bf16x8*)(mm + (size_t)(o * 64 + 16 * q + fr) * NK + 32 * ks + 8 * fq); }
    unsigned tra[2], xe[2];
#pragma unroll
    for (int t = 0; t < 2; ++t) { const unsigned g = (unsigned)F.lane >> 4, qq = ((unsigned)F.lane & 15u) >> 2, pp = (unsigned)F.lane & 3u, row = 8u * g + 4u * t + qq;
        const unsigned x = ((row & 3u) << 2) | ((row >> 2) & 3u); xe[t] = x & 14u; tra[t] = 256u * row + 16u * ((pp >> 1) ^ (x & 1u)) + 8u * (pp & 1u); }
    constexpr int NS = 512 / (128 * NIMG);
    const int nunits = (STAGE == 0 ? NB * 128 : NB * 64) * NS;
    int u0 = F.bid, ustride = F.G, ulimit = nunits;
    if (STAGE == 0 && F.G == 256) { if (F.bid < 64) { ustride = 64; ulimit = 576; } else { u0 = 576 + F.bid - 64; ustride = 192; } }
    constexpr int NLD = NK * NPC / NTHREADS;
    u32x4 pre[NLD];
    auto unit_decode = [&](int unit, int& b, int& a1, int& slab) { slab = unit % NS; const int rest = unit / NS; if (STAGE == 0) { b = rest >> 7; a1 = rest & 127; } else { b = rest >> 6; a1 = rest & 63; } };
    if (u0 < ulimit) { int b, a1, slab; unit_decode(u0, b, a1, slab);
#pragma unroll
        for (int i = 0; i < NLD; ++i) { const int pc = F.tid + i * NTHREADS, k = pc / NPC, c32 = pc % NPC, ri = k / (NK / 2), idx = k % (NK / 2);
            const size_t srow = (size_t)b * SEQ + (STAGE == 0 ? 128 * idx + a1 : 128 * a1 + idx);
            pre[i] = *(const GAS u32x4*)(V + srow * 1024 + ri * 512 + slab * (128 * NIMG) + c32 * 8); } }
    for (int unit = u0; unit < ulimit; unit += ustride) {
        int b, a1, slab; unit_decode(unit, b, a1, slab);
        __syncthreads();
#pragma unroll
        for (int i = 0; i < NLD; ++i) { const int pc = F.tid + i * NTHREADS, k = pc / NPC, c32 = pc % NPC;
            *(LAS u32x4*)(X + (c32 >> 4) * IMG + dft_offb((unsigned)k, (unsigned)(c32 & 15))) = pre[i]; }
        __syncthreads();
        if (unit + ustride < ulimit) { int nb, na1, nslab; unit_decode(unit + ustride, nb, na1, nslab);
#pragma unroll
            for (int i = 0; i < NLD; ++i) { const int pc = F.tid + i * NTHREADS, k = pc / NPC, c32 = pc % NPC, ri = k / (NK / 2), idx = k % (NK / 2);
                const size_t srow = (size_t)nb * SEQ + (STAGE == 0 ? 128 * idx + na1 : 128 * na1 + idx);
                pre[i] = *(const GAS u32x4*)(V + srow * 1024 + ri * 512 + nslab * (128 * NIMG) + c32 * 8); } }
        f32x4 acc[MBW][2];
#pragma unroll
        for (int mb = 0; mb < MBW; ++mb) { acc[mb][0] = (f32x4){0.f, 0.f, 0.f, 0.f}; acc[mb][1] = (f32x4){0.f, 0.f, 0.f, 0.f}; }
        LAS unsigned char* Xi = X + ((mb0 * 16) >> 7) * IMG; const unsigned c0 = (unsigned)(mb0 & 7);
#pragma unroll
        for (int ks = 0; ks < NKS; ++ks) {
#pragma unroll
            for (int mb = 0; mb < MBW; ++mb) {
                const s16x4 lo = __builtin_amdgcn_ds_read_tr16_b64_v4i16((LAS s16x4*)(Xi + ks * 8192 + tra[0] + 16u * ((2u * (c0 + mb)) ^ xe[0])));
                const s16x4 hi = __builtin_amdgcn_ds_read_tr16_b64_v4i16((LAS s16x4*)(Xi + ks * 8192 + tra[1] + 16u * ((2u * (c0 + mb)) ^ xe[1])));
                const bf16x8 af = {lo[0], lo[1], lo[2], lo[3], hi[0], hi[1], hi[2], hi[3]};
                acc[mb][0] = __builtin_amdgcn_mfma_f32_16x16x32_bf16(af, bfr[0][ks], acc[mb][0], 0, 0, 0);
                acc[mb][1] = __builtin_amdgcn_mfma_f32_16x16x32_bf16(af, bfr[1][ks], acc[mb][1], 0, 0, 0);
            }
            __builtin_amdgcn_sched_barrier(0);
        }
        if (STG == 0) __syncthreads();
        float tc = 1.f, ts = 0.f;
        if (STAGE == 0) sincospif((float)((16 * q + fr) * a1) / 4096.0f, &ts, &tc);
#pragma unroll
        for (int mb = 0; mb < MBW; ++mb) { f32x4 r0 = acc[mb][0], r1 = acc[mb][1];
            if (STAGE == 0) { const f32x4 tr = r0, ti = r1; r0 = tr * tc + ti * ts; r1 = ti * tc - tr * ts; }
            u32x2 w0, w1; w0.x = pk2(r0[0], r0[1]); w0.y = pk2(r0[2], r0[3]); w1.x = pk2(r1[0], r1[1]); w1.y = pk2(r1[2], r1[3]);
            *(LAS u32x2*)(St + (16 * q + fr) * DSP + (16 * (mb0 + mb) + 4 * fq) * 2) = w0;
            *(LAS u32x2*)(St + (64 + 16 * q + fr) * DSP + (16 * (mb0 + mb) + 4 * fq) * 2) = w1; }
        asm volatile("s_waitcnt lgkmcnt(0)" ::: "memory"); __builtin_amdgcn_s_barrier(); asm volatile("" ::: "memory");
#pragma unroll
        for (int i = 0; i < 128 * NPC / NTHREADS; ++i) { const int pc = F.tid + i * NTHREADS, row = pc / NPC, c32 = pc % NPC;
            const u32x4 v = *(const LAS u32x4*)(St + row * DSP + c32 * 16);
            if (STAGE == 0) { const int ri = row >> 6, k1 = row & 63; *(GAS u32x4*)(V + ((size_t)b * SEQ + 128 * k1 + a1) * 1024 + ri * 512 + slab * (128 * NIMG) + c32 * 8) = v; }
            else *(GAS u32x4*)(Y + ((size_t)b * SEQ + a1 + 64 * row) * 512 + slab * (128 * NIMG) + c32 * 8) = v; }
    }
}

__device__ __forceinline__ void dft_stageA_u(const Params& p, Frame& F) {
    constexpr int UPI = 272, IMG = 128 * 256, DSP = 272;
    LAS unsigned char* Ul = F.lds; LAS unsigned char* X = F.lds + 17408; LAS unsigned char* St = F.lds + 17408 + IMG;
    const bf16_t* ZF = (const bf16_t*)(p.ws + WS_B7); bf16_t* Tb = (bf16_t*)(p.ws + WS_B1);
    const int fr = F.lane & 15, fq = F.lane >> 4, q = F.wave & 3, mb0 = (F.wave >> 2) * 4;
    bf16x8 bfr[2][4], mfr0[2][4];
    { const bf16_t* mm = (const bf16_t*)(p.ws + WS_DFTM); const bf16_t* m0 = mm + 128 * 128 + 128 * 256;
#pragma unroll
      for (int o = 0; o < 2; ++o)
#pragma unroll
          for (int ks = 0; ks < 4; ++ks) { bfr[o][ks] = *(const bf16x8*)(mm + (size_t)(o * 64 + 16 * q + fr) * 128 + 32 * ks + 8 * fq);
                                           mfr0[o][ks] = *(const bf16x8*)(m0 + (size_t)(32 * F.wave + 16 * o + fr) * 128 + 32 * ks + 8 * fq); } }
    unsigned tra[2], xe[2];
#pragma unroll
    for (int t = 0; t < 2; ++t) { const unsigned g = (unsigned)F.lane >> 4, qq = ((unsigned)F.lane & 15u) >> 2, pp = (unsigned)F.lane & 3u, row = 8u * g + 4u * t + qq;
        const unsigned x = ((row & 3u) << 2) | ((row >> 2) & 3u); xe[t] = x & 14u; tra[t] = 256u * row + 16u * ((pp >> 1) ^ (x & 1u)) + 8u * (pp & 1u); }
    const int nunits = NB * 128 * 4;
    int u0 = F.bid, ustride = F.G, ulimit = nunits;
    if (F.G == 256) { if (F.bid < 64) { ustride = 64; ulimit = 576; } else { u0 = 576 + F.bid - 64; ustride = 192; } }
    u32x4 pre[2];
    if (u0 < ulimit) { const int g = u0 & 3, rest = u0 >> 2, b = rest >> 7, l2 = rest & 127;
#pragma unroll
        for (int i = 0; i < 2; ++i) { const int pc = F.tid + i * NTHREADS, l1 = pc >> 4, c16 = pc & 15;
            pre[i] = *(const GAS u32x4*)(ZF + ((size_t)b * SEQ + 128 * l1 + l2) * 512 + g * 128 + c16 * 8); } }
    for (int unit = u0; unit < ulimit; unit += ustride) {
        const int g = unit & 3, rest = unit >> 2, b = rest >> 7, l2 = rest & 127;
        __syncthreads();
#pragma unroll
        for (int i = 0; i < 2; ++i) { const int pc = F.tid + i * NTHREADS, l1 = pc >> 4, c16 = pc & 15; *(LAS u32x4*)(Ul + l1 * UPI + c16 * 16) = pre[i]; }
        __syncthreads();
        if (unit + ustride < ulimit) { const int nu = unit + ustride, ng = nu & 3, nrest = nu >> 2, nb = nrest >> 7, nl2 = nrest & 127;
#pragma unroll
            for (int i = 0; i < 2; ++i) { const int pc = F.tid + i * NTHREADS, l1 = pc >> 4, c16 = pc & 15;
                pre[i] = *(const GAS u32x4*)(ZF + ((size_t)nb * SEQ + 128 * l1 + nl2) * 512 + ng * 128 + c16 * 8); } }
        { f32x4 a1[2][4];
#pragma unroll
          for (int o = 0; o < 2; ++o)
#pragma unroll
              for (int lb = 0; lb < 4; ++lb) a1[o][lb] = (f32x4){0.f, 0.f, 0.f, 0.f};
#pragma unroll
          for (int ks = 0; ks < 4; ++ks)
#pragma unroll
              for (int lb = 0; lb < 4; ++lb) { const bf16x8 uf = *(const LAS bf16x8*)(Ul + (16 * lb + fr) * UPI + (32 * ks + 8 * fq) * 2);
                  a1[0][lb] = __builtin_amdgcn_mfma_f32_16x16x32_bf16(mfr0[0][ks], uf, a1[0][lb], 0, 0, 0);
                  a1[1][lb] = __builtin_amdgcn_mfma_f32_16x16x32_bf16(mfr0[1][ks], uf, a1[1][lb], 0, 0, 0); }
          const int ri = F.wave >> 2;
#pragma unroll
          for (int o = 0; o < 2; ++o)
#pragma unroll
              for (int lb = 0; lb < 4; ++lb) { const int m0 = (32 * F.wave + 16 * o + 4 * fq) & 127, k = ri * 64 + 16 * lb + fr;
                  *(LAS u32x2*)(X + dft_offb((unsigned)k, (unsigned)(m0 >> 3)) + (m0 & 7) * 2) = (u32x2){pk2(a1[o][lb][0], a1[o][lb][1]), pk2(a1[o][lb][2], a1[o][lb][3])}; }
        }
        __syncthreads();
        f32x4 acc[4][2];
#pragma unroll
        for (int mb = 0; mb < 4; ++mb) { acc[mb][0] = (f32x4){0.f, 0.f, 0.f, 0.f}; acc[mb][1] = (f32x4){0.f, 0.f, 0.f, 0.f}; }
        const unsigned c0 = (unsigned)(mb0 & 7);
#pragma unroll
        for (int ks = 0; ks < 4; ++ks) {
#pragma unroll
            for (int mb = 0; mb < 4; ++mb) {
                const s16x4 lo = __builtin_amdgcn_ds_read_tr16_b64_v4i16((LAS s16x4*)(X + ks * 8192 + tra[0] + 16u * ((2u * (c0 + mb)) ^ xe[0])));
                const s16x4 hi = __builtin_amdgcn_ds_read_tr16_b64_v4i16((LAS s16x4*)(X + ks * 8192 + tra[1] + 16u * ((2u * (c0 + mb)) ^ xe[1])));
                const bf16x8 af = {lo[0], lo[1], lo[2], lo[3], hi[0], hi[1], hi[2], hi[3]};
                acc[mb][0] = __builtin_amdgcn_mfma_f32_16x16x32_bf16(af, bfr[0][ks], acc[mb][0], 0, 0, 0);
                acc[mb][1] = __builtin_amdgcn_mfma_f32_16x16x32_bf16(af, bfr[1][ks], acc[mb][1], 0, 0, 0);
            }
            __builtin_amdgcn_sched_barrier(0);
        }
        float tc, ts; sincospif((float)((16 * q + fr) * l2) / 4096.0f, &ts, &tc);
#pragma unroll
        for (int mb = 0; mb < 4; ++mb) { const f32x4 tr = acc[mb][0], ti = acc[mb][1]; const f32x4 r0 = tr * tc + ti * ts, r1 = ti * tc - tr * ts;
            *(LAS u32x2*)(St + (16 * q + fr) * DSP + (16 * (mb0 + mb) + 4 * fq) * 2) = (u32x2){pk2(r0[0], r0[1]), pk2(r0[2], r0[3])};
            *(LAS u32x2*)(St + (64 + 16 * q + fr) * DSP + (16 * (mb0 + mb) + 4 * fq) * 2) = (u32x2){pk2(r1[0], r1[1]), pk2(r1[2], r1[3])}; }
        asm volatile("s_waitcnt lgkmcnt(0)" ::: "memory"); __builtin_amdgcn_s_barrier(); asm volatile("" ::: "memory");
#pragma unroll
        for (int i = 0; i < 4; ++i) { const int pc = F.tid + i * NTHREADS, row = pc >> 4, c16 = pc & 15, ri = row >> 6, k1 = row & 63;
            *(GAS u32x4*)(Tb + ((size_t)b * SEQ + 128 * k1 + l2) * 1024 + ri * 512 + g * 128 + c16 * 8) = *(const LAS u32x4*)(St + row * DSP + c16 * 16); }
    }
}

struct SchedPlain {
    static constexpr bool EVEC = false;
    unsigned lda, ldb; int nM, nN, G, c;
    __device__ __forceinline__ bool next(int i, pg8::Unit& u) const {
        const long L = (long)i * G + c; int pm, pn; if (!pg8::tile_order(L, nM, nN, pm, pn)) return false;
        u.pm = pm; u.pn = pn; u.aux = 0; u.A = (unsigned)pm * 256u * lda; u.B = (unsigned)pn * 256u * ldb; return true;
    }
};
struct EpiR {
    static constexpr bool PERM = true;
    const bf16_t* gate; bf16_t* out;
    __device__ __forceinline__ void operator()(const f32x4 (&acc)[2][2][4][2], const pg8::Unit& u, int wr, int wc, int fr, int fq, const LAS float* ev) const {
        const int row0 = u.pm * 256 + wr * 64 + fr, col0 = u.pn * 256 + wc * 32 + 8 * fq;
#pragma unroll
        for (int ai = 0; ai < 2; ++ai)
#pragma unroll
            for (int m = 0; m < 4; ++m) { const size_t off = (size_t)(row0 + ai * 128 + m * 16) * 1024 + col0;
#pragma unroll
                for (int bj = 0; bj < 2; ++bj) { const f32x4 v0 = acc[ai][bj][m][0], v1 = acc[ai][bj][m][1];
                    const u32x4 g = *(const u32x4*)(gate + off + bj * 128);
                    u32x4 w; w.x = cvt_pk_bf16(v0[0] * bflo(g.x), v0[1] * bfhi(g.x)); w.y = cvt_pk_bf16(v0[2] * bflo(g.y), v0[3] * bfhi(g.y));
                    w.z = cvt_pk_bf16(v1[0] * bflo(g.z), v1[1] * bfhi(g.z)); w.w = cvt_pk_bf16(v1[2] * bflo(g.w), v1[3] * bfhi(g.w));
                    *(u32x4*)(out + off + bj * 128) = w; } }
    }
};
struct EpiF {
    static constexpr bool PERM = true;
    const bf16_t* gate; const bf16_t* rp; bf16_t* out;
    __device__ __forceinline__ void operator()(const f32x4 (&acc)[2][2][4][2], const pg8::Unit& u, int wr, int wc, int fr, int fq, const LAS float* ev) const {
        const int row0 = u.pm * 256 + wr * 64 + fr, col0 = u.pn * 256 + wc * 32 + 8 * fq;
#pragma unroll
        for (int ai = 0; ai < 2; ++ai)
#pragma unroll
            for (int m = 0; m < 4; ++m) { const size_t off = (size_t)(row0 + ai * 128 + m * 16) * 1024 + col0;
#pragma unroll
                for (int bj = 0; bj < 2; ++bj) { const f32x4 v0 = acc[ai][bj][m][0], v1 = acc[ai][bj][m][1];
                    const u32x4 g = *(const u32x4*)(gate + off + bj * 128), r = *(const u32x4*)(rp + off + bj * 128);
                    u32x4 w; w.x = cvt_pk_bf16(v0[0] * bflo(g.x) + bflo(r.x), v0[1] * bfhi(g.x) + bfhi(r.x)); w.y = cvt_pk_bf16(v0[2] * bflo(g.y) + bflo(r.y), v0[3] * bfhi(g.y) + bfhi(r.y));
                    w.z = cvt_pk_bf16(v1[0] * bflo(g.z) + bflo(r.z), v1[1] * bfhi(g.z) + bfhi(r.z)); w.w = cvt_pk_bf16(v1[2] * bflo(g.w) + bflo(r.w), v1[3] * bfhi(g.w) + bfhi(r.w));
                    *(u32x4*)(out + off + bj * 128) = w; } }
    }
};
struct EpiO {
    static constexpr bool PERM = true;
    const float* x; const float* mod; bf16_t* out;
    __device__ __forceinline__ void operator()(const f32x4 (&acc)[2][2][4][2], const pg8::Unit& u, int wr, int wc, int fr, int fq, const LAS float* ev) const {
        const int row0 = u.pm * 256 + wr * 64 + fr, col0 = u.pn * 256 + wc * 32 + 8 * fq;
        const float* g1 = mod + (size_t)(u.pm >> 5) * 6144 + M_G1 * 1024;
        f32x4 gv[2][2];
#pragma unroll
        for (int bj = 0; bj < 2; ++bj)
#pragma unroll
            for (int n = 0; n < 2; ++n) gv[bj][n] = *(const f32x4*)(g1 + col0 + bj * 128 + n * 4);
#pragma unroll
        for (int ai = 0; ai < 2; ++ai)
#pragma unroll
            for (int m = 0; m < 4; ++m) { const size_t off = (size_t)(row0 + ai * 128 + m * 16) * 1024 + col0;
#pragma unroll
                for (int bj = 0; bj < 2; ++bj) { const f32x4 x0 = *(const f32x4*)(x + off + bj * 128), x1 = *(const f32x4*)(x + off + bj * 128 + 4);
                    const f32x4 v0 = x0 + gv[bj][0] * acc[ai][bj][m][0], v1 = x1 + gv[bj][1] * acc[ai][bj][m][1];
                    u32x4 w; w.x = cvt_pk_bf16(v0[0], v0[1]); w.y = cvt_pk_bf16(v0[2], v0[3]); w.z = cvt_pk_bf16(v1[0], v1[1]); w.w = cvt_pk_bf16(v1[2], v1[3]);
                    *(u32x4*)(out + off + bj * 128) = w; } }
    }
};

__device__ __forceinline__ void p7_route(const Params& p, Frame& F) {
    LAS bf16_t* At = (LAS bf16_t*)F.lds;
    LAS float* red = (LAS float*)(F.lds + 66560);
    LAS float* lg = (LAS float*)(F.lds + 99328);
    LAS int* etop = (LAS int*)(F.lds + 133120);
    LAS int* wcnt = etop + 1024;
    const float* mod = MODP(p.ws);
    unsigned char* hn = (unsigned char*)p.out + 128 * MiB;
    const bf16_t* x1b = (const bf16_t*)(p.ws + WS_B0);
    const bf16_t* wr = (const bf16_t*)(p.ws + WS_WROUT);
    unsigned char* rt = p.ws + WS_ROUTE;
    unsigned char* topi = rt + RT_TOPI; float* topw = (float*)(rt + RT_TOPW); unsigned short* rankl = (unsigned short*)(rt + RT_RANK); unsigned* hist = (unsigned*)(rt + RT_HIST);
    const int fr = F.lane & 15, fq = F.lane >> 4;
    bf16x8 breg[4][2];
#pragma unroll
    for (int s = 0; s < 4; ++s)
#pragma unroll
        for (int h2 = 0; h2 < 2; ++h2) breg[s][h2] = *(const bf16x8*)(wr + (size_t)(16 * h2 + fr) * 1024 + 128 * F.wave + 32 * s + 8 * fq);
    for (int blk = F.bid; blk < T / 256; blk += F.G) {
        const int t0 = blk * 256, b = t0 / SEQ;
        const float* sc = mod + b * 6144 + M_SC2 * 1024; const float* sh = mod + b * 6144 + M_SH2 * 1024;
        f32x4 gn[4], sf[4];
#pragma unroll
        for (int j = 0; j < 4; ++j) { const f32x4 g = ((const f32x4*)p.norm2)[F.lane + 64 * j], a = ((const f32x4*)sc)[F.lane + 64 * j]; gn[j] = g * (a + 1.0f); sf[j] = ((const f32x4*)sh)[F.lane + 64 * j]; }
        u32x2 n1[4][4], n2[4][4];
#pragma unroll
        for (int j2 = 0; j2 < 4; ++j2)
#pragma unroll
            for (int j = 0; j < 4; ++j) { n1[j2][j] = ((const GAS u32x2*)(x1b + (size_t)(t0 + 4 * F.wave + j2) * D) + F.lane)[64 * j];
                                          n2[j2][j] = ((const GAS u32x2*)(x1b + (size_t)(t0 + 32 + 4 * F.wave + j2) * D) + F.lane)[64 * j]; }
#pragma unroll 1
        for (int it = 0; it < 8; ++it) {
            const int r0 = t0 + 32 * it;
            u32x2 cx[4][4];
#pragma unroll
            for (int j2 = 0; j2 < 4; ++j2)
#pragma unroll
                for (int j = 0; j < 4; ++j) { cx[j2][j] = n1[j2][j]; n1[j2][j] = n2[j2][j];
                    if (it < 6) n2[j2][j] = ((const GAS u32x2*)(x1b + (size_t)(r0 + 64 + 4 * F.wave + j2) * D) + F.lane)[64 * j]; }
            float ssq[4];
#pragma unroll
            for (int j2 = 0; j2 < 4; ++j2) { float s = 0.f;
#pragma unroll
                for (int j = 0; j < 4; ++j) { const u32x2 w = cx[j2][j]; const float x0 = bflo(w.x), x1 = bfhi(w.x), x2 = bflo(w.y), x3 = bfhi(w.y); s += (x0 * x0 + x1 * x1) + (x2 * x2 + x3 * x3); }
                ssq[j2] = s; }
#pragma unroll
            for (int j2 = 0; j2 < 4; ++j2) ssq[j2] = wave_sum(ssq[j2], F.lane);
#pragma unroll
            for (int j2 = 0; j2 < 4; ++j2) {
                const int lr = 4 * F.wave + j2; const size_t row = (size_t)(r0 + lr);
                const float rs = 1.0f / sqrtf(ssq[j2] * (1.f / D) + EPS);
                GAS unsigned* o4 = (GAS unsigned*)(hn + row * D) + F.lane;
#pragma unroll
                for (int j = 0; j < 4; ++j) { const u32x2 w = cx[j2][j];
                    const float o0 = bflo(w.x) * rs * gn[j].x + sf[j].x, o1 = bfhi(w.x) * rs * gn[j].y + sf[j].y, o2 = bflo(w.y) * rs * gn[j].z + sf[j].z, o3 = bfhi(w.y) * rs * gn[j].w + sf[j].w;
                    const unsigned long long ww = (unsigned long long)pk2(o0, o1) | ((unsigned long long)pk2(o2, o3) << 32);
                    *(LAS unsigned long long*)(At + lr * 1032 + 4 * F.lane + 256 * j) = ww;
                    int q8 = 0; q8 = __builtin_amdgcn_cvt_pk_fp8_f32(o0, o1, q8, false); q8 = __builtin_amdgcn_cvt_pk_fp8_f32(o2, o3, q8, true);
                    o4[64 * j] = (unsigned)q8; }
            }
            asm volatile("s_waitcnt lgkmcnt(0)" ::: "memory"); __builtin_amdgcn_s_barrier(); asm volatile("" ::: "memory");
#pragma unroll
            for (int mt = 0; mt < 2; ++mt) {
                f32x4 a0 = {0.f, 0.f, 0.f, 0.f}, a1 = {0.f, 0.f, 0.f, 0.f};
#pragma unroll
                for (int s = 0; s < 4; ++s) { const bf16x8 af = *(const LAS bf16x8*)(At + (16 * mt + fr) * 1032 + 128 * F.wave + 32 * s + 8 * fq);
                    a0 = __builtin_amdgcn_mfma_f32_16x16x32_bf16(af, breg[s][0], a0, 0, 0, 0); a1 = __builtin_amdgcn_mfma_f32_16x16x32_bf16(af, breg[s][1], a1, 0, 0, 0); }
#pragma unroll
                for (int j = 0; j < 4; ++j) { red[(F.wave * 32 + 16 * mt + 4 * fq + j) * 32 + fr] = a0[j]; red[(F.wave * 32 + 16 * mt + 4 * fq + j) * 32 + 16 + fr] = a1[j]; }
            }
            asm volatile("s_waitcnt lgkmcnt(0)" ::: "memory"); __builtin_amdgcn_s_barrier(); asm volatile("" ::: "memory");
#pragma unroll
            for (int q = 0; q < 2; ++q) { const int row = (F.tid >> 5) + 16 * q, e = F.tid & 31; float s = p.b_router[e];
#pragma unroll
              for (int w = 0; w < 8; ++w) s += red[(w * 32 + row) * 32 + e];
              lg[(32 * it + row) * 33 + e] = s; }
        }
        __syncthreads();
        if (F.tid < 256) {
            const int row = F.tid; float v[4]; int ix[4]; unsigned used = 0u;
#pragma unroll
            for (int k = 0; k < 4; ++k) { float best = -3.0e38f; int bi = 0;
                for (int e = 0; e < 32; ++e) { const float x = lg[row * 33 + e]; if (!((used >> e) & 1u) && x > best) { best = x; bi = e; } }
                used |= 1u << bi; v[k] = best; ix[k] = bi; }
            const float e1 = __expf(v[1] - v[0]), e2 = __expf(v[2] - v[0]), e3 = __expf(v[3] - v[0]); const float inv = 1.0f / (1.0f + e1 + e2 + e3);
            const float w4[4] = {inv, e1 * inv, e2 * inv, e3 * inv};
            const size_t tok = (size_t)(t0 + row);
#pragma unroll
            for (int k = 0; k < 4; ++k) { topi[tok * 4 + k] = (unsigned char)ix[k]; topw[tok * 4 + k] = w4[k]; etop[row * 4 + k] = ix[k]; }
        }
        __syncthreads();
        const int a0i = 128 * F.wave + F.lane, a1i = a0i + 64; const int e0 = etop[a0i], e1 = etop[a1i]; int r0 = 0, r1 = 0;
        const unsigned long long lt = (1ull << F.lane) - 1ull;
#pragma unroll 1
        for (int e = 0; e < 32; ++e) { const unsigned long long m0 = __ballot(e0 == e), m1 = __ballot(e1 == e);
            if (e0 == e) r0 = __popcll(m0 & lt); if (e1 == e) r1 = __popcll(m0) + __popcll(m1 & lt);
            if (F.lane == 0) wcnt[F.wave * 32 + e] = __popcll(m0) + __popcll(m1); }
        __syncthreads();
        int b0 = 0, b1 = 0;
        for (int w = 0; w < F.wave; ++w) { b0 += wcnt[w * 32 + e0]; b1 += wcnt[w * 32 + e1]; }
        rankl[(size_t)t0 * 4 + a0i] = (unsigned short)(b0 + r0); rankl[(size_t)t0 * 4 + a1i] = (unsigned short)(b1 + r1);
        if (F.tid < 32) { int s = 0; for (int w = 0; w < 8; ++w) s += wcnt[w * 32 + F.tid]; hist[blk * 32 + F.tid] = (unsigned)s; }
        __syncthreads();
    }
}
__device__ __forceinline__ void p8_slots(const Params& p, Frame& F) {
    LAS int* tot = (LAS int*)F.lds; LAS int* base = tot + 32; LAS int* rup = tot + 64; LAS int* sp = tot + 96;
    unsigned char* rt = p.ws + WS_ROUTE;
    const unsigned char* topi = rt + RT_TOPI; const float* topw = (const float*)(rt + RT_TOPW); const unsigned short* rankl = (const unsigned short*)(rt + RT_RANK); const unsigned* hist = (const unsigned*)(rt + RT_HIST);
    int* slot_tok = (int*)(rt + RT_SLOTTOK); float* slot_w = (float*)(rt + RT_SLOTW); int* tok_slot = (int*)(rt + RT_TOKSLOT); int* tile_exp = (int*)(rt + RT_TILEEXP);
    unsigned* ctl = (unsigned*)(p.ws + WS_CTL);
    for (int blk = F.bid; blk < T / 256; blk += F.G) {
        const int half = blk >> 7;
        __syncthreads();
        { LAS int* part = tot + 1280; const int e = F.tid & 31, pt = F.tid >> 5; int t = 0, bs = 0;
#pragma unroll
          for (int q = 0; q < 8; ++q) { const int b2 = half * 128 + pt * 8 + q; const int h = (int)hist[b2 * 32 + e]; t += h; if (b2 < blk) bs += h; }
          part[pt * 32 + e] = t; part[512 + pt * 32 + e] = bs;
          __syncthreads();
          if (F.tid < 32) { int t2 = 0, b2s = 0;
#pragma unroll
              for (int q = 0; q < 16; ++q) { t2 += part[q * 32 + F.tid]; b2s += part[512 + q * 32 + F.tid]; }
              tot[F.tid] = t2; base[F.tid] = b2s; rup[F.tid] = (t2 + 255) & ~255; } }
        __syncthreads();
        if (F.tid < 33) { int s2 = 0;
#pragma unroll
            for (int e = 0; e < 32; ++e) { const int r = rup[e]; if (e < F.tid) s2 += r; }
            sp[F.tid] = s2; }
        __syncthreads();
        int* st = slot_tok + (size_t)half * PHALF; float* sw = slot_w + (size_t)half * PHALF;
#pragma unroll
        for (int q = 0; q < 2; ++q) { const int a = F.tid * 2 + q; const size_t ga = (size_t)blk * 1024 + a; const int e = topi[ga];
            const int slot = sp[e] + base[e] + (int)rankl[ga];
            st[slot] = (int)(ga >> 2); sw[slot] = topw[ga]; tok_slot[ga] = slot; }
        { LAS int* slotl = tot + 160;
          slotl[F.tid * 2] = sp[topi[(size_t)blk * 1024 + F.tid * 2]] + base[topi[(size_t)blk * 1024 + F.tid * 2]] + (int)rankl[(size_t)blk * 1024 + F.tid * 2];
          slotl[F.tid * 2 + 1] = sp[topi[(size_t)blk * 1024 + F.tid * 2 + 1]] + base[topi[(size_t)blk * 1024 + F.tid * 2 + 1]] + (int)rankl[(size_t)blk * 1024 + F.tid * 2 + 1];
          __syncthreads();
          const unsigned char* hn8 = (const unsigned char*)p.out + 128 * MiB; unsigned char* hs = p.ws + WS_HN8S + (size_t)half * PHALF * 1024;
#pragma unroll 8
          for (int i = 0; i < 32; ++i) { const int tl = F.wave * 32 + i; const u32x4 v = *(const GAS u32x4*)(hn8 + ((size_t)blk * 256 + tl) * 1024 + F.lane * 16);
#pragma unroll
              for (int k = 0; k < 4; ++k) *(GAS u32x4*)(hs + (size_t)slotl[tl * 4 + k] * 1024 + F.lane * 16) = v; }
        }
        if ((blk & 127) == 0) {
            if (F.tid == 0) ctl[CW_NTILES + half] = (unsigned)(sp[32] >> 8);
            for (int e = 0; e < 32; ++e) {
                for (int s = sp[e] + tot[e] + F.tid; s < sp[e] + rup[e]; s += NTHREADS) { st[s] = half * HALF_T; sw[s] = 0.f; }
                for (int t = (sp[e] >> 8) + F.tid; t < ((sp[e] + rup[e]) >> 8); t += NTHREADS) tile_exp[half * 1024 + t] = e;
            }
        }
    }
}
struct SchedG1 {
    static constexpr bool EVEC = true;
    const int* tile_exp; const float* b_gu; int ntiles, G, c;
    __device__ __forceinline__ bool next(int i, pg8::Unit& u) const {
        const long L = (long)i * G + c; int pm, pn; if (!pg8::tile_order(L, ntiles, 8, pm, pn)) return false;
        const int e = __builtin_amdgcn_readfirstlane(tile_exp[pm]); u.pm = pm; u.pn = pn; u.aux = e; u.A = (unsigned)pm * 256u * 1024u; u.B = ((unsigned)e * 2048u + (unsigned)pn * 256u) * 1024u; return true;
    }
    __device__ __forceinline__ float evec(const pg8::Unit& u, int i) const { return i < 256 ? b_gu[(size_t)u.aux * 2048 + (i >> 7) * 1024 + u.pn * 128 + (i & 127)] : 0.f; }
};
struct EpiG1 {
    static constexpr bool PERM = true;
    const float* b_gu; unsigned char* act;
    __device__ __forceinline__ void operator()(const f32x4 (&acc)[2][2][4][2], const pg8::Unit& u, int wr, int wc, int fr, int fq, const LAS float* ev) const {
        const int row0 = u.pm * 256 + wr * 64 + fr, col0 = u.pn * 128 + wc * 32 + 8 * fq;
        const int cl = wc * 32 + 8 * fq;
        const f32x4 bg0 = *(const LAS f32x4*)(ev + cl), bg1 = *(const LAS f32x4*)(ev + cl + 4), bu0 = *(const LAS f32x4*)(ev + 128 + cl), bu1 = *(const LAS f32x4*)(ev + 128 + cl + 4);
        const f32x2 bgp[4] = {{bg0.x, bg0.y}, {bg0.z, bg0.w}, {bg1.x, bg1.y}, {bg1.z, bg1.w}}, bup[4] = {{bu0.x, bu0.y}, {bu0.z, bu0.w}, {bu1.x, bu1.y}, {bu1.z, bu1.w}};
#pragma unroll
        for (int ai = 0; ai < 2; ++ai)
#pragma unroll
            for (int m = 0; m < 4; ++m) {
                float o[8];
#pragma unroll
                for (int q = 0; q < 4; ++q) { const f32x4 ag = acc[ai][0][m][q >> 1], au = acc[ai][1][m][q >> 1];
                    f32x2 g = (q & 1) ? (f32x2){ag.z, ag.w} : (f32x2){ag.x, ag.y}, u = (q & 1) ? (f32x2){au.z, au.w} : (f32x2){au.x, au.y};
                    g = g * 0.015625f + bgp[q]; u = u * 0.015625f + bup[q];
                    g.x = fminf(g.x, 7.0f); g.y = fminf(g.y, 7.0f); u.x = __builtin_amdgcn_fmed3f(u.x, -7.0f, 7.0f); u.y = __builtin_amdgcn_fmed3f(u.y, -7.0f, 7.0f);
                    f32x2 e = g * (-1.702f * 1.44269504f); e.x = __builtin_amdgcn_exp2f(e.x); e.y = __builtin_amdgcn_exp2f(e.y);
                    f32x2 d = e + 1.0f; d.x = __builtin_amdgcn_rcpf(d.x); d.y = __builtin_amdgcn_rcpf(d.y);
                    const f32x2 r = (u * g + g) * d;
                    o[2 * q] = r.x; o[2 * q + 1] = r.y; }
                int w0 = 0, w1 = 0; w0 = __builtin_amdgcn_cvt_pk_fp8_f32(o[0], o[1], w0, false); w0 = __builtin_amdgcn_cvt_pk_fp8_f32(o[2], o[3], w0, true);
                w1 = __builtin_amdgcn_cvt_pk_fp8_f32(o[4], o[5], w1, false); w1 = __builtin_amdgcn_cvt_pk_fp8_f32(o[6], o[7], w1, true);
                *(u32x2*)(act + (size_t)(row0 + ai * 128 + m * 16) * 1024 + col0) = (u32x2){(unsigned)w0, (unsigned)w1}; }
    }
};
struct SchedG2 {
    static constexpr bool EVEC = true;
    const int* tile_exp; const float* b_down; const float* slot_w; int ntiles, G, c;
    __device__ __forceinline__ bool next(int i, pg8::Unit& u) const {
        const long L = (long)i * G + c; int pm, pn; if (!pg8::tile_order(L, ntiles, 4, pm, pn)) return false;
        const int e = __builtin_amdgcn_readfirstlane(tile_exp[pm]); u.pm = pm; u.pn = pn; u.aux = e; u.A = (unsigned)pm * 256u * 1024u; u.B = ((unsigned)e * 1024u + (unsigned)pn * 256u) * 1024u; return true;
    }
    __device__ __forceinline__ float evec(const pg8::Unit& u, int i) const { return i < 256 ? b_down[(size_t)u.aux * 1024 + u.pn * 256 + i] : slot_w[u.pm * 256 + (i - 256)]; }
};
struct EpiG2 {
    static constexpr bool PERM = true;
    const float* b_down; const float* slot_w; unsigned char* outa;
    __device__ __forceinline__ void operator()(const f32x4 (&acc)[2][2][4][2], const pg8::Unit& u, int wr, int wc, int fr, int fq, const LAS float* ev) const {
        const int row0 = u.pm * 256 + wr * 64 + fr, col0 = u.pn * 256 + wc * 32 + 8 * fq;
        const int cl = wc * 32 + 8 * fq;
#pragma unroll
        for (int bj = 0; bj < 2; ++bj) { const f32x4 bv0 = *(const LAS f32x4*)(ev + bj * 128 + cl) * 16.0f, bv1 = *(const LAS f32x4*)(ev + bj * 128 + cl + 4) * 16.0f;
#pragma unroll
        for (int ai = 0; ai < 2; ++ai)
#pragma unroll
            for (int m = 0; m < 4; ++m) { const int row = row0 + ai * 128 + m * 16; const float sw = ev[256 + ai * 128 + wr * 64 + m * 16 + fr];
                const f32x4 v0 = (acc[ai][bj][m][0] * 0.25f + bv0) * sw, v1 = (acc[ai][bj][m][1] * 0.25f + bv1) * sw;
                int w0 = 0, w1 = 0; w0 = __builtin_amdgcn_cvt_pk_fp8_f32(v0[0], v0[1], w0, false); w0 = __builtin_amdgcn_cvt_pk_fp8_f32(v0[2], v0[3], w0, true);
                w1 = __builtin_amdgcn_cvt_pk_fp8_f32(v1[0], v1[1], w1, false); w1 = __builtin_amdgcn_cvt_pk_fp8_f32(v1[2], v1[3], w1, true);
                *(GAS u32x2*)(outa + (size_t)row * 1024 + col0 + bj * 128) = (u32x2){(unsigned)w0, (unsigned)w1}; } }
    }
};
__device__ __forceinline__ void p11_combine(const Params& p, Frame& F, int half) {
    const float* mod = MODP(p.ws); const int* tok_slot = (const int*)(p.ws + WS_ROUTE + RT_TOKSLOT); const bf16_t* x1b = (const bf16_t*)(p.ws + WS_B0);
    const unsigned char* outa = half ? p.ws + WS_HN8S + (size_t)PHALF * 1024 : p.ws + WS_OUTA;
    const int gw = F.bid * NWAVES + F.wave, ngw = F.G * NWAVES;
    const int col = 16 * F.lane;
    for (int m = half * HALF_T + gw; m < (half + 1) * HALF_T; m += ngw) {
        const float* g2 = mod + (size_t)(m / SEQ) * 6144 + M_G2 * 1024;
        const GAS int* tsg = (const GAS int*)tok_slot + (size_t)m * 4; const int s0 = tsg[0], s1 = tsg[1], s2 = tsg[2], s3 = tsg[3];
        const u32x4 a = *(const GAS u32x4*)(outa + (size_t)s0 * 1024 + col), b = *(const GAS u32x4*)(outa + (size_t)s1 * 1024 + col),
                    c = *(const GAS u32x4*)(outa + (size_t)s2 * 1024 + col), d = *(const GAS u32x4*)(outa + (size_t)s3 * 1024 + col);
        const u32x4 xa = *(const GAS u32x4*)(x1b + (size_t)m * 1024 + col), xb = *(const GAS u32x4*)(x1b + (size_t)m * 1024 + col + 8);
        const unsigned aw[4] = {a.x, a.y, a.z, a.w}, bw[4] = {b.x, b.y, b.z, b.w}, cw[4] = {c.x, c.y, c.z, c.w}, dw[4] = {d.x, d.y, d.z, d.w};
        const unsigned xw[8] = {xa.x, xa.y, xa.z, xa.w, xb.x, xb.y, xb.z, xb.w};
        float v[16]; float ss = 0.f;
#pragma unroll
        for (int q = 0; q < 4; ++q) {
            const f32x4 gg = *(const GAS f32x4*)(g2 + col + 4 * q);
            const f32x2 lo = (__builtin_amdgcn_cvt_pk_f32_fp8((int)aw[q], false) + __builtin_amdgcn_cvt_pk_f32_fp8((int)bw[q], false)) + (__builtin_amdgcn_cvt_pk_f32_fp8((int)cw[q], false) + __builtin_amdgcn_cvt_pk_f32_fp8((int)dw[q], false));
            const f32x2 hi = (__builtin_amdgcn_cvt_pk_f32_fp8((int)aw[q], true) + __builtin_amdgcn_cvt_pk_f32_fp8((int)bw[q], true)) + (__builtin_amdgcn_cvt_pk_f32_fp8((int)cw[q], true) + __builtin_amdgcn_cvt_pk_f32_fp8((int)dw[q], true));
            v[4 * q + 0] = bflo(xw[2 * q]) + gg.x * 0.0625f * lo.x; v[4 * q + 1] = bfhi(xw[2 * q]) + gg.y * 0.0625f * lo.y;
            v[4 * q + 2] = bflo(xw[2 * q + 1]) + gg.z * 0.0625f * hi.x; v[4 * q + 3] = bfhi(xw[2 * q + 1]) + gg.w * 0.0625f * hi.y;
            ss += (v[4 * q] * v[4 * q] + v[4 * q + 1] * v[4 * q + 1]) + (v[4 * q + 2] * v[4 * q + 2] + v[4 * q + 3] * v[4 * q + 3]); }
        const float rs = 1.0f / sqrtf(wave_sum(ss, F.lane) * (1.f / D) + EPS);
#pragma unroll
        for (int q = 0; q < 4; ++q) { const f32x4 na = *(const GAS f32x4*)(p.norm_f + col + 4 * q);
            *(GAS f32x4*)(p.out + (size_t)m * D + col + 4 * q) = (f32x4){v[4 * q] * rs * na.x, v[4 * q + 1] * rs * na.y, v[4 * q + 2] * rs * na.z, v[4 * q + 3] * rs * na.w}; }
    }
}

constexpr int NPHASES = 14;
__global__ void __launch_bounds__(NTHREADS, 2) fwd_kernel(Params p_arg) {
    extern __shared__ __attribute__((aligned(16))) unsigned char lds_raw[];
    Frame F; F.lds = (LAS unsigned char*)lds_raw; F.tid = threadIdx.x; F.lane = F.tid & 63; F.wave = __builtin_amdgcn_readfirstlane(F.tid >> 6); F.G = gridDim.x; F.bid = blockIdx.x; F.pacc = 0ull;
    typedef const unsigned long long __attribute__((address_space(4))) cu64;
    cu64* kp = (cu64*)__builtin_amdgcn_kernarg_segment_ptr();
    (void)p_arg;
    static_assert(sizeof(Params) % 8 == 0, "Params is a whole number of 8-byte words");
    Params p;
#define LOADP() do { unsigned long long* d_ = (unsigned long long*)&p; _Pragma("unroll") for (int i_ = 0; i_ < (int)(sizeof(Params) / 8); ++i_) d_[i_] = kp[i_]; } while (0)
    LOADP();
    const int kwave = F.wave;
    volatile LAS unsigned* misc = (volatile LAS unsigned*)(F.lds + LDS_MISC);
    if (F.tid < 64) misc[F.tid] = 0u;
    __syncthreads();
    unsigned char* ws = p.ws;
    unsigned* ctl = (unsigned*)(ws + WS_CTL);
    const int lo = p.ph_lo, hi = p.ph_hi;
    XcdBarrier bar; bar.bar = ctl + CW_BAR; bar.x = 0; bar.st = nullptr;
    if (hi - lo > 1) bar = xcd_barrier_post(ctl + CW_BAR, misc + 8);
#ifdef ONLY_PHASE
#define IN(k) ((k) == ONLY_PHASE && lo <= (k) && (k) < hi)
#else
#define IN(k) (lo <= (k) && (k) < hi)
#endif
#ifdef PROBE_PHASE
    volatile LAS unsigned long long* pr_ts = (volatile LAS unsigned long long*)(F.lds + LDS_MISC + 64);
    if (threadIdx.x == 0) { pr_ts[0] = __builtin_amdgcn_s_memrealtime(); pr_ts[1] = 0ull; }
#define SEAM(k) do { if (IN(k) && IN((k) + 1)) xcd_barrier(bar); if (threadIdx.x == 0) { if ((k) + 1 == PROBE_PHASE) pr_ts[0] = __builtin_amdgcn_s_memrealtime(); if ((k) == PROBE_PHASE) pr_ts[1] = __builtin_amdgcn_s_memrealtime(); } } while (0)
#else
#define SEAM(k) do { if (IN(k) && IN((k) + 1)) xcd_barrier(bar); } while (0)
#endif
#define PH() do { int l_; asm volatile("v_mbcnt_lo_u32_b32 %0, -1, 0\n\tv_mbcnt_hi_u32_b32 %0, -1, %0" : "=v"(l_)); const int t_ = kwave * 64 + l_; F.tid = t_; F.lane = l_; F.wave = kwave; asm volatile("" : "+s"(kp)); LOADP(); ws = p.ws; } while (0)

    if (IN(0)) { PH(); p0_ada(p, F); }
    SEAM(0);
    if (IN(1)) { PH(); p1_norm(p, F); __syncthreads(); p0_weights(p, F); }
    SEAM(1);
    if (IN(2)) { PH();
#ifdef DRY_P2
        { Sched2 S{F.G, F.bid}; EpiNull E{(float*)(ws + WS_AGG)};
          pg8::gemm_phase<EpiNull, Sched2, false, false, DRY_P2>(F.lds, F.tid, S, E, 16, 2048u, 2048u, ws + WS_B0, ws + WS_WCAT); }
#endif
        Sched2 S{F.G, F.bid}; Epi2 E{ws, 1.0f};
        pg8::gemm_phase<Epi2, Sched2, false>(F.lds, F.tid, S, E, 16, 2048u, 2048u, ws + WS_B0, ws + WS_WCAT);
#if GATES_F8
        { Sched2G S8{F.G, F.bid}; Epi2 E8{ws, 0.015625f};
          pg8::gemm_phase<Epi2, Sched2G, false, true>(F.lds, F.tid, S8, E8, 8, 1024u, 1024u, ws + WS_B1, ws + WS_ROUTE); }
#endif
    }
    SEAM(2);
    if (IN(3)) { PH(); p3_rnn_fast(p, F);
#if UNFOLD_CH
        dft_stageA_u(p, F);
#else
        dft_fast<0, 1>(p, F);
#endif
    }
    SEAM(3);
    if (IN(4)) { PH(); p3c_carries(p, F); dft_fast<1, 1>(p, F); }
    SEAM(4);
    if (IN(5)) { PH();
        if (F.bid & 1) p4_yg_fast(p, F);
        { SchedPlain S{1024, 1024, 256, 4, F.G, F.bid};
          EpiR E{(const bf16_t*)(ws + WS_B4), (bf16_t*)(ws + WS_B4)};
          pg8::gemm_phase<EpiR, SchedPlain, false>(F.lds, F.tid, S, E, 8, 1024u, 1024u, ws + WS_B7, ws + WS_WF); }
        if (!(F.bid & 1)) p4_yg_fast(p, F);
    }
    SEAM(5);
    if (IN(6)) { PH();
        SchedPlain S{2048, 2048, 256, 4, F.G, F.bid};
        EpiF E{(const bf16_t*)(ws + WS_B5), (const bf16_t*)(ws + WS_B4), (bf16_t*)(ws + WS_B2)};
        pg8::gemm_phase<EpiF, SchedPlain, false>(F.lds, F.tid, S, E, 16, 2048u, 2048u, ws + WS_B1, ws + WS_WR);
    }
    SEAM(6);
    if (IN(7)) { PH();
        if (F.bid & 1) { p_moe_weights(p, F); __syncthreads(); }
        SchedPlain S{2048, 2048, 256, 4, F.G, F.bid};
        EpiO E{p.x, MODP(ws), (bf16_t*)(ws + WS_B0)};
        pg8::gemm_phase<EpiO, SchedPlain, false>(F.lds, F.tid, S, E, 16, 2048u, 2048u, ws + WS_B2, ws + WS_WO);
        if (!(F.bid & 1)) p_moe_weights(p, F);
    }
    SEAM(7);
    if (IN(8)) { PH(); p7_route(p, F); }
    SEAM(8);
    if (IN(9)) { PH(); p8_slots(p, F); }
    SEAM(9);
#pragma unroll 1
    for (int st = 0; st < 4; ++st) {
        const int ph = 10 + st;
        const bool doG1 = st < 2, doG2 = (st == 1 || st == 2), doC = st >= 2;
        const int h1 = st, h2 = st - 1, hc = st - 2;
        if (IN(ph)) { PH();
            if (doC && !(doG2 && (F.bid & 1))) p11_combine(p, F, hc);
            int crot = F.bid;
            if (doG2) {
                const float* slot_w = (const float*)(ws + WS_ROUTE + RT_SLOTW) + (size_t)h2 * PHALF;
                const int* tile_exp = (const int*)(ws + WS_ROUTE + RT_TILEEXP) + h2 * 1024;
                const int ntiles = __builtin_amdgcn_readfirstlane((int)ctl[CW_NTILES + h2]);
                SchedG2 S{tile_exp, p.b_down, slot_w, ntiles, F.G, F.bid};
                EpiG2 E{p.b_down, slot_w, h2 ? ws + WS_HN8S + (size_t)PHALF * 1024 : ws + WS_OUTA};
                pg8::gemm_phase<EpiG2, SchedG2, false, true>(F.lds, F.tid, S, E, 8, 1024u, 1024u, h2 ? ws + WS_HN8S : ws + WS_ACT, ws + WS_WD);
                crot = (F.bid + F.G - (ntiles * 4) % F.G) % F.G;
            }
            if (doG1) {
                const int* tile_exp = (const int*)(ws + WS_ROUTE + RT_TILEEXP) + h1 * 1024;
                const int ntiles = __builtin_amdgcn_readfirstlane((int)ctl[CW_NTILES + h1]);
                SchedG1 S{tile_exp, p.b_gu, ntiles, F.G, crot};
                EpiG1 E{p.b_gu, h1 ? ws + WS_HN8S : ws + WS_ACT};
                pg8::gemm_phase<EpiG1, SchedG1, false, true>(F.lds, F.tid, S, E, 8, 1024u, 1024u, ws + WS_HN8S + (size_t)h1 * PHALF * 1024, ws + WS_WGU);
            }
            if (doC && doG2 && (F.bid & 1)) p11_combine(p, F, hc);
        }
        SEAM(ph);
    }
#ifdef PROBE_SEL
    if (F.bid == 0 && threadIdx.x == 0) { const unsigned long long span = (F.pacc + PT_LDS[1]) * PROBE_MULT, tb = __builtin_amdgcn_s_memrealtime();
        while (__builtin_amdgcn_s_memrealtime() - tb < span) __builtin_amdgcn_s_sleep(8); }
#endif
#ifdef PROBE_PHASE
    if (F.bid == 0 && threadIdx.x == 0) { const unsigned long long span = (pr_ts[1] - pr_ts[0]) * PROBE_MULT, tb = __builtin_amdgcn_s_memrealtime();
        while (__builtin_amdgcn_s_memrealtime() - tb < span) __builtin_amdgcn_s_sleep(8); }
#endif
#undef IN
#undef SEAM
}

extern "C" void kernel_launch(void* const* d_in, const int* in_sizes, int n_in, void* d_out, int out_size, void* d_ws, size_t ws_size, hipStream_t stream) {
    static int grid = 0;
    if (grid == 0) {
        if (n_in != 26 || out_size != T * D || ws_size < WS_END) { fprintf(stderr, "kernel_launch: unexpected shapes (n_in %d out %d ws %zu)\n", n_in, out_size, ws_size); grid = -1; return; }
        int dev = 0, cus = 0, per_cu = 0;
        if (hipGetDevice(&dev) != hipSuccess || hipDeviceGetAttribute(&cus, hipDeviceAttributeMultiprocessorCount, dev) != hipSuccess) { grid = -1; return; }
        if (hipFuncSetAttribute((const void*)fwd_kernel, hipFuncAttributeMaxDynamicSharedMemorySize, LDS_BYTES) != hipSuccess) { fprintf(stderr, "kernel_launch: hipFuncSetAttribute failed\n"); grid = -1; return; }
        if (hipOccupancyMaxActiveBlocksPerMultiprocessor(&per_cu, (const void*)fwd_kernel, NTHREADS, LDS_BYTES) != hipSuccess || per_cu < 1) { fprintf(stderr, "kernel_launch: occupancy query says %d\n", per_cu); }
        (void)hipGetLastError();
        grid = cus > 256 ? 256 : cus;
    }
    if (grid < 0) return;
    (void)hipMemsetAsync((char*)d_ws + WS_CTL, 0, CTL_BYTES, stream);
    Params p{};
    const float** f = (const float**)&p;
    for (int i = 0; i < 26; ++i) f[i] = (const float*)d_in[i];
    p.out = (float*)d_out; p.ws = (unsigned char*)d_ws;
#if SPLIT_LAUNCH
    for (int k = 0; k < NPHASES; ++k) { p.ph_lo = k; p.ph_hi = k + 1; hipLaunchKernelGGL(fwd_kernel, dim3(grid), dim3(NTHREADS), LDS_BYTES, stream, p); }
#else
    p.ph_lo = 0; p.ph_hi = NPHASES;
    hipLaunchKernelGGL(fwd_kernel, dim3(grid), dim3(NTHREADS), LDS_BYTES, stream, p);
#endif
}
```

```cpp
#include <hip/hip_runtime.h>
#include <cstdio>
#include <cstdint>

#ifndef SPLIT_LAUNCH
#define SPLIT_LAUNCH 0
#endif

#define SPLIT_P3 1
#ifndef PROBE_MULT
#define PROBE_MULT 4
#endif
#ifdef PROBE_SEL
#define PT_LDS ((volatile LAS unsigned long long*)((LAS unsigned char*)0 + LDS_MISC + 96))
#define PT_BEGIN() do { if (threadIdx.x == 0) PT_LDS[0] = __builtin_amdgcn_s_memrealtime(); } while (0)
#define PT_END(sel) do { if ((sel) == PROBE_SEL && threadIdx.x == 0) PT_LDS[1] += __builtin_amdgcn_s_memrealtime() - PT_LDS[0]; } while (0)
#else
#define PT_BEGIN() do { } while (0)
#define PT_END(sel) do { } while (0)
#endif
#ifdef PROBE_SEL
#define PSTAMP(sel, expr) do { const unsigned long long t_ = __builtin_amdgcn_s_memrealtime(); expr; if ((sel) == PROBE_SEL) F.pacc += __builtin_amdgcn_s_memrealtime() - t_; } while (0)
#else
#define PSTAMP(sel, expr) do { expr; } while (0)
#endif
#ifndef GATES_F8
#define GATES_F8 1
#endif
#ifndef UNFOLD_CH
#define UNFOLD_CH 1
#endif
#ifndef RNN_FAST
#define RNN_FAST 1
#endif
#ifndef DFT_FAST
#define DFT_FAST 1
#endif
#define GAS __attribute__((address_space(1)))
#define LAS __attribute__((address_space(3)))
typedef unsigned short bf16_t;
typedef short bf16x8 __attribute__((ext_vector_type(8)));
typedef float f32x4 __attribute__((ext_vector_type(4)));
typedef float f32x2 __attribute__((ext_vector_type(2)));
typedef unsigned u32x4 __attribute__((ext_vector_type(4)));
typedef unsigned u32x2 __attribute__((ext_vector_type(2)));

constexpr int D = 1024, NB = 8, SEQ = 8192, T = NB * SEQ, CTXL = 256, TC = NB * CTXL, MT = T + TC;
constexpr int DIN = 4608, NCAT = 5120;
constexpr int NE = 32, TOPK = 4, DE = 1024;
constexpr float EPS = 1e-6f;
constexpr int HALF_T = T / 2;
constexpr int PHALF = HALF_T * TOPK + NE * 256;

constexpr size_t MiB = 1u << 20;
constexpr size_t WS_CTL = 0, CTL_BYTES = 1 * MiB;
constexpr size_t WS_MOD = 1 * MiB;
constexpr size_t WS_SPL = 1 * MiB + 256 * 1024;
constexpr size_t WS_DFTM = 1 * MiB + 512 * 1024;
constexpr size_t WS_WCAT = 2 * MiB;
constexpr size_t WS_WF = 12 * MiB;
constexpr size_t WS_WR = 13 * MiB;
constexpr size_t WS_WO = 15 * MiB;
constexpr size_t WS_GW = 17 * MiB;
constexpr size_t WS_WROUT = 18 * MiB;
constexpr size_t WS_AGG = 19 * MiB;
constexpr size_t WS_ROUTE = 26 * MiB;
constexpr size_t WS_B0 = 32 * MiB;
constexpr size_t WS_B1 = 164 * MiB;
constexpr size_t WS_B2 = 292 * MiB;
constexpr size_t WS_B3 = 424 * MiB;
constexpr size_t WS_B4 = 552 * MiB;
constexpr size_t WS_B5 = 680 * MiB;
constexpr size_t WS_B6 = 808 * MiB;
constexpr size_t WS_B7 = 936 * MiB;
constexpr size_t WS_WGU = 164 * MiB;
constexpr size_t WS_WD = 228 * MiB;
constexpr size_t WS_HN8S = 260 * MiB;
constexpr size_t WS_ACT = 532 * MiB;
constexpr size_t WS_OUTA = 668 * MiB;
constexpr size_t WS_END = 1000 * MiB;
static_assert((size_t)PHALF * 2048 <= 272 * MiB, "act capacity");
static_assert(WS_HN8S + (size_t)2 * PHALF * 1024 == WS_ACT && WS_ACT + (size_t)PHALF * 1024 == WS_OUTA, "half-1 overlays: act(1) = HN8S half 0, outa(1) = [HN8S half 1 | ACT]");
constexpr size_t RT_TOPI = 0;
constexpr size_t RT_TOPW = 256 * 1024;
constexpr size_t RT_RANK = RT_TOPW + 1 * MiB;
constexpr size_t RT_HIST = RT_RANK + 512 * 1024;
constexpr size_t RT_SLOTTOK = RT_HIST + 32 * 1024;
constexpr size_t RT_SLOTW = RT_SLOTTOK + 1152 * 1024;
constexpr size_t RT_TOKSLOT = RT_SLOTW + 1152 * 1024;
constexpr size_t RT_TILEEXP = RT_TOKSLOT + 1 * MiB;
constexpr size_t RT_END = RT_TILEEXP + 8192;
static_assert(RT_END <= 6 * MiB, "route tables");
constexpr int CW_NTILES = 16;
constexpr int CW_BAR = 4096;

constexpr int NWAVES = 8, NTHREADS = 512;
constexpr int LDS_BYTES = 155648;
constexpr int LDS_MISC = 151552;

__device__ __forceinline__ unsigned f2bf(float f) { unsigned u = __builtin_bit_cast(unsigned, f); return (u + 0x7fffu + ((u >> 16) & 1u)) >> 16; }
typedef __bf16 bf16x2_t __attribute__((ext_vector_type(2)));
__device__ __forceinline__ unsigned cvt_pk_bf16(float lo, float hi) { const f32x2 v = {lo, hi}; return __builtin_bit_cast(unsigned, __builtin_convertvector(v, bf16x2_t)); }
__device__ __forceinline__ unsigned pk2(float lo, float hi) { return cvt_pk_bf16(lo, hi); }
__device__ __forceinline__ float bf2f(unsigned short b) { return __builtin_bit_cast(float, (unsigned)b << 16); }
__device__ __forceinline__ float bflo(unsigned w) { return __builtin_bit_cast(float, w << 16); }
__device__ __forceinline__ float bfhi(unsigned w) { return __builtin_bit_cast(float, w & 0xffff0000u); }
__device__ __forceinline__ float fast_sigmoid(float x) { return __builtin_amdgcn_rcpf(1.0f + __builtin_amdgcn_exp2f(-1.44269504f * x)); }
__device__ __forceinline__ float wave_sum(float v, int lane) {
#pragma unroll
    for (int o = 1; o < 64; o <<= 1) v += __builtin_bit_cast(float, __builtin_amdgcn_ds_bpermute((lane ^ o) << 2, __builtin_bit_cast(int, v)));
    return v;
}

namespace pg8 {
constexpr int BM = 256, BK = 64, HALF = 128, HTB = HALF * BK * 2, STAGE_BYTES = 8 * HTB, NXCD = 8, WGM = 8;
__host__ __device__ __forceinline__ int lds_byte(int r, int chunk) { return r * 128 + ((chunk ^ ((r >> 1) & 7)) << 4); }
__host__ __device__ __forceinline__ void stage_rc(int b, int& R, int& C) { R = b >> 7; C = ((((b >> 4) & 7) ^ ((R >> 1) & 7))) * 8; }
__host__ __device__ __forceinline__ int perm32(int rho) { const int n = rho >> 4, i = rho & 15; return 8 * (i >> 2) + 4 * n + (i & 3); }

struct Unit { int pm, pn, aux; unsigned A; unsigned B; };

__device__ __forceinline__ bool tile_order(long L, int nM, int nN, int& pm, int& pn) {
    const int nwg = nM * nN; if (L >= nwg) return false;
    int wgid = (int)L; { const int q = nwg / NXCD, r = nwg % NXCD, xcd = wgid % NXCD, off = wgid / NXCD; wgid = (xcd < r ? xcd * (q + 1) : r * (q + 1) + (xcd - r) * q) + off; }
    const int nig = WGM * nN, gid = wgid / nig, fm = gid * WGM, gsz = (nM - fm) < WGM ? (nM - fm) : WGM;
    pm = fm + ((wgid % nig) % gsz); pn = (wgid % nig) / gsz; return true;
}

typedef int v8i32 __attribute__((ext_vector_type(8)));
typedef unsigned u32x8 __attribute__((ext_vector_type(8)));
template <bool F8> struct FragT { typedef bf16x8 type; };
template <> struct FragT<true> { typedef u32x8 type; };
template <class Epi, class Sched, bool GATHER, bool F8 = false, int DRY = 0>
__device__ __forceinline__ void gemm_phase(LAS unsigned char* lds, int tid_, const Sched& S, const Epi& E, const int nt, const unsigned lda, const unsigned ldb, const void* baseA, const void* baseB) {
    asm volatile("" : "+v"(tid_));
    const int tid = tid_, wid = __builtin_amdgcn_readfirstlane(tid >> 6), lane = tid & 63, wr = wid >> 2, wc = wid & 3, fr = lane & 15, fq = lane >> 4;
    const __amdgpu_buffer_rsrc_t rsA = __builtin_amdgcn_make_buffer_rsrc(const_cast<void*>(baseA), 0, -1, 0x00020000);
    const __amdgpu_buffer_rsrc_t rsB = __builtin_amdgcn_make_buffer_rsrc(const_cast<void*>(baseB), 0, -1, 0x00020000);
    unsigned voffA0, voffB0; int RA0;
    { int R, C; stage_rc(tid * 16, R, C); const int Rb = Epi::PERM ? ((R & ~31) + perm32(R & 31)) : R; RA0 = R;
      voffB0 = (unsigned)Rb * ldb + (unsigned)C * 2u; voffA0 = GATHER ? (unsigned)C * 2u : (unsigned)R * lda + (unsigned)C * 2u; }
    const unsigned p1A = GATHER ? 0u : 64u * lda, p1B = 64u * ldb;
    LAS unsigned* gtab = (LAS unsigned*)(lds + STAGE_BYTES);
    LAS float* etab = (LAS float*)(lds + STAGE_BYTES + 2048);
    const unsigned kstep = (unsigned)(BK * 2);
    const unsigned hstepB = (unsigned)HALF * ldb, hstepA = GATHER ? 0u : (unsigned)HALF * lda;
    const unsigned ldsw = (unsigned)wid * 1024u;
    int aoffk[2], boffk[2];
#pragma unroll
    for (int k = 0; k < 2; ++k) { aoffk[k] = lds_byte(wr * 64 + fr, 4 * k + fq); boffk[k] = lds_byte(wc * 32 + fr, 4 * k + fq); }
    constexpr int NKF = F8 ? 1 : 2;
    using Frag = typename FragT<F8>::type;
#define PG8_SA(b, h) (((b) * 2 + (h)) * HTB)
#define PG8_SB(b, h) ((4 + (b) * 2 + (h)) * HTB)
#define PG8_STAGE2(rs, bufoff, soff, o0, o1, p1) do { if constexpr (!(DRY & 4)) { \
        __builtin_amdgcn_raw_ptr_buffer_load_lds(rs, (LAS void*)(lds + (bufoff) + ldsw), 16, (int)(o0), (int)(soff), 0, 0); \
        __builtin_amdgcn_raw_ptr_buffer_load_lds(rs, (LAS void*)(lds + (bufoff) + ldsw + 8192), 16, (int)(o1), (int)((soff) + (p1)), 0, 0); } } while (0)
#define PG8_STAGE_B(bufoff, soff) PG8_STAGE2(rsB, bufoff, soff, voffB0, voffB0, p1B)
#define PG8_GO(par, hh, i) (gtab[(par) * 256 + (hh) * HALF + RA0 + 64 * (i)] + voffA0)
#define PG8_STAGE_A(bufoff, soff, hh) do { if constexpr (GATHER) PG8_STAGE2(rsA, bufoff, soff, PG8_GO(ui & 1, hh, 0), PG8_GO(ui & 1, hh, 1), 0u); \
        else PG8_STAGE2(rsA, bufoff, (soff) + (hh) * hstepA, voffA0, voffA0, p1A); } while (0)
#define PG8_STAGE_AN(bufoff, soff, hh, usenext) do { if constexpr (GATHER) { const int par_ = ((usenext) ? ui + 1 : ui) & 1; PG8_STAGE2(rsA, bufoff, soff, PG8_GO(par_, hh, 0), PG8_GO(par_, hh, 1), 0u); } \
        else PG8_STAGE2(rsA, bufoff, (soff) + (hh) * hstepA, voffA0, voffA0, p1A); } while (0)
#define PG8_RD(addr) (*(const LAS bf16x8*)(addr))
#define PG8_RD8(a0, a1) __builtin_bit_cast(Frag, __builtin_shufflevector(*(const LAS u32x4*)(a0), *(const LAS u32x4*)(a1), 0, 1, 2, 3, 4, 5, 6, 7))
#define PG8_LDA(dst, b, h) do { if constexpr (!(DRY & 1)) _Pragma("unroll") for (int m = 0; m < 4; ++m) _Pragma("unroll") for (int k = 0; k < NKF; ++k) { \
        if constexpr (F8) dst[m][k] = PG8_RD8(lds + PG8_SA(b, h) + aoffk[0] + m * 2048, lds + PG8_SA(b, h) + aoffk[1] + m * 2048); else dst[m][k] = __builtin_bit_cast(Frag, PG8_RD(lds + PG8_SA(b, h) + aoffk[k] + m * 2048)); } } while (0)
#define PG8_LDB(dst, b, h) do { if constexpr (!(DRY & 1)) _Pragma("unroll") for (int n = 0; n < 2; ++n) _Pragma("unroll") for (int k = 0; k < NKF; ++k) { \
        if constexpr (F8) dst[n][k] = PG8_RD8(lds + PG8_SB(b, h) + boffk[0] + n * 2048, lds + PG8_SB(b, h) + boffk[1] + n * 2048); else dst[n][k] = __builtin_bit_cast(Frag, PG8_RD(lds + PG8_SB(b, h) + boffk[k] + n * 2048)); } } while (0)
#define PG8_MMA(ai, bj, At, Bt) do { __builtin_amdgcn_s_setprio(1); if constexpr (!(DRY & 2)) _Pragma("unroll") for (int m = 0; m < 4; ++m) _Pragma("unroll") for (int n = 0; n < 2; ++n) _Pragma("unroll") for (int k = 0; k < NKF; ++k) { \
        if constexpr (F8) acc[ai][bj][m][n] = __builtin_amdgcn_mfma_scale_f32_16x16x128_f8f6f4(__builtin_bit_cast(v8i32, Bt[n][k]), __builtin_bit_cast(v8i32, At[m][k]), acc[ai][bj][m][n], 0, 0, 0, 127, 0, 127); \
        else acc[ai][bj][m][n] = __builtin_amdgcn_mfma_f32_16x16x32_bf16(__builtin_bit_cast(bf16x8, Bt[n][k]), __builtin_bit_cast(bf16x8, At[m][k]), acc[ai][bj][m][n], 0, 0, 0); } __builtin_amdgcn_s_setprio(0); } while (0)
#define PG8_WAIT_V(n) asm volatile("s_waitcnt vmcnt(" #n ")" ::: "memory")
#define PG8_WAIT_L(n) asm volatile("s_waitcnt lgkmcnt(" #n ")" ::: "memory")
#define PG8_BAR __builtin_amdgcn_s_barrier()
#define PG8_SCHED __builtin_amdgcn_sched_barrier(0)
    Unit cur, nxt; int ui = 0;
    if (!S.next(0, cur)) return;
    if constexpr (GATHER) {
        if (tid < 256) gtab[tid] = (unsigned)S.row(cur, tid) * lda;
        asm volatile("s_waitcnt lgkmcnt(0)" ::: "memory"); __builtin_amdgcn_s_barrier();
    }
    f32x4 acc[2][2][4][2];
#pragma unroll
    for (int a = 0; a < 2; ++a)
#pragma unroll
        for (int b = 0; b < 2; ++b)
#pragma unroll
            for (int m = 0; m < 4; ++m)
#pragma unroll
                for (int n = 0; n < 2; ++n) acc[a][b][m][n] = (f32x4){0.f, 0.f, 0.f, 0.f};
    Frag At[4][NKF], B0[2][NKF], B1[2][NKF];
    if constexpr (DRY & 1) { _Pragma("unroll") for (int m = 0; m < 4; ++m) _Pragma("unroll") for (int k = 0; k < NKF; ++k) { At[m][k] = Frag{}; if (m < 2) { B0[m][k] = Frag{}; B1[m][k] = Frag{}; } } }
    unsigned cA = cur.A, cB = cur.B;
    PG8_STAGE_B(PG8_SB(0, 0), cB); PG8_STAGE_B(PG8_SB(0, 1), cB + hstepB); PG8_STAGE_A(PG8_SA(0, 0), cA, 0); PG8_STAGE_A(PG8_SA(0, 1), cA, 1);
    if (wr == 1) PG8_BAR;
    PG8_WAIT_V(2); PG8_BAR;
    PG8_STAGE_B(PG8_SB(1, 0), cB + kstep); PG8_STAGE_A(PG8_SA(1, 0), cA + kstep, 0); PG8_STAGE_B(PG8_SB(1, 1), cB + hstepB + kstep);
    PG8_WAIT_V(6); PG8_BAR;
    for (;;) {
        const bool has_next = S.next(ui + 1, nxt);
        const unsigned nA = has_next ? nxt.A : cA, nB = has_next ? nxt.B : cB;
        if constexpr (Sched::EVEC) S.evec_dma(cur, lds + STAGE_BYTES + 2048 + (ui & 1) * 2048, wid);
        if constexpr (GATHER) {
            if (tid < 256) gtab[((ui + 1) & 1) * 256 + tid] = has_next ? (unsigned)S.row(nxt, tid) * lda : gtab[(ui & 1) * 256 + tid];
        }
        if constexpr (!F8) PT_BEGIN();
#pragma unroll 1
        for (int t = 0; t < nt; t += 2) {
            const bool last = (t == nt - 2);
            const unsigned a1 = cA + (unsigned)(t + 1) * kstep;
            const unsigned a2 = last ? nA : cA + (unsigned)(t + 2) * kstep, b2 = last ? nB : cB + (unsigned)(t + 2) * kstep;
            const unsigned a3 = a2 + kstep, b3 = b2 + kstep;
            const bool un = GATHER && last;
            PG8_LDB(B0, 0, 0); PG8_LDB(B1, 0, 1); PG8_SCHED; PG8_LDA(At, 0, 0); PG8_STAGE_A(PG8_SA(1, 1), a1, 1);
            PG8_WAIT_V(8); PG8_WAIT_L(0); PG8_BAR; PG8_MMA(0, 0, At, B0); PG8_MMA(0, 1, At, B1); PG8_BAR; PG8_SCHED;
            PG8_LDA(At, 0, 1); PG8_STAGE_B(PG8_SB(0, 0), b2); PG8_STAGE_B(PG8_SB(0, 1), b2 + hstepB); PG8_STAGE_AN(PG8_SA(0, 0), a2, 0, un);
            PG8_WAIT_V(8); PG8_WAIT_L(0); PG8_BAR; PG8_MMA(1, 0, At, B0); PG8_MMA(1, 1, At, B1); PG8_BAR; PG8_SCHED;
            PG8_LDB(B0, 1, 0); PG8_LDB(B1, 1, 1); PG8_SCHED; PG8_LDA(At, 1, 0); PG8_STAGE_AN(PG8_SA(0, 1), a2, 1, un);
            PG8_WAIT_V(8); PG8_WAIT_L(0); PG8_BAR; PG8_MMA(0, 0, At, B0); PG8_MMA(0, 1, At, B1); PG8_BAR; PG8_SCHED;
            PG8_LDA(At, 1, 1); PG8_STAGE_B(PG8_SB(1, 0), b3); PG8_STAGE_B(PG8_SB(1, 1), b3 + hstepB); PG8_STAGE_AN(PG8_SA(1, 0), a3, 0, un);
            PG8_WAIT_V(8); PG8_WAIT_L(0); PG8_BAR; PG8_MMA(1, 0, At, B0); PG8_MMA(1, 1, At, B1); PG8_BAR; PG8_SCHED;
        }
        if constexpr (!F8) PT_END(10);
        if (wr == 0) PG8_BAR;
        { int t2 = tid; asm volatile("" : "+v"(t2));
          E(acc, cur, wr, wc, t2 & 15, (t2 & 63) >> 4, etab + (ui & 1) * 512); }
        if (!has_next) break;
#pragma unroll
        for (int a = 0; a < 2; ++a)
#pragma unroll
            for (int b = 0; b < 2; ++b)
#pragma unroll
                for (int m = 0; m < 4; ++m)
#pragma unroll
                    for (int n = 0; n < 2; ++n) acc[a][b][m][n] = (f32x4){0.f, 0.f, 0.f, 0.f};
        cur = nxt; cA = nA; cB = nB; ++ui;
        if (wr == 1) PG8_BAR;
    }
    PG8_WAIT_V(0);
    PG8_BAR;
#undef PG8_SA
#undef PG8_SB
#undef PG8_STAGE2
#undef PG8_STAGE_A
#undef PG8_STAGE_AN
#undef PG8_GO
#undef PG8_STAGE_B
#undef PG8_LDA
#undef PG8_LDB
#undef PG8_MMA
#undef PG8_RD
#undef PG8_RD8
#undef PG8_WAIT_V
#undef PG8_WAIT_L
#undef PG8_BAR
#undef PG8_SCHED
}
}

#define XB_TMO      128
#define XB_XCNT(j)  (256  + 64 * (j))
#define XB_XSUB(j)  (1280 + 64 * (j))
#define XB_XGEN(j)  (2304 + 64 * (j))
#define XB_TOP      3328
#define XB_TOPGEN   3392
#define XCD_BAR_WORDS 3456
#define XB_SPIN_CAP (1u << 22)

__device__ __forceinline__ unsigned xb_ld(unsigned* p)              { return __hip_atomic_load(p, __ATOMIC_RELAXED, __HIP_MEMORY_SCOPE_AGENT); }
__device__ __forceinline__ unsigned xb_add(unsigned* p, unsigned v) { return __hip_atomic_fetch_add(p, v, __ATOMIC_RELAXED, __HIP_MEMORY_SCOPE_AGENT); }
__device__ __forceinline__ unsigned xb_xcc_id() { return (unsigned)__builtin_amdgcn_s_getreg((3 << 11) | 20) & 0xFu; }
#define XB_SPIN(cond, bar) do { unsigned _sp = 0; while (cond) { __builtin_amdgcn_s_sleep(1); \
    if ((++_sp & 255u) == 0u) { if (xb_ld(&(bar)[XB_TMO])) break; if (_sp > XB_SPIN_CAP) { atomicAdd(&(bar)[XB_TMO], 1u); break; } } } } while (0)

struct XcdBarrier { unsigned* bar; unsigned x; volatile LAS unsigned* st; };

__device__ __forceinline__ XcdBarrier xcd_barrier_post(unsigned* bar, volatile LAS unsigned* st) {
    XcdBarrier b; b.bar = bar; b.x = xb_xcc_id(); b.st = st;
    if (threadIdx.x == 0) (void)xb_add(&bar[XB_XCNT(b.x)], 1u);
    return b;
}
__device__ __forceinline__ void xcd_barrier_complete(unsigned* bar, unsigned x, unsigned& nloc, unsigned& nx) {
    const unsigned G = gridDim.x * gridDim.y * gridDim.z;
    unsigned sum, cnt, mine, sp = 0u;
    for (;;) {
        sum = 0u; cnt = 0u; mine = 0u;
#pragma unroll
        for (unsigned j = 0; j < 16; ++j) { const unsigned c = xb_ld(&bar[XB_XCNT(j)]); sum += c; cnt += (c > 0u) ? 1u : 0u; mine = (j == x) ? c : mine; }
        if (sum == G) break;
        __builtin_amdgcn_s_sleep(1);
        if ((++sp & 255u) == 0u) { if (xb_ld(&bar[XB_TMO])) break; if (sp > XB_SPIN_CAP) { atomicAdd(&bar[XB_TMO], 1u); break; } }
    }
    nloc = mine > 0u ? mine : 1u; nx = cnt > 0u ? cnt : 1u;
}
__device__ __forceinline__ void xcd_barrier(const XcdBarrier& b) {
    asm volatile("s_waitcnt vmcnt(0)" ::: "memory");
    __syncthreads();
    if (threadIdx.x == 0) {
        unsigned* bar = b.bar;
        __builtin_amdgcn_s_waitcnt(0);
        unsigned nloc = b.st[0], nx = b.st[1];
        if (nloc == 0u) { xcd_barrier_complete(bar, b.x, nloc, nx); b.st[0] = nloc; b.st[1] = nx; }
        const unsigned old = xb_add(&bar[XB_XSUB(b.x)], 1u);
        const unsigned gen = old / nloc;
        if (old + 1u == (gen + 1u) * nloc) {
            __builtin_amdgcn_fence(__ATOMIC_RELEASE, "agent");
            asm volatile("s_waitcnt vmcnt(0)" ::: "memory");
            const unsigned og = xb_add(&bar[XB_TOP], 1u);
            const unsigned tg = og / nx;
            if (og + 1u == (tg + 1u) * nx) xb_add(&bar[XB_TOPGEN], 1u);
            else XB_SPIN(xb_ld(&bar[XB_TOPGEN]) == tg, bar);
            __builtin_amdgcn_fence(__ATOMIC_ACQUIRE, "agent");
            xb_add(&bar[XB_XGEN(b.x)], 1u);
            asm volatile("s_waitcnt vmcnt(0)" ::: "memory");
        } else {
            XB_SPIN(xb_ld(&bar[XB_XGEN(b.x)]) == gen, bar);
            __builtin_amdgcn_fence(__ATOMIC_ACQUIRE, "agent");
            asm volatile("s_waitcnt vmcnt(0)" ::: "memory");
        }
    }
    __syncthreads();
}

struct Params {
    const float *x, *c, *ctx, *c_ctx, *w_ada, *b_ada, *norm1, *w_in, *conv_w, *conv_b, *gate_a_w, *gate_a_b, *gate_x_w, *gate_x_b, *lam,
                *w_f, *w_r, *w_o, *norm2, *w_router, *b_router, *w_gu, *b_gu, *w_down, *b_down, *norm_f;
    float* out; unsigned char* ws;
    int ph_lo, ph_hi;
};
struct Frame {
    LAS unsigned char* lds; int tid, lane, wave, G, bid; unsigned long long pacc;
};
#define MODP(ws) ((const float*)((ws) + WS_MOD))
enum { M_SH1 = 0, M_SC1 = 1, M_G1 = 2, M_SH2 = 3, M_SC2 = 4, M_G2 = 5 };

__device__ __forceinline__ void p0_ada(const Params& p, Frame& F) {
    LAS float* scond = (LAS float*)F.lds;
    LAS float* red = (LAS float*)(F.lds + 9 * 1024 * 4);
    for (int i = F.tid; i < 9 * 1024; i += NTHREADS) { const int r = i >> 10, k = i & 1023; const float v = r < 8 ? p.c[r * 1024 + k] : p.c_ctx[k]; scond[i] = v / (1.0f + __expf(-v)); }
    __syncthreads();
    float* mod = (float*)(p.ws + WS_MOD);
    for (int i = F.bid * NTHREADS + F.tid; i < 2048; i += F.G * NTHREADS) ((float*)(p.ws + WS_SPL))[i] = 8.0f * log1pf(expf(-p.lam[i]));
    for (int item = F.bid; item < 6144 / 32; item += F.G) {
        const int n = item * 32 + (F.lane & 31), sl = F.wave * 2 + (F.lane >> 5);
        float a[9];
#pragma unroll
        for (int r = 0; r < 9; ++r) a[r] = 0.f;
#pragma unroll 8
        for (int kk = 0; kk < 64; ++kk) { const int k = sl * 64 + kk; const float w = p.w_ada[(size_t)k * 6144 + n];
#pragma unroll
            for (int r = 0; r < 9; ++r) a[r] += scond[r * 1024 + k] * w; }
#pragma unroll
        for (int r = 0; r < 9; ++r) red[(sl * 9 + r) * 32 + (F.lane & 31)] = a[r];
        __syncthreads();
        if (F.tid < 9 * 32) { const int r = F.tid >> 5, nn = F.tid & 31; float s = p.b_ada[item * 32 + nn];
            for (int q = 0; q < 16; ++q) s += red[(q * 9 + r) * 32 + nn];
            mod[r * 6144 + item * 32 + nn] = s; }
        __syncthreads();
    }
}
__device__ __forceinline__ void transpose_item(const float* W, int ldw, int ncol0, int k0, bf16_t* WT, int ldt, int drow0, LAS float* scr, int lane) {
#pragma unroll 8
    for (int i = 0; i < 32; ++i) { const int kk = 2 * i + (lane >> 5); scr[kk * 33 + (lane & 31)] = W[(size_t)(k0 + kk) * ldw + ncol0 + (lane & 31)]; }
    asm volatile("s_waitcnt lgkmcnt(0)" ::: "memory");
    const int c = lane & 7;
#pragma unroll
    for (int j = 0; j < 4; ++j) { const int n = (lane >> 3) + 8 * j; const LAS float* s = scr + (8 * c) * 33 + n;
        u32x4 o; o.x = pk2(s[0 * 33], s[1 * 33]); o.y = pk2(s[2 * 33], s[3 * 33]); o.z = pk2(s[4 * 33], s[5 * 33]); o.w = pk2(s[6 * 33], s[7 * 33]);
        *(u32x4*)(WT + (size_t)(drow0 + n) * ldt + k0 + 8 * c) = o; }
    asm volatile("s_waitcnt lgkmcnt(0)" ::: "memory");
}
__device__ __forceinline__ void transpose_item64(const float* W, int ldw, int ncol0, int k0, bf16_t* WT, int ldt, int drow0, LAS float* scr, int lane) {
    f32x4 v[16];
#pragma unroll
    for (int i = 0; i < 16; ++i) v[i] = *(const f32x4*)(W + (size_t)(k0 + 4 * i + (lane >> 4)) * ldw + ncol0 + 4 * (lane & 15));
#pragma unroll
    for (int i = 0; i < 16; ++i) { LAS float* d = scr + (4 * i + (lane >> 4)) * 65 + 4 * (lane & 15); d[0] = v[i].x; d[1] = v[i].y; d[2] = v[i].z; d[3] = v[i].w; }
    asm volatile("s_waitcnt lgkmcnt(0)" ::: "memory");
    const int c = lane & 7;
#pragma unroll
    for (int j = 0; j < 8; ++j) { const int n = (lane >> 3) + 8 * j; const LAS float* s = scr + (8 * c) * 65 + n;
        u32x4 o; o.x = pk2(s[0 * 65], s[1 * 65]); o.y = pk2(s[2 * 65], s[3 * 65]); o.z = pk2(s[4 * 65], s[5 * 65]); o.w = pk2(s[6 * 65], s[7 * 65]);
        *(u32x4*)(WT + (size_t)(drow0 + n) * ldt + k0 + 8 * c) = o; }
    asm volatile("s_waitcnt lgkmcnt(0)" ::: "memory");
}
__device__ __forceinline__ void transpose_item64_f8(const float* W, int ldw, int ncol0, int k0, unsigned char* WT, int ldt, int drow0, LAS float* scr, int lane) {
    f32x4 v[16];
#pragma unroll
    for (int i = 0; i < 16; ++i) v[i] = *(const f32x4*)(W + (size_t)(k0 + 4 * i + (lane >> 4)) * ldw + ncol0 + 4 * (lane & 15));
#pragma unroll
    for (int i = 0; i < 16; ++i) { LAS float* d = scr + (4 * i + (lane >> 4)) * 65 + 4 * (lane & 15); d[0] = v[i].x; d[1] = v[i].y; d[2] = v[i].z; d[3] = v[i].w; }
    asm volatile("s_waitcnt lgkmcnt(0)" ::: "memory");
    const int c = lane & 3;
#pragma unroll
    for (int j = 0; j < 4; ++j) { const int n = (lane >> 2) + 16 * j; const LAS float* s = scr + (16 * c) * 65 + n; unsigned w[4];
#pragma unroll
        for (int q = 0; q < 4; ++q) { int t = 0; t = __builtin_amdgcn_cvt_pk_fp8_f32(64.0f * s[(4 * q) * 65], 64.0f * s[(4 * q + 1) * 65], t, false);
            t = __builtin_amdgcn_cvt_pk_fp8_f32(64.0f * s[(4 * q + 2) * 65], 64.0f * s[(4 * q + 3) * 65], t, true); w[q] = (unsigned)t; }
        *(u32x4*)(WT + (size_t)(drow0 + n) * ldt + k0 + 16 * c) = (u32x4){w[0], w[1], w[2], w[3]}; }
    asm volatile("s_waitcnt lgkmcnt(0)" ::: "memory");
}
__device__ __forceinline__ void transpose_matrix(const float* W, int K, int ldw, int c0, int N, bf16_t* WT, int drow0, LAS float* scr, int gw, int ngw, int lane) {
    const int nb = N / 32, nitems = (K / 64) * nb;
    for (int it = gw; it < nitems; it += ngw) { const int kb = it / nb, b = it % nb; transpose_item(W, ldw, c0 + 32 * b, 64 * kb, WT, K, drow0 + 32 * b, scr, lane); }
}
__device__ __forceinline__ void p0_weights(const Params& p, Frame& F) {
    unsigned char* ws = p.ws;
    LAS float* scr = (LAS float*)(F.lds + 65536 + F.wave * 8704);
    LAS float* tab = (LAS float*)(F.lds + 65536 + 8 * 8704);
    if (F.tid < 128) tab[F.tid] = cospif((float)F.tid / 64.0f);
    __syncthreads();
    { bf16_t* m1 = (bf16_t*)(ws + WS_DFTM); bf16_t* m2 = m1 + 128 * 128;
      for (int i = F.bid * NTHREADS + F.tid; i < 256 * 128; i += F.G * NTHREADS) {
          const int n = i >> 7, c = i & 127, m = n & 127; const float a = (float)((m * c) & 127) / 64.0f;
          (m2 + 128 * 256)[i] = (bf16_t)f2bf(0.08838834764831845f * ((n >> 7) ? -sinpif(a) : cospif(a))); }
      for (int i = F.bid * NTHREADS + F.tid; i < 128 * 128 + 128 * 256; i += F.G * NTHREADS) {
          if (i < 128 * 128) { const int kk = i >> 7, k = i & 127, k1 = kk & 63, l1 = k & 63, oi = kk >> 6, ii = k >> 6; const float a = (float)((k1 * l1) & 63) / 32.0f; const float c = cospif(a), sn = sinpif(a);
              m1[i] = (bf16_t)f2bf(0.125f * (oi == ii ? c : (oi ? -sn : sn))); }
          else { const int j = i - 128 * 128, kk = j >> 8, k = j & 255, l2 = k & 127, ii = k >> 7; const float a = (float)((kk * l2) & 127) / 64.0f;
              m2[j] = (bf16_t)f2bf(0.08838834764831845f * (ii ? sinpif(a) : cospif(a))); } } }
    const int gw = F.bid * NWAVES + F.wave, ngw = F.G * NWAVES;
    bf16_t* wcat = (bf16_t*)(ws + WS_WCAT);
    for (int it = gw; it < (UNFOLD_CH ? 0 : 1024 * 4); it += ngw) {
        const int k = it >> 2, g = it & 3; const float* src = p.w_in + (size_t)k * DIN + g * 128;
        float re0 = 0.f, re1 = 0.f, im0 = 0.f, im1 = 0.f; const int m0 = F.lane, m1 = F.lane + 64;
        for (int c = 0; c < 128; ++c) { const float u = src[c];
            re0 += u * tab[(m0 * c) & 127]; im0 -= u * tab[(m0 * c + 96) & 127];
            re1 += u * tab[(m1 * c) & 127]; im1 -= u * tab[(m1 * c + 96) & 127]; }
        const float sc = 0.08838834764831845f;
        wcat[(size_t)(g * 128 + m0) * 1024 + k] = (bf16_t)f2bf(re0 * sc); wcat[(size_t)(g * 128 + m1) * 1024 + k] = (bf16_t)f2bf(re1 * sc);
        wcat[(size_t)(512 + g * 128 + m0) * 1024 + k] = (bf16_t)f2bf(im0 * sc); wcat[(size_t)(512 + g * 128 + m1) * 1024 + k] = (bf16_t)f2bf(im1 * sc);
    }
#if UNFOLD_CH
    {
        __syncthreads();
        LAS float* scr8 = (LAS float*)(F.lds + F.wave * 16640);
        constexpr int I_IN = 16 * 72, I_F = 8 * 16, I_R = 16 * 16, I_O = 16 * 16;
        for (int it = gw; it < I_IN + I_F + I_R + I_O; it += ngw) { int r = it;
            if (r < I_IN) { const int cb = r % 72;
                if (GATES_F8 && cb >= 40) transpose_item64_f8(p.w_in, DIN, 64 * cb, 64 * (r / 72), ws + WS_ROUTE, 1024, 64 * (cb - 40), scr8, F.lane);
                else transpose_item64(p.w_in, DIN, 64 * cb, 64 * (r / 72), wcat, 1024, 64 * cb, scr8, F.lane);
                continue; } r -= I_IN;
            if (r < I_F) { transpose_item64(p.w_f, 1024, 64 * (r % 16), 64 * (r / 16), (bf16_t*)(ws + WS_WF), 512, 64 * (r % 16), scr8, F.lane); continue; } r -= I_F;
            if (r < I_R) { transpose_item64(p.w_r, 1024, 64 * (r % 16), 64 * (r / 16), (bf16_t*)(ws + WS_WR), 1024, 64 * (r % 16), scr8, F.lane); continue; } r -= I_R;
            transpose_item64(p.w_o, 1024, 64 * (r % 16), 64 * (r / 16), (bf16_t*)(ws + WS_WO), 1024, 64 * (r % 16), scr8, F.lane); }
        __syncthreads();
    }
#else
    transpose_matrix(p.w_in, 1024, DIN, 512, 4096, wcat, 1024, scr, gw, ngw, F.lane);
    transpose_matrix(p.w_f, 512, 1024, 0, 1024, (bf16_t*)(ws + WS_WF), 0, scr, gw, ngw, F.lane);
    transpose_matrix(p.w_r, 1024, 1024, 0, 1024, (bf16_t*)(ws + WS_WR), 0, scr, gw, ngw, F.lane);
    transpose_matrix(p.w_o, 1024, 1024, 0, 1024, (bf16_t*)(ws + WS_WO), 0, scr, gw, ngw, F.lane);
#endif
    transpose_matrix(p.w_router, 1024, 32, 0, 32, (bf16_t*)(ws + WS_WROUT), 0, scr, gw, ngw, F.lane);
    for (int it = gw; it < 256; it += ngw) { const int q = it >> 3, sub = it & 7, d = q >> 4, ax = (q >> 3) & 1, h = q & 7;
        transpose_item((ax ? p.gate_x_w : p.gate_a_w) + (size_t)(d * 8 + h) * 16384, 128, 32 * (sub & 3), 64 * (sub >> 2), (bf16_t*)(ws + WS_GW) + (size_t)((d * 2 + ax) * 8 + h) * 16384, 128, 32 * (sub & 3), scr, F.lane); }
}
__device__ __forceinline__ void p_moe_weights(const Params& p, Frame& F) {
    LAS float* scr = (LAS float*)(F.lds + F.wave * 16640);
    const int gw = F.bid * NWAVES + F.wave, ngw = F.G * NWAVES;
    unsigned char* wgu = p.ws + WS_WGU; unsigned char* wd = p.ws + WS_WD;
    constexpr int IT_GU = 16 * 32, IT_D = 16 * 16;
    for (int it = gw; it < NE * (IT_GU + IT_D); it += ngw) {
        const int e = it / (IT_GU + IT_D); int r = it % (IT_GU + IT_D);
        if (r < IT_GU) { const int kb = r / 32, b = r % 32, n0 = 64 * b; const int j = n0 & 1023, up = n0 >> 10;
            const int drow = 256 * (j >> 7) + 128 * up + (j & 127);
            transpose_item64_f8(p.w_gu + (size_t)e * 1024 * 2048, 2048, n0, 64 * kb, wgu + (size_t)e * 2048 * 1024, 1024, drow, scr, F.lane);
        } else { r -= IT_GU; const int kb = r / 16, b = r % 16;
            transpose_item64_f8(p.w_down + (size_t)e * 1024 * 1024, 1024, 64 * b, 64 * kb, wd + (size_t)e * 1024 * 1024, 1024, 64 * b, scr, F.lane); }
    }
}

__device__ __forceinline__ void norm_row_bf16(const float* xrow, const float* gain, const float* sc, const float* sh, bf16_t* orow, int lane) {
    const GAS f32x4* xr = (const GAS f32x4*)xrow + lane;
    f32x4 v[4]; float s = 0.f;
#pragma unroll
    for (int j = 0; j < 4; ++j) { v[j] = xr[64 * j]; s += (v[j].x * v[j].x + v[j].y * v[j].y) + (v[j].z * v[j].z + v[j].w * v[j].w); }
    const float rs = 1.0f / sqrtf(wave_sum(s, lane) * (1.f / D) + EPS);
    GAS unsigned long long* o8 = (GAS unsigned long long*)orow + lane;
#pragma unroll
    for (int j = 0; j < 4; ++j) { const f32x4 g = ((const f32x4*)gain)[lane + 64 * j], a = ((const f32x4*)sc)[lane + 64 * j], b = ((const f32x4*)sh)[lane + 64 * j];
        const float o0 = v[j].x * rs * g.x * (1.f + a.x) + b.x, o1 = v[j].y * rs * g.y * (1.f + a.y) + b.y, o2 = v[j].z * rs * g.z * (1.f + a.z) + b.z, o3 = v[j].w * rs * g.w * (1.f + a.w) + b.w;
        o8[64 * j] = (unsigned long long)pk2(o0, o1) | ((unsigned long long)pk2(o2, o3) << 32); }
}
__device__ __forceinline__ void p1_norm(const Params& p, Frame& F) {
    const float* mod = MODP(p.ws); bf16_t* hx = (bf16_t*)(p.ws + WS_B0);
    const int gw = F.bid * NWAVES + F.wave, ngw = F.G * NWAVES;
    for (int chunk = gw; chunk < T / 32; chunk += ngw) {
        const int m0 = chunk * 32, r = m0 / SEQ;
        const float* sc = mod + r * 6144 + M_SC1 * 1024; const float* sh = mod + r * 6144 + M_SH1 * 1024;
        f32x4 gm[4], bsh[4];
#pragma unroll
        for (int j = 0; j < 4; ++j) { const f32x4 g = ((const f32x4*)p.norm1)[F.lane + 64 * j], a = ((const f32x4*)sc)[F.lane + 64 * j]; gm[j] = g * (1.0f + a); bsh[j] = ((const f32x4*)sh)[F.lane + 64 * j]; }
        f32x4 nx[3][4];
#pragma unroll
        for (int q = 0; q < 3; ++q)
#pragma unroll
            for (int j = 0; j < 4; ++j) nx[q][j] = ((const GAS f32x4*)(p.x + (size_t)(m0 + q) * D) + F.lane)[64 * j];
#pragma unroll 1
        for (int i3 = 0; i3 < 33; i3 += 3) {
#pragma unroll
            for (int q = 0; q < 3; ++q) { const int i = i3 + q; if (i < 32) { const int m = m0 + i; f32x4 v[4]; float s = 0.f;
#pragma unroll
                for (int j = 0; j < 4; ++j) { v[j] = nx[q][j]; if (i + 3 < 32) nx[q][j] = ((const GAS f32x4*)(p.x + (size_t)(m + 3) * D) + F.lane)[64 * j];
                    s += (v[j].x * v[j].x + v[j].y * v[j].y) + (v[j].z * v[j].z + v[j].w * v[j].w); }
                const float rs = 1.0f / sqrtf(wave_sum(s, F.lane) * (1.f / D) + EPS);
                GAS unsigned long long* o8 = (GAS unsigned long long*)(hx + (size_t)m * D) + F.lane;
#pragma unroll
                for (int j = 0; j < 4; ++j) { const f32x4 o = v[j] * rs * gm[j] + bsh[j]; o8[64 * j] = (unsigned long long)pk2(o.x, o.y) | ((unsigned long long)pk2(o.z, o.w) << 32);
                    if (GATES_F8) { int q8 = 0; q8 = __builtin_amdgcn_cvt_pk_fp8_f32(o.x, o.y, q8, false); q8 = __builtin_amdgcn_cvt_pk_fp8_f32(o.z, o.w, q8, true);
                        ((GAS unsigned*)(p.ws + WS_B1 + (size_t)m * D) + F.lane)[64 * j] = (unsigned)q8; } } } }
        }
    }
    for (int m = T + gw; m < MT; m += ngw)
        norm_row_bf16(p.ctx + (size_t)(m - T) * D, p.norm1, mod + 8 * 6144 + M_SC1 * 1024, mod + 8 * 6144 + M_SH1 * 1024, hx + (size_t)m * D, F.lane);
}

struct Sched2 {
    static constexpr bool EVEC = false;
    int G, c;
    __device__ __forceinline__ bool next(int i, pg8::Unit& u) const {
        const long L = (long)i * G + c; int pm, pn;
        constexpr int NNT = UNFOLD_CH ? (GATES_F8 ? 10 : 18) : 20, PZR = UNFOLD_CH ? 2 : 4;
        if (L < 256 * NNT) { pg8::tile_order(L, 256, NNT, pm, pn); }
        else if (L < 256 * NNT + 32) { const int j = (int)(L - 256 * NNT); pm = 256 + (j >> 2); pn = PZR + (j & 3); }
        else return false;
        u.pm = pm; u.pn = pn; u.aux = 0; u.A = (unsigned)pm * 256u * 2048u; u.B = (unsigned)pn * 256u * 2048u; return true;
    }
};
struct Sched2G {
    static constexpr bool EVEC = false;
    int G, c;
    __device__ __forceinline__ bool next(int i, pg8::Unit& u) const {
        long L; if (G == 256) { if (c < 32) { if (i >= 6) return false; L = 1856 + i * 32 + c; } else { L = (long)i * 224 + (c - 32); if (L >= 1856) return false; } }
        else L = (long)i * G + (c + G - (256 * 10 + 32) % G) % G;
        int pm, pn; if (!pg8::tile_order(L, 256, 8, pm, pn)) return false;
        u.pm = pm; u.pn = 10 + pn; u.aux = 0; u.A = (unsigned)pm * 256u * 1024u; u.B = (unsigned)pn * 256u * 1024u; return true;
    }
};
__device__ __forceinline__ f32x4 gelu_tanh4(f32x4 v) {
    f32x4 o;
#pragma unroll
    for (int j = 0; j < 4; ++j) { const float x = v[j]; o[j] = x * fast_sigmoid(1.59576912f * x * (1.0f + 0.044715f * x * x)); }
    return o;
}
__device__ __forceinline__ f32x4 sigmoid4(f32x4 v) { f32x4 o;
#pragma unroll
    for (int j = 0; j < 4; ++j) o[j] = fast_sigmoid(v[j]);
    return o; }
struct Epi2 {
    static constexpr bool PERM = true;
    unsigned char* ws; float gscale;
    __device__ __forceinline__ void operator()(const f32x4 (&acc)[2][2][4][2], const pg8::Unit& u, int wr, int wc, int fr, int fq, const LAS float* ev) const {
#if UNFOLD_CH
        const int t = u.pn < 2 ? 0 : ((u.pn + 2) >> 2), pq = u.pn < 2 ? u.pn : ((u.pn - 2) & 3); const int ld0 = t == 0 ? 512 : 1024;
        const size_t boff = t == 0 ? WS_B7 : t == 1 ? WS_B2 : t == 2 ? WS_B3 : t == 3 ? WS_B4 : WS_B5;
#else
        const int t = u.pn >> 2, pq = u.pn & 3; const int ld0 = 1024; const size_t boff = t == 0 ? WS_B1 : t == 1 ? WS_B2 : t == 2 ? WS_B3 : t == 3 ? WS_B4 : WS_B5;
#endif
        bf16_t* base = (bf16_t*)(ws + boff);
        const int row0 = u.pm * 256 + wr * 64 + fr, col0 = pq * 256 + wc * 32 + 8 * fq;
        const bool hm = (t == 1) || (t == 2); const size_t hstride = (t == 1 ? (size_t)MT : (size_t)T) * 128;
#pragma unroll
        for (int ai = 0; ai < 2; ++ai)
#pragma unroll
            for (int m = 0; m < 4; ++m) { const size_t r = (size_t)(row0 + ai * 128 + m * 16);
                bf16_t* rowp = hm ? base + (size_t)(pq * 2) * hstride + r * 128 + wc * 32 + 8 * fq : base + r * ld0 + col0;
                const size_t bjs = hm ? hstride : (size_t)128;
#pragma unroll
                for (int bj = 0; bj < 2; ++bj) { f32x4 v0 = acc[ai][bj][m][0], v1 = acc[ai][bj][m][1];
                    if (t == 2) { v0 = gelu_tanh4(v0); v1 = gelu_tanh4(v1); }
                    else if (t >= 3) { v0 = sigmoid4(v0 * gscale); v1 = sigmoid4(v1 * gscale); }
                    u32x4 w; w.x = cvt_pk_bf16(v0[0], v0[1]); w.y = cvt_pk_bf16(v0[2], v0[3]); w.z = cvt_pk_bf16(v1[0], v1[1]); w.w = cvt_pk_bf16(v1[2], v1[3]);
                    *(u32x4*)(rowp + bj * bjs) = w; } }
    }
};

struct EpiNull {
    static constexpr bool PERM = true;
    float* sink;
    __device__ __forceinline__ void operator()(const f32x4 (&acc)[2][2][4][2], const pg8::Unit& u, int wr, int wc, int fr, int fq, const LAS float* ev) const {
        float s = 0.f;
#pragma unroll
        for (int ai = 0; ai < 2; ++ai)
#pragma unroll
            for (int bj = 0; bj < 2; ++bj)
#pragma unroll
                for (int m = 0; m < 4; ++m)
#pragma unroll
                    for (int n = 0; n < 2; ++n) s += acc[ai][bj][m][n][0] + acc[ai][bj][m][n][1] + acc[ai][bj][m][n][2] + acc[ai][bj][m][n][3];
        if (s == 123456.789f) sink[u.pm] = s;
    }
};
__device__ __forceinline__ void p3_rnn_naive(const Params& p, Frame& F) {
    LAS float* wa = (LAS float*)F.lds;
    LAS float* wx = wa + 128 * 128;
    LAS float* urow = wx + 128 * 128;
    LAS float* part = urow + 128;
    const bf16_t* zr = (const bf16_t*)(p.ws + WS_B2);
    bf16_t* hf = (bf16_t*)(p.ws + WS_B0); bf16_t* hb = (bf16_t*)(p.ws + WS_B6);
    const int c = F.tid & 127, part_i = F.tid >> 7;
    for (int chain = F.bid; chain < 128; chain += F.G) {
        const int b = chain >> 4, d = (chain >> 3) & 1, h = chain & 7, ch = h * 128 + c;
        __syncthreads();
        for (int i = F.tid; i < 128 * 128; i += NTHREADS) { wa[i] = p.gate_a_w[((size_t)(d * 8 + h) * 128) * 128 + i]; wx[i] = p.gate_x_w[((size_t)(d * 8 + h) * 128) * 128 + i]; }
        const float ba = p.gate_a_b[d * 1024 + ch], bx = p.gate_x_b[d * 1024 + ch];
        const float lam = p.lam[d * 1024 + ch]; const float spl = 8.0f * log1pf(expf(-lam));
        const float cw0 = p.conv_w[0 * 1024 + ch], cw1 = p.conv_w[1 * 1024 + ch], cw2 = p.conv_w[2 * 1024 + ch], cw3 = p.conv_w[3 * 1024 + ch], cb = p.conv_b[ch];
        float hstate = 0.f;
        __syncthreads();
        for (int step = 0; step < CTXL + SEQ; ++step) {
            const bool isctx = step < CTXL; const int s = isctx ? step : step - CTXL; const int len = isctx ? CTXL : SEQ;
            const int t = d ? (len - 1 - s) : s;
            const size_t rbase = isctx ? (size_t)T + (size_t)b * CTXL : (size_t)b * SEQ;
            float u = 0.f;
            if (part_i == 0) {
                const int lo = isctx ? 0 : (t & ~63), hi = isctx ? CTXL : lo + 64;
                u = cb;
                if (t - 2 >= lo) u += cw0 * bf2f(zr[(rbase + t - 2) * 1024 + ch]);
                if (t - 1 >= lo) u += cw1 * bf2f(zr[(rbase + t - 1) * 1024 + ch]);
                u += cw2 * bf2f(zr[(rbase + t) * 1024 + ch]);
                if (t + 1 < hi) u += cw3 * bf2f(zr[(rbase + t + 1) * 1024 + ch]);
                urow[c] = u;
            }
            __syncthreads();
            float pa = 0.f, px = 0.f;
#pragma unroll 8
            for (int i = 0; i < 32; ++i) { const int ii = part_i * 32 + i; const float uv = urow[ii]; pa += uv * wa[ii * 128 + c]; px += uv * wx[ii * 128 + c]; }
            part[(0 * 4 + part_i) * 128 + c] = pa; part[(1 * 4 + part_i) * 128 + c] = px;
            __syncthreads();
            if (part_i == 0) {
                const float sa = ba + part[c] + part[128 + c] + part[256 + c] + part[384 + c];
                const float sx = bx + part[512 + c] + part[640 + c] + part[768 + c] + part[896 + c];
                const float r = 1.0f / (1.0f + expf(-sa)), ig = 1.0f / (1.0f + expf(-sx));
                const float la = -spl * r, a = expf(la), bt = sqrtf(-expm1f(2.0f * la)) * (ig * u);
                hstate = a * hstate + bt;
                if (!isctx) { bf16_t* o = d ? hb : hf; o[(rbase + t) * 1024 + ch] = (bf16_t)f2bf(hstate); }
            }
        }
    }
}
__device__ __forceinline__ void p3_dftA_naive(const Params& p, Frame& F, int myi, int nbl) {
    LAS float* c64 = (LAS float*)(F.lds + 140 * 1024); LAS float* s64 = c64 + 64;
    __syncthreads();
    if (F.tid < 64) { c64[F.tid] = cospif((float)F.tid / 32.0f); s64[F.tid] = sinpif((float)F.tid / 32.0f); }
    __syncthreads();
    const bf16_t* V = (const bf16_t*)(p.ws + WS_B1); bf16_t* Tb = (bf16_t*)(p.ws + WS_B1);
    const int m = F.tid;
    for (int item = myi; item < NB * 128; item += nbl) {
        const int b = item >> 7, l2 = item & 127;
        float xr[64], xi[64];
#pragma unroll
        for (int l1 = 0; l1 < 64; ++l1) { const size_t row = (size_t)b * SEQ + 128 * l1 + l2; xr[l1] = bf2f(V[row * 1024 + m]); xi[l1] = bf2f(V[row * 1024 + 512 + m]); }
        for (int k1 = 0; k1 < 64; ++k1) {
            float ar = 0.f, ai = 0.f;
#pragma unroll
            for (int l1 = 0; l1 < 64; ++l1) { const int q = (k1 * l1) & 63; const float cc = c64[q], ss = s64[q];
                ar += cc * xr[l1] + ss * xi[l1]; ai += cc * xi[l1] - ss * xr[l1]; }
            float tc, ts; sincospif((float)(k1 * l2) / 4096.0f, &ts, &tc);
            const float orr = (ar * tc + ai * ts) * 0.125f, oi = (ai * tc - ar * ts) * 0.125f;
            const size_t orow = (size_t)b * SEQ + 128 * k1 + l2;
            Tb[orow * 1024 + m] = (bf16_t)f2bf(orr); Tb[orow * 1024 + 512 + m] = (bf16_t)f2bf(oi);
        }
    }
}
__device__ __forceinline__ void p4_dftB_naive(const Params& p, Frame& F) {
    LAS bf16_t* tile = (LAS bf16_t*)F.lds;
    LAS float* c128 = (LAS float*)(F.lds + 140 * 1024); LAS float* s128 = c128 + 128;
    __syncthreads();
    if (F.tid < 128) { c128[F.tid] = cospif((float)F.tid / 64.0f); s128[F.tid] = sinpif((float)F.tid / 64.0f); }
    const bf16_t* Tb = (const bf16_t*)(p.ws + WS_B1); bf16_t* Y = (bf16_t*)(p.ws + WS_B7);
    for (int item = F.bid; item < NB * 64 * 2; item += F.G) {
        const int b = item >> 7, k1 = (item >> 1) & 63, chh = item & 1;
        __syncthreads();
        for (int i = F.tid; i < 128 * 64; i += NTHREADS) {
            const int l2 = i >> 6, pc = i & 63, im = pc >> 5, cc = (pc & 31) * 8;
            const size_t row = (size_t)b * SEQ + 128 * k1 + l2;
            *(LAS u32x4*)(tile + l2 * 512 + im * 256 + cc) = *(const u32x4*)(Tb + row * 1024 + im * 512 + chh * 256 + cc);
        }
        __syncthreads();
        const int m = F.tid & 255, kh = F.tid >> 8;
        for (int kk = 0; kk < 64; ++kk) { const int k2 = kh * 64 + kk; float s = 0.f;
#pragma unroll 8
            for (int l2 = 0; l2 < 128; ++l2) { const int q = (k2 * l2) & 127; s += c128[q] * bf2f(tile[l2 * 512 + m]) + s128[q] * bf2f(tile[l2 * 512 + 256 + m]); }
            Y[((size_t)b * SEQ + k1 + 64 * k2) * 512 + chh * 256 + m] = (bf16_t)f2bf(s * 0.08838834764831845f);
        }
    }
}
__device__ __forceinline__ void p4_yg_naive(const Params& p, Frame& F) {
    const u32x4* hf = (const u32x4*)(p.ws + WS_B0); const u32x4* hb = (const u32x4*)(p.ws + WS_B6); const u32x4* G = (const u32x4*)(p.ws + WS_B3); u32x4* yg = (u32x4*)(p.ws + WS_B2);
    const size_t n = (size_t)T * 1024 / 8;
    for (size_t i = (size_t)F.bid * NTHREADS + F.tid; i < n; i += (size_t)F.G * NTHREADS) {
        const u32x4 a = hf[i], b = hb[i], g = G[i]; u32x4 o;
        o.x = pk2((bflo(a.x) + bflo(b.x)) * bflo(g.x), (bfhi(a.x) + bfhi(b.x)) * bfhi(g.x));
        o.y = pk2((bflo(a.y) + bflo(b.y)) * bflo(g.y), (bfhi(a.y) + bfhi(b.y)) * bfhi(g.y));
        o.z = pk2((bflo(a.z) + bflo(b.z)) * bflo(g.z), (bfhi(a.z) + bfhi(b.z)) * bfhi(g.z));
        o.w = pk2((bflo(a.w) + bflo(b.w)) * bflo(g.w), (bfhi(a.w) + bfhi(b.w)) * bfhi(g.w));
        yg[i] = o;
    }
}

constexpr size_t AGG_CAR = 4608 * 1024;
constexpr int UP = 272;
template <int DIR> __device__ __forceinline__ void rnn_block(const f32x4 pa, const f32x4 px, const float (&u)[4], float ba, float bx, float spl2, float spl, int fq, int fr,
                                                             float& Pc, float& Lc, float (&hout)[4], float (&pout)[4]) {
    float a[4], b[4];
#pragma unroll
    for (int j = 0; j < 4; ++j) {
        const float r = __builtin_amdgcn_rcpf(1.0f + __builtin_amdgcn_exp2f(-1.44269504f * (pa[j] + ba)));
        const float ig = __builtin_amdgcn_rcpf(1.0f + __builtin_amdgcn_exp2f(-1.44269504f * (px[j] + bx)));
        a[j] = __builtin_amdgcn_exp2f(-spl2 * r);
        const float t = 2.0f * spl * r;
        const float om = t < 0.25f ? t * (1.0f - t * (0.5f - t * (0.16666667f - t * (0.041666668f - t * 0.0083333338f)))) : 1.0f - a[j] * a[j];
        b[j] = __builtin_amdgcn_sqrtf(om) * ig * u[j];
    }
    float P[4], L[4];
    if (DIR == 0) { P[0] = a[0]; L[0] = b[0];
#pragma unroll
        for (int j = 1; j < 4; ++j) { P[j] = a[j] * P[j - 1]; L[j] = a[j] * L[j - 1] + b[j]; } }
    else { P[3] = a[3]; L[3] = b[3];
#pragma unroll
        for (int j = 2; j >= 0; --j) { P[j] = a[j] * P[j + 1]; L[j] = a[j] * L[j + 1] + b[j]; } }
    float Pg = DIR == 0 ? P[3] : P[0], Lg = DIR == 0 ? L[3] : L[0];
    float Pp, Lp;
    if (DIR == 0) { Pp = __shfl_up(Pg, 16); Lp = __shfl_up(Lg, 16); if (fq >= 1) { Lg = Pg * Lp + Lg; Pg = Pg * Pp; }
                    Pp = __shfl_up(Pg, 32); Lp = __shfl_up(Lg, 32); if (fq >= 2) { Lg = Pg * Lp + Lg; Pg = Pg * Pp; } }
    else          { Pp = __shfl_down(Pg, 16); Lp = __shfl_down(Lg, 16); if (fq <= 2) { Lg = Pg * Lp + Lg; Pg = Pg * Pp; }
                    Pp = __shfl_down(Pg, 32); Lp = __shfl_down(Lg, 32); if (fq <= 1) { Lg = Pg * Lp + Lg; Pg = Pg * Pp; } }
    float Pe, Le;
    if (DIR == 0) { Pe = __shfl_up(Pg, 16); Le = __shfl_up(Lg, 16); if (fq == 0) { Pe = 1.f; Le = 0.f; } }
    else          { Pe = __shfl_down(Pg, 16); Le = __shfl_down(Lg, 16); if (fq == 3) { Pe = 1.f; Le = 0.f; } }
    const float Pin = Pe * Pc, Lin = Pe * Lc + Le;
#pragma unroll
    for (int j = 0; j < 4; ++j) { hout[j] = P[j] * Lin + L[j]; pout[j] = P[j] * Pin; }
    const float Pb = __shfl(Pg, DIR == 0 ? 48 + fr : fr), Lb = __shfl(Lg, DIR == 0 ? 48 + fr : fr);
    Lc = Pb * Lc + Lb; Pc = Pb * Pc;
}
template <int CTRL> __device__ __forceinline__ float dpp_mov(float old, float src) {
    return __builtin_bit_cast(float, __builtin_amdgcn_update_dpp(__builtin_bit_cast(int, old), __builtin_bit_cast(int, src), CTRL, 0xF, 0xF, false)); }
template <int DIR> __device__ __forceinline__ void rnn_block_t(const f32x4 pa, const f32x4 px, const float (&u)[4], const f32x4 ba, const f32x4 bx, const f32x4 spl, int fr,
                                                               float (&prevP)[4], float (&prevL)[4], float (&hout)[4], float (&pout)[4]) {
    float P[4], L[4];
#pragma unroll
    for (int h2 = 0; h2 < 2; ++h2) {
        const f32x2 xa = (h2 ? (f32x2){pa.z, pa.w} : (f32x2){pa.x, pa.y}) + (h2 ? (f32x2){ba.z, ba.w} : (f32x2){ba.x, ba.y});
        const f32x2 xx = (h2 ? (f32x2){px.z, px.w} : (f32x2){px.x, px.y}) + (h2 ? (f32x2){bx.z, bx.w} : (f32x2){bx.x, bx.y});
        const f32x2 sp = h2 ? (f32x2){spl.z, spl.w} : (f32x2){spl.x, spl.y};
        f32x2 ea = xa * (-1.44269504f), ex = xx * (-1.44269504f);
        ea.x = __builtin_amdgcn_exp2f(ea.x); ea.y = __builtin_amdgcn_exp2f(ea.y); ex.x = __builtin_amdgcn_exp2f(ex.x); ex.y = __builtin_amdgcn_exp2f(ex.y);
        f32x2 r = ea + 1.0f, ig = ex + 1.0f;
        r.x = __builtin_amdgcn_rcpf(r.x); r.y = __builtin_amdgcn_rcpf(r.y); ig.x = __builtin_amdgcn_rcpf(ig.x); ig.y = __builtin_amdgcn_rcpf(ig.y);
        const f32x2 sr = sp * r;
        f32x2 Pv = sr * (-1.44269504f); Pv.x = __builtin_amdgcn_exp2f(Pv.x); Pv.y = __builtin_amdgcn_exp2f(Pv.y);
        f32x2 om = Pv * (-Pv) + 1.0f;
        om.x = __builtin_amdgcn_sqrtf(om.x); om.y = __builtin_amdgcn_sqrtf(om.y);
        const f32x2 uu = {u[2 * h2], u[2 * h2 + 1]};
        const f32x2 Lv = om * ig * uu;
        P[2 * h2] = Pv.x; P[2 * h2 + 1] = Pv.y; L[2 * h2] = Lv.x; L[2 * h2 + 1] = Lv.y;
    }
#define RNN_EDGE(SH) \
        "v_fmac_f32_dpp %0, %8, %4 " SH " row_mask:0xf bank_mask:0xf\n\t" "v_fmac_f32_dpp %1, %9, %5 " SH " row_mask:0xf bank_mask:0xf\n\t" \
        "v_fmac_f32_dpp %2, %10, %6 " SH " row_mask:0xf bank_mask:0xf\n\t" "v_fmac_f32_dpp %3, %11, %7 " SH " row_mask:0xf bank_mask:0xf\n\t" \
        "v_mul_f32_dpp %4, %12, %4 " SH " row_mask:0xf bank_mask:0xf\n\t" "v_mul_f32_dpp %5, %13, %5 " SH " row_mask:0xf bank_mask:0xf\n\t" \
        "v_mul_f32_dpp %6, %14, %6 " SH " row_mask:0xf bank_mask:0xf\n\t" "v_mul_f32_dpp %7, %15, %7 " SH " row_mask:0xf bank_mask:0xf\n\t"
#define RNN_STEP(SH) \
        "v_fmac_f32_dpp %0, %0, %4 " SH " row_mask:0xf bank_mask:0xf\n\t" "v_fmac_f32_dpp %1, %1, %5 " SH " row_mask:0xf bank_mask:0xf\n\t" \
        "v_fmac_f32_dpp %2, %2, %6 " SH " row_mask:0xf bank_mask:0xf\n\t" "v_fmac_f32_dpp %3, %3, %7 " SH " row_mask:0xf bank_mask:0xf\n\t" \
        "v_mul_f32_dpp %4, %4, %4 " SH " row_mask:0xf bank_mask:0xf\n\t" "v_mul_f32_dpp %5, %5, %5 " SH " row_mask:0xf bank_mask:0xf\n\t" \
        "v_mul_f32_dpp %6, %6, %6 " SH " row_mask:0xf bank_mask:0xf\n\t" "v_mul_f32_dpp %7, %7, %7 " SH " row_mask:0xf bank_mask:0xf\n\t"
    if (DIR == 0) asm volatile("s_nop 1\n\t" RNN_EDGE("row_shl:15") RNN_STEP("row_shr:1") RNN_STEP("row_shr:2") RNN_STEP("row_shr:4") RNN_STEP("row_shr:8")
                               : "+v"(L[0]), "+v"(L[1]), "+v"(L[2]), "+v"(L[3]), "+v"(P[0]), "+v"(P[1]), "+v"(P[2]), "+v"(P[3])
                               : "v"(prevL[0]), "v"(prevL[1]), "v"(prevL[2]), "v"(prevL[3]), "v"(prevP[0]), "v"(prevP[1]), "v"(prevP[2]), "v"(prevP[3]));
    else          asm volatile("s_nop 1\n\t" RNN_EDGE("row_shr:15") RNN_STEP("row_shl:1") RNN_STEP("row_shl:2") RNN_STEP("row_shl:4") RNN_STEP("row_shl:8")
                               : "+v"(L[0]), "+v"(L[1]), "+v"(L[2]), "+v"(L[3]), "+v"(P[0]), "+v"(P[1]), "+v"(P[2]), "+v"(P[3])
                               : "v"(prevL[0]), "v"(prevL[1]), "v"(prevL[2]), "v"(prevL[3]), "v"(prevP[0]), "v"(prevP[1]), "v"(prevP[2]), "v"(prevP[3]));
#undef RNN_STEP
#undef RNN_EDGE
#pragma unroll
    for (int j = 0; j < 4; ++j) { hout[j] = L[j]; pout[j] = P[j]; prevP[j] = P[j]; prevL[j] = L[j]; }
}
__device__ __forceinline__ void p3_rnn_fast(const Params& p, Frame& F) {
    LAS unsigned char* Rt = F.lds;
    LAS unsigned char* Ut = F.lds + 65536;
    bf16_t* zr = (bf16_t*)(p.ws + WS_B2); bf16_t* pfb = (bf16_t*)(p.ws + WS_B0); bf16_t* pbb = (bf16_t*)(p.ws + WS_B6);
    const bf16_t* gw = (const bf16_t*)(p.ws + WS_GW);
    f32x2* agg = (f32x2*)(p.ws + WS_AGG);
    const int fr = F.lane & 15, fq = F.lane >> 4, chl = 16 * F.wave + fr;
    const __amdgpu_buffer_rsrc_t rsPf = __builtin_amdgcn_make_buffer_rsrc(pfb, 0, -1, 0x00020000), rsS = __builtin_amdgcn_make_buffer_rsrc(zr, 0, -1, 0x00020000), rsPb = __builtin_amdgcn_make_buffer_rsrc(pbb, 0, -1, 0x00020000);
    const unsigned lane_off = (unsigned)(fr * 256 + (16 * F.wave + 4 * fq) * 2);
#define RNN_UNIT(ui_, pm_, h_, ok_) do { ok_ = true; \
        if (F.G == 256) { if ((ui_) < 8) { pm_ = F.bid; h_ = (ui_); } else if ((ui_) == 8 && F.bid < 64) { pm_ = 256 + (F.bid >> 3); h_ = F.bid & 7; } else ok_ = false; } \
        else { const int unit_ = F.bid + (ui_) * F.G; if (unit_ >= 264 * 8) ok_ = false; pm_ = unit_ >> 3; h_ = unit_ & 7; } } while (0)
    u32x4 pre[8];
    { int pm0, h0; bool ok0; RNN_UNIT(0, pm0, h0, ok0);
      if (ok0) {
#pragma unroll
          for (int i = 0; i < 8; ++i) { const int pc = F.tid + i * NTHREADS, r = pc >> 4, c16 = pc & 15; pre[i] = *(const GAS u32x4*)(zr + ((size_t)h0 * MT + (size_t)pm0 * 256 + r) * 128 + c16 * 8); } } }
    LAS float* cwt = (LAS float*)(F.lds + 135168);
    { int pm0, h0; bool ok0; RNN_UNIT(0, pm0, h0, ok0);
      if (ok0 && F.tid < 160) { const int k = F.tid >> 5, c = (F.tid & 31) * 4;
          *(LAS f32x4*)(cwt + k * 128 + c) = k < 4 ? *(const GAS f32x4*)(p.conv_w + k * 1024 + h0 * 128 + c) : *(const GAS f32x4*)(p.conv_b + h0 * 128 + c); } }
    for (int ui = 0;; ++ui) {
        int pm, h; bool ok; RNN_UNIT(ui, pm, h, ok); if (!ok) break;
        const bool isctx = pm >= 256;
        const size_t row0 = (size_t)pm * 256;
        const unsigned tile_mt = (unsigned)(((size_t)h * MT + row0) * 256), tile_t = (unsigned)(((size_t)h * T + row0) * 256);
        const int chl4 = 16 * F.wave + 4 * fq, ch4 = h * 128 + chl4;
        __syncthreads();
#pragma unroll
        for (int i = 0; i < 8; ++i) { const int pc = F.tid + i * NTHREADS, r = pc >> 4, c16 = pc & 15; *(LAS u32x4*)(Rt + r * 256 + c16 * 16) = pre[i]; }
        f32x4 ba = *(const GAS f32x4*)(p.gate_a_b + ch4), bx = *(const GAS f32x4*)(p.gate_x_b + ch4), spl = *(const GAS f32x4*)((const float*)(p.ws + WS_SPL) + ch4);
        bf16x8 bfa[4], bfx[4];
#pragma unroll
        for (int s = 0; s < 4; ++s) { bfa[s] = *(const GAS bf16x8*)(gw + ((size_t)((0 * 2 + 0) * 8 + h) * 128 + chl) * 128 + 32 * s + 8 * fq);
                                      bfx[s] = *(const GAS bf16x8*)(gw + ((size_t)((0 * 2 + 1) * 8 + h) * 128 + chl) * 128 + 32 * s + 8 * fq); }
        __syncthreads();
        { const int cp = F.tid & 15, rg = F.tid >> 4, r8 = rg * 8; const int lo = isctx ? 0 : (r8 & ~63), hi = isctx ? 256 : lo + 64;
#pragma unroll 1
          for (int c4 = 0; c4 < 2; ++c4) {
              const LAS float* cw = cwt + (ui & 1) * 640 + cp * 8 + c4 * 4;
              const f32x4 w0 = *(const LAS f32x4*)(cw), w1 = *(const LAS f32x4*)(cw + 128), w2 = *(const LAS f32x4*)(cw + 256), w3 = *(const LAS f32x4*)(cw + 384), cb4 = *(const LAS f32x4*)(cw + 512);
              f32x4 in[11];
#pragma unroll
              for (int i = 0; i < 11; ++i) { const int r = r8 - 2 + i; u32x2 v = {0u, 0u}; if (r >= lo && r < hi) v = *(const LAS u32x2*)(Rt + r * 256 + cp * 16 + c4 * 8);
                  in[i] = (f32x4){bflo(v.x), bfhi(v.x), bflo(v.y), bfhi(v.y)}; }
#pragma unroll
              for (int i = 0; i < 8; ++i) { const f32x4 o = cb4 + w0 * in[i] + w1 * in[i + 1] + w2 * in[i + 2] + w3 * in[i + 3];
                  *(LAS u32x2*)(Ut + (r8 + i) * UP + cp * 16 + c4 * 8) = (u32x2){pk2(o[0], o[1]), pk2(o[2], o[3])}; }
          }
        }
        __syncthreads();
        f32x4 ba1 = *(const GAS f32x4*)(p.gate_a_b + 1024 + ch4), bx1 = *(const GAS f32x4*)(p.gate_x_b + 1024 + ch4), spl1 = *(const GAS f32x4*)((const float*)(p.ws + WS_SPL) + 1024 + ch4);
        bf16x8 bfa1[4], bfx1[4];
#pragma unroll
        for (int s = 0; s < 4; ++s) { bfa1[s] = *(const GAS bf16x8*)(gw + ((size_t)((1 * 2 + 0) * 8 + h) * 128 + chl) * 128 + 32 * s + 8 * fq);
                                      bfx1[s] = *(const GAS bf16x8*)(gw + ((size_t)((1 * 2 + 1) * 8 + h) * 128 + chl) * 128 + 32 * s + 8 * fq); }
        {
#pragma unroll
            for (int j = 0; j < 4; ++j) asm volatile("" : "+v"(ba[j]), "+v"(bx[j]), "+v"(spl[j]));
            float prevP[4] = {1.f, 1.f, 1.f, 1.f}, prevL[4] = {0.f, 0.f, 0.f, 0.f};
#pragma unroll 1
            for (int mb = 0; mb < 16; ++mb) {
                f32x4 pa = {0.f, 0.f, 0.f, 0.f}, px = {0.f, 0.f, 0.f, 0.f};
#pragma unroll
                for (int s = 0; s < 4; ++s) { const bf16x8 af = *(const LAS bf16x8*)(Ut + (16 * mb + fr) * UP + (32 * s + 8 * fq) * 2);
                    pa = __builtin_amdgcn_mfma_f32_16x16x32_bf16(bfa[s], af, pa, 0, 0, 0); px = __builtin_amdgcn_mfma_f32_16x16x32_bf16(bfx[s], af, px, 0, 0, 0); }
                const u32x2 uw = *(const LAS u32x2*)(Ut + (16 * mb + fr) * UP + chl4 * 2);
                const float u[4] = {bflo(uw.x), bfhi(uw.x), bflo(uw.y), bfhi(uw.y)};
                float hout[4], pout[4];
                rnn_block_t<0>(pa, px, u, ba, bx, spl, fr, prevP, prevL, hout, pout);
                *(LAS u32x2*)(Rt + (16 * mb + fr) * 256 + chl4 * 2) = (u32x2){pk2(hout[0], hout[1]), pk2(hout[2], hout[3])};
                if (!isctx) __builtin_amdgcn_raw_buffer_store_b64((u32x2){pk2(pout[0], pout[1]), pk2(pout[2], pout[3])}, rsPf, (int)lane_off, (int)(tile_mt + (unsigned)mb * 4096u), 0);
            }
            if (fr == 15) {
#pragma unroll
                for (int j = 0; j < 4; ++j) agg[((size_t)0 * 264 + pm) * 1024 + ch4 + j] = (f32x2){prevP[j], prevL[j]}; }
        }
        f32x4 cwn = {0.f, 0.f, 0.f, 0.f}; bool havecw = false;
        { int pmn, hn2; bool okn; RNN_UNIT(ui + 1, pmn, hn2, okn);
          if (okn) {
#pragma unroll
              for (int i = 0; i < 8; ++i) { const int pc = F.tid + i * NTHREADS, r = pc >> 4, c16 = pc & 15; pre[i] = *(const GAS u32x4*)(zr + ((size_t)hn2 * MT + (size_t)pmn * 256 + r) * 128 + c16 * 8); }
              if (F.tid < 160) { const int k = F.tid >> 5, c = (F.tid & 31) * 4; havecw = true;
                  cwn = k < 4 ? *(const GAS f32x4*)(p.conv_w + k * 1024 + hn2 * 128 + c) : *(const GAS f32x4*)(p.conv_b + hn2 * 128 + c); } } }
        {
#pragma unroll
            for (int j = 0; j < 4; ++j) asm volatile("" : "+v"(ba1[j]), "+v"(bx1[j]), "+v"(spl1[j]));
            float prevP[4] = {1.f, 1.f, 1.f, 1.f}, prevL[4] = {0.f, 0.f, 0.f, 0.f};
#pragma unroll 1
            for (int mb = 15; mb >= 0; --mb) {
                f32x4 pa = {0.f, 0.f, 0.f, 0.f}, px = {0.f, 0.f, 0.f, 0.f};
#pragma unroll
                for (int s = 0; s < 4; ++s) { const bf16x8 af = *(const LAS bf16x8*)(Ut + (16 * mb + fr) * UP + (32 * s + 8 * fq) * 2);
                    pa = __builtin_amdgcn_mfma_f32_16x16x32_bf16(bfa1[s], af, pa, 0, 0, 0); px = __builtin_amdgcn_mfma_f32_16x16x32_bf16(bfx1[s], af, px, 0, 0, 0); }
                const u32x2 uw = *(const LAS u32x2*)(Ut + (16 * mb + fr) * UP + chl4 * 2);
                const float u[4] = {bflo(uw.x), bfhi(uw.x), bflo(uw.y), bfhi(uw.y)};
                float hout[4], pout[4];
                rnn_block_t<1>(pa, px, u, ba1, bx1, spl1, fr, prevP, prevL, hout, pout);
                const u32x2 hw = *(const LAS u32x2*)(Rt + (16 * mb + fr) * 256 + chl4 * 2);
                if (!isctx) {
                    __builtin_amdgcn_raw_buffer_store_b64((u32x2){pk2(bflo(hw.x) + hout[0], bfhi(hw.x) + hout[1]), pk2(bflo(hw.y) + hout[2], bfhi(hw.y) + hout[3])}, rsS, (int)lane_off, (int)(tile_mt + (unsigned)mb * 4096u), 0);
                    __builtin_amdgcn_raw_buffer_store_b64((u32x2){pk2(pout[0], pout[1]), pk2(pout[2], pout[3])}, rsPb, (int)lane_off, (int)(tile_t + (unsigned)mb * 4096u), 0); }
            }
            if (fr == 0) {
#pragma unroll
                for (int j = 0; j < 4; ++j) agg[((size_t)1 * 264 + pm) * 1024 + ch4 + j] = (f32x2){prevP[j], prevL[j]}; }
        }
        if (havecw) *(LAS f32x4*)(cwt + ((ui + 1) & 1) * 640 + (F.tid >> 5) * 128 + (F.tid & 31) * 4) = cwn;
    }
#undef RNN_UNIT
}
__device__ __forceinline__ void p3c_carries(const Params& p, Frame& F) {
    const f32x2* agg = (const f32x2*)(p.ws + WS_AGG); float* car = (float*)(p.ws + WS_AGG + AGG_CAR);
    for (int i = F.bid * NTHREADS + F.tid; i < 2 * NB * 1024; i += F.G * NTHREADS) {
        const int d = i >> 13, b = (i >> 10) & 7, ch = i & 1023;
        float c = agg[((size_t)d * 264 + 256 + b) * 1024 + ch].y;
        for (int s = 0; s < 32; ++s) { const int j = d ? 31 - s : s; const size_t t = (size_t)b * 32 + j;
            car[((size_t)d * 256 + t) * 1024 + ch] = c; const f32x2 a = agg[((size_t)d * 264 + t) * 1024 + ch]; c = a.x * c + a.y; }
    }
}
__device__ __forceinline__ void p4_yg_fast(const Params& p, Frame& F) {
    const bf16_t* S = (const bf16_t*)(p.ws + WS_B2); const bf16_t* Pf = (const bf16_t*)(p.ws + WS_B0); const bf16_t* Pb = (const bf16_t*)(p.ws + WS_B6); const bf16_t* G = (const bf16_t*)(p.ws + WS_B3);
    bf16_t* yg = (bf16_t*)(p.ws + WS_B1);
    const float* car = (const float*)(p.ws + WS_AGG + AGG_CAR);
    const int cg = F.tid & 127, ro = F.tid >> 7, hh = cg >> 4, cw = (cg & 15) * 8;
    for (int pm = F.bid; pm < 256; pm += F.G) {
        float cf[8], cb[8];
#pragma unroll
        for (int c = 0; c < 8; ++c) { cf[c] = car[((size_t)0 * 256 + pm) * 1024 + cg * 8 + c]; cb[c] = car[((size_t)1 * 256 + pm) * 1024 + cg * 8 + c]; }
#pragma unroll 4
        for (int rr = 0; rr < 64; ++rr) { const size_t row = (size_t)pm * 256 + ro + 4 * rr;
            const size_t om = ((size_t)hh * MT + row) * 128 + cw, ot = ((size_t)hh * T + row) * 128 + cw;
            const u32x4 s = *(const GAS u32x4*)(S + om), f = *(const GAS u32x4*)(Pf + om), b = *(const GAS u32x4*)(Pb + ot), g = *(const GAS u32x4*)(G + ot);
            u32x4 o;
            o.x = pk2((bflo(s.x) + bflo(f.x) * cf[0] + bflo(b.x) * cb[0]) * bflo(g.x), (bfhi(s.x) + bfhi(f.x) * cf[1] + bfhi(b.x) * cb[1]) * bfhi(g.x));
            o.y = pk2((bflo(s.y) + bflo(f.y) * cf[2] + bflo(b.y) * cb[2]) * bflo(g.y), (bfhi(s.y) + bfhi(f.y) * cf[3] + bfhi(b.y) * cb[3]) * bfhi(g.y));
            o.z = pk2((bflo(s.z) + bflo(f.z) * cf[4] + bflo(b.z) * cb[4]) * bflo(g.z), (bfhi(s.z) + bfhi(f.z) * cf[5] + bfhi(b.z) * cb[5]) * bfhi(g.z));
            o.w = pk2((bflo(s.w) + bflo(f.w) * cf[6] + bflo(b.w) * cb[6]) * bflo(g.w), (bfhi(s.w) + bfhi(f.w) * cf[7] + bfhi(b.w) * cb[7]) * bfhi(g.w));
            *(GAS u32x4*)(yg + row * 1024 + cg * 8) = o; }
    }
}

typedef short s16x4 __attribute__((ext_vector_type(4)));
__device__ __forceinline__ unsigned dft_offb(unsigned row, unsigned ch) { return 256u * row + 16u * (ch ^ (((row & 3u) << 2) | ((row >> 2) & 3u))); }
__device__ __forceinline__ unsigned dft_tr_addr(unsigned lane, unsigned c, unsigned ks, unsigned t) {
    const unsigned g = lane >> 4, q = (lane & 15u) >> 2, p = lane & 3u;
    return dft_offb(32u * ks + 8u * g + 4u * t + q, 2u * c + (p >> 1)) + 8u * (p & 1u);
}
template <int STAGE, int NIMG> __device__ __forceinline__ void dft_fast(const Params& p, Frame& F) {
    constexpr int NK = STAGE == 0 ? 128 : 256, NKS = NK / 32, IMG = NK * 256, MBW = NIMG * 4, NPC = 16 * NIMG  , DSP = NIMG * 256 + 16  ;
    constexpr int STG = (NK * 256 * NIMG + 128 * DSP <= 147456) ? NK * 256 * NIMG : 0;
    LAS unsigned char* X = F.lds; LAS unsigned char* St = F.lds + STG;
    bf16_t* V = (bf16_t*)(p.ws + WS_B1); bf16_t* Y = (bf16_t*)(p.ws + WS_B7);
    const int fr = F.lane & 15, fq = F.lane >> 4, q = F.wave & 3, mb0 = (F.wave >> 2) * MBW;
    bf16x8 bfr[2][NKS];
    { const bf16_t* mm = (const bf16_t*)(p.ws + WS_DFTM) + (STAGE == 0 ? 0 : 128 * 128);
#pragma unroll
      for (int o = 0; o < 2; ++o)
#pragma unroll
          for (int ks = 0; ks < NKS; ++ks) bfr[o][ks] = *(const bf16x8*)(mm + (size_t)(o * 64 + 16 * q + fr) * NK + 32 * ks + 8 * fq); }
    unsigned tra[2], xe[2];
#pragma unroll
    for (int t = 0; t < 2; ++t) { const unsigned g = (unsigned)F.lane >> 4, qq = ((unsigned)F.lane & 15u) >> 2, pp = (unsigned)F.lane & 3u, row = 8u * g + 4u * t + qq;
        const unsigned x = ((row & 3u) << 2) | ((row >> 2) & 3u); xe[t] = x & 14u; tra[t] = 256u * row + 16u * ((pp >> 1) ^ (x & 1u)) + 8u * (pp & 1u); }
    constexpr int NS = 512 / (128 * NIMG);
    const int nunits = (STAGE == 0 ? NB * 128 : NB * 64) * NS;
    int u0 = F.bid, ustride = F.G, ulimit = nunits;
    if (STAGE == 0 && F.G == 256) { if (F.bid < 64) { ustride = 64; ulimit = 576; } else { u0 = 576 + F.bid - 64; ustride = 192; } }
    constexpr int NLD = NK * NPC / NTHREADS;
    u32x4 pre[NLD];
    auto unit_decode = [&](int unit, int& b, int& a1, int& slab) { slab = unit % NS; const int rest = unit / NS; if (STAGE == 0) { b = rest >> 7; a1 = rest & 127; } else { b = rest >> 6; a1 = rest & 63; } };
    if (u0 < ulimit) { int b, a1, slab; unit_decode(u0, b, a1, slab);
#pragma unroll
        for (int i = 0; i < NLD; ++i) { const int pc = F.tid + i * NTHREADS, k = pc / NPC, c32 = pc % NPC, ri = k / (NK / 2), idx = k % (NK / 2);
            const size_t srow = (size_t)b * SEQ + (STAGE == 0 ? 128 * idx + a1 : 128 * a1 + idx);
            pre[i] = *(const GAS u32x4*)(V + srow * 1024 + ri * 512 + slab * (128 * NIMG) + c32 * 8); } }
    for (int unit = u0; unit < ulimit; unit += ustride) {
        int b, a1, slab; unit_decode(unit, b, a1, slab);
        __syncthreads();
#pragma unroll
        for (int i = 0; i < NLD; ++i) { const int pc = F.tid + i * NTHREADS, k = pc / NPC, c32 = pc % NPC;
            *(LAS u32x4*)(X + (c32 >> 4) * IMG + dft_offb((unsigned)k, (unsigned)(c32 & 15))) = pre[i]; }
        __syncthreads();
        if (unit + ustride < ulimit) { int nb, na1, nslab; unit_decode(unit + ustride, nb, na1, nslab);
#pragma unroll
            for (int i = 0; i < NLD; ++i) { const int pc = F.tid + i * NTHREADS, k = pc / NPC, c32 = pc % NPC, ri = k / (NK / 2), idx = k % (NK / 2);
                const size_t srow = (size_t)nb * SEQ + (STAGE == 0 ? 128 * idx + na1 : 128 * na1 + idx);
                pre[i] = *(const GAS u32x4*)(V + srow * 1024 + ri * 512 + nslab * (128 * NIMG) + c32 * 8); } }
        f32x4 acc[MBW][2];
#pragma unroll
        for (int mb = 0; mb < MBW; ++mb) { acc[mb][0] = (f32x4){0.f, 0.f, 0.f, 0.f}; acc[mb][1] = (f32x4){0.f, 0.f, 0.f, 0.f}; }
        LAS unsigned char* Xi = X + ((mb0 * 16) >> 7) * IMG; const unsigned c0 = (unsigned)(mb0 & 7);
#pragma unroll
        for (int ks = 0; ks < NKS; ++ks) {
#pragma unroll
            for (int mb = 0; mb < MBW; ++mb) {
                const s16x4 lo = __builtin_amdgcn_ds_read_tr16_b64_v4i16((LAS s16x4*)(Xi + ks * 8192 + tra[0] + 16u * ((2u * (c0 + mb)) ^ xe[0])));
                const s16x4 hi = __builtin_amdgcn_ds_read_tr16_b64_v4i16((LAS s16x4*)(Xi + ks * 8192 + tra[1] + 16u * ((2u * (c0 + mb)) ^ xe[1])));
                const bf16x8 af = {lo[0], lo[1], lo[2], lo[3], hi[0], hi[1], hi[2], hi[3]};
                acc[mb][0] = __builtin_amdgcn_mfma_f32_16x16x32_bf16(af, bfr[0][ks], acc[mb][0], 0, 0, 0);
                acc[mb][1] = __builtin_amdgcn_mfma_f32_16x16x32_bf16(af, bfr[1][ks], acc[mb][1], 0, 0, 0);
            }
            __builtin_amdgcn_sched_barrier(0);
        }
        if (STG == 0) __syncthreads();
        float tc = 1.f, ts = 0.f;
        if (STAGE == 0) sincospif((float)((16 * q + fr) * a1) / 4096.0f, &ts, &tc);
#pragma unroll
        for (int mb = 0; mb < MBW; ++mb) { f32x4 r0 = acc[mb][0], r1 = acc[mb][1];
            if (STAGE == 0) { const f32x4 tr = r0, ti = r1; r0 = tr * tc + ti * ts; r1 = ti * tc - tr * ts; }
            u32x2 w0, w1; w0.x = pk2(r0[0], r0[1]); w0.y = pk2(r0[2], r0[3]); w1.x = pk2(r1[0], r1[1]); w1.y = pk2(r1[2], r1[3]);
            *(LAS u32x2*)(St + (16 * q + fr) * DSP + (16 * (mb0 + mb) + 4 * fq) * 2) = w0;
            *(LAS u32x2*)(St + (64 + 16 * q + fr) * DSP + (16 * (mb0 + mb) + 4 * fq) * 2) = w1; }
        asm volatile("s_waitcnt lgkmcnt(0)" ::: "memory"); __builtin_amdgcn_s_barrier(); asm volatile("" ::: "memory");
#pragma unroll
        for (int i = 0; i < 128 * NPC / NTHREADS; ++i) { const int pc = F.tid + i * NTHREADS, row = pc / NPC, c32 = pc % NPC;
            const u32x4 v = *(const LAS u32x4*)(St + row * DSP + c32 * 16);
            if (STAGE == 0) { const int ri = row >> 6, k1 = row & 63; *(GAS u32x4*)(V + ((size_t)b * SEQ + 128 * k1 + a1) * 1024 + ri * 512 + slab * (128 * NIMG) + c32 * 8) = v; }
            else *(GAS u32x4*)(Y + ((size_t)b * SEQ + a1 + 64 * row) * 512 + slab * (128 * NIMG) + c32 * 8) = v; }
    }
}

__device__ __forceinline__ void dft_stageA_u(const Params& p, Frame& F) {
    constexpr int UPI = 272, IMG = 128 * 256, DSP = 272;
    LAS unsigned char* Ul = F.lds; LAS unsigned char* X = F.lds + 17408; LAS unsigned char* St = F.lds + 17408 + IMG;
    const bf16_t* ZF = (const bf16_t*)(p.ws + WS_B7); bf16_t* Tb = (bf16_t*)(p.ws + WS_B1);
    const int fr = F.lane & 15, fq = F.lane >> 4, q = F.wave & 3, mb0 = (F.wave >> 2) * 4;
    bf16x8 bfr[2][4], mfr0[2][4];
    { const bf16_t* mm = (const bf16_t*)(p.ws + WS_DFTM); const bf16_t* m0 = mm + 128 * 128 + 128 * 256;
#pragma unroll
      for (int o = 0; o < 2; ++o)
#pragma unroll
          for (int ks = 0; ks < 4; ++ks) { bfr[o][ks] = *(const bf16x8*)(mm + (size_t)(o * 64 + 16 * q + fr) * 128 + 32 * ks + 8 * fq);
                                           mfr0[o][ks] = *(const bf16x8*)(m0 + (size_t)(32 * F.wave + 16 * o + fr) * 128 + 32 * ks + 8 * fq); } }
    unsigned tra[2], xe[2];
#pragma unroll
    for (int t = 0; t < 2; ++t) { const unsigned g = (unsigned)F.lane >> 4, qq = ((unsigned)F.lane & 15u) >> 2, pp = (unsigned)F.lane & 3u, row = 8u * g + 4u * t + qq;
        const unsigned x = ((row & 3u) << 2) | ((row >> 2) & 3u); xe[t] = x & 14u; tra[t] = 256u * row + 16u * ((pp >> 1) ^ (x & 1u)) + 8u * (pp & 1u); }
    const int nunits = NB * 128 * 4;
    int u0 = F.bid, ustride = F.G, ulimit = nunits;
    if (F.G == 256) { if (F.bid < 64) { ustride = 64; ulimit = 576; } else { u0 = 576 + F.bid - 64; ustride = 192; } }
    u32x4 pre[2];
    if (u0 < ulimit) { const int g = u0 & 3, rest = u0 >> 2, b = rest >> 7, l2 = rest & 127;
#pragma unroll
        for (int i = 0; i < 2; ++i) { const int pc = F.tid + i * NTHREADS, l1 = pc >> 4, c16 = pc & 15;
            pre[i] = *(const GAS u32x4*)(ZF + ((size_t)b * SEQ + 128 * l1 + l2) * 512 + g * 128 + c16 * 8); } }
    for (int unit = u0; unit < ulimit; unit += ustride) {
        const int g = unit & 3, rest = unit >> 2, b = rest >> 7, l2 = rest & 127;
        __syncthreads();
#pragma unroll
        for (int i = 0; i < 2; ++i) { const int pc = F.tid + i * NTHREADS, l1 = pc >> 4, c16 = pc & 15; *(LAS u32x4*)(Ul + l1 * UPI + c16 * 16) = pre[i]; }
        __syncthreads();
        if (unit + ustride < ulimit) { const int nu = unit + ustride, ng = nu & 3, nrest = nu >> 2, nb = nrest >> 7, nl2 = nrest & 127;
#pragma unroll
            for (int i = 0; i < 2; ++i) { const int pc = F.tid + i * NTHREADS, l1 = pc >> 4, c16 = pc & 15;
                pre[i] = *(const GAS u32x4*)(ZF + ((size_t)nb * SEQ + 128 * l1 + nl2) * 512 + ng * 128 + c16 * 8); } }
        { f32x4 a1[2][4];
#pragma unroll
          for (int o = 0; o < 2; ++o)
#pragma unroll
              for (int lb = 0; lb < 4; ++lb) a1[o][lb] = (f32x4){0.f, 0.f, 0.f, 0.f};
#pragma unroll
          for (int ks = 0; ks < 4; ++ks)
#pragma unroll
              for (int lb = 0; lb < 4; ++lb) { const bf16x8 uf = *(const LAS bf16x8*)(Ul + (16 * lb + fr) * UPI + (32 * ks + 8 * fq) * 2);
                  a1[0][lb] = __builtin_amdgcn_mfma_f32_16x16x32_bf16(mfr0[0][ks], uf, a1[0][lb], 0, 0, 0);
                  a1[1][lb] = __builtin_amdgcn_mfma_f32_16x16x32_bf16(mfr0[1][ks], uf, a1[1][lb], 0, 0, 0); }
          const int ri = F.wave >> 2;
#pragma unroll
          for (int o = 0; o < 2; ++o)
#pragma unroll
              for (int lb = 0; lb < 4; ++lb) { const int m0 = (32 * F.wave + 16 * o + 4 * fq) & 127, k = ri * 64 + 16 * lb + fr;
                  *(LAS u32x2*)(X + dft_offb((unsigned)k, (unsigned)(m0 >> 3)) + (m0 & 7) * 2) = (u32x2){pk2(a1[o][lb][0], a1[o][lb][1]), pk2(a1[o][lb][2], a1[o][lb][3])}; }
        }
        __syncthreads();
        f32x4 acc[4][2];
#pragma unroll
        for (int mb = 0; mb < 4; ++mb) { acc[mb][0] = (f32x4){0.f, 0.f, 0.f, 0.f}; acc[mb][1] = (f32x4){0.f, 0.f, 0.f, 0.f}; }
        const unsigned c0 = (unsigned)(mb0 & 7);
#pragma unroll
        for (int ks = 0; ks < 4; ++ks) {
#pragma unroll
            for (int mb = 0; mb < 4; ++mb) {
                const s16x4 lo = __builtin_amdgcn_ds_read_tr16_b64_v4i16((LAS s16x4*)(X + ks * 8192 + tra[0] + 16u * ((2u * (c0 + mb)) ^ xe[0])));
                const s16x4 hi = __builtin_amdgcn_ds_read_tr16_b64_v4i16((LAS s16x4*)(X + ks * 8192 + tra[1] + 16u * ((2u * (c0 + mb)) ^ xe[1])));
                const bf16x8 af = {lo[0], lo[1], lo[2], lo[3], hi[0], hi[1], hi[2], hi[3]};
                acc[mb][0] = __builtin_amdgcn_mfma_f32_16x16x32_bf16(af, bfr[0][ks], acc[mb][0], 0, 0, 0);
                acc[mb][1] = __builtin_amdgcn_mfma_f32_16x16x32_bf16(af, bfr[1][ks], acc[mb][1], 0, 0, 0);
            }
            __builtin_amdgcn_sched_barrier(0);
        }
        float tc, ts; sincospif((float)((16 * q + fr) * l2) / 4096.0f, &ts, &tc);
#pragma unroll
        for (int mb = 0; mb < 4; ++mb) { const f32x4 tr = acc[mb][0], ti = acc[mb][1]; const f32x4 r0 = tr * tc + ti * ts, r1 = ti * tc - tr * ts;
            *(LAS u32x2*)(St + (16 * q + fr) * DSP + (16 * (mb0 + mb) + 4 * fq) * 2) = (u32x2){pk2(r0[0], r0[1]), pk2(r0[2], r0[3])};
            *(LAS u32x2*)(St + (64 + 16 * q + fr) * DSP + (16 * (mb0 + mb) + 4 * fq) * 2) = (u32x2){pk2(r1[0], r1[1]), pk2(r1[2], r1[3])}; }
        asm volatile("s_waitcnt lgkmcnt(0)" ::: "memory"); __builtin_amdgcn_s_barrier(); asm volatile("" ::: "memory");
#pragma unroll
        for (int i = 0; i < 4; ++i) { const int pc = F.tid + i * NTHREADS, row = pc >> 4, c16 = pc & 15, ri = row >> 6, k1 = row & 63;
            *(GAS u32x4*)(Tb + ((size_t)b * SEQ + 128 * k1 + l2) * 1024 + ri * 512 + g * 128 + c16 * 8) = *(const LAS u32x4*)(St + row * DSP + c16 * 16); }
    }
}

struct SchedPlain {
    static constexpr bool EVEC = false;
    unsigned lda, ldb; int nM, nN, G, c;
    __device__ __forceinline__ bool next(int i, pg8::Unit& u) const {
        const long L = (long)i * G + c; int pm, pn; if (!pg8::tile_order(L, nM, nN, pm, pn)) return false;
        u.pm = pm; u.pn = pn; u.aux = 0; u.A = (unsigned)pm * 256u * lda; u.B = (unsigned)pn * 256u * ldb; return true;
    }
};
struct EpiR {
    static constexpr bool PERM = true;
    const bf16_t* gate; bf16_t* out;
    __device__ __forceinline__ void operator()(const f32x4 (&acc)[2][2][4][2], const pg8::Unit& u, int wr, int wc, int fr, int fq, const LAS float* ev) const {
        const int row0 = u.pm * 256 + wr * 64 + fr, col0 = u.pn * 256 + wc * 32 + 8 * fq;
#pragma unroll
        for (int ai = 0; ai < 2; ++ai)
#pragma unroll
            for (int m = 0; m < 4; ++m) { const size_t off = (size_t)(row0 + ai * 128 + m * 16) * 1024 + col0;
#pragma unroll
                for (int bj = 0; bj < 2; ++bj) { const f32x4 v0 = acc[ai][bj][m][0], v1 = acc[ai][bj][m][1];
                    const u32x4 g = *(const u32x4*)(gate + off + bj * 128);
                    u32x4 w; w.x = cvt_pk_bf16(v0[0] * bflo(g.x), v0[1] * bfhi(g.x)); w.y = cvt_pk_bf16(v0[2] * bflo(g.y), v0[3] * bfhi(g.y));
                    w.z = cvt_pk_bf16(v1[0] * bflo(g.z), v1[1] * bfhi(g.z)); w.w = cvt_pk_bf16(v1[2] * bflo(g.w), v1[3] * bfhi(g.w));
                    *(u32x4*)(out + off + bj * 128) = w; } }
    }
};
struct EpiF {
    static constexpr bool PERM = true;
    const bf16_t* gate; const bf16_t* rp; bf16_t* out;
    __device__ __forceinline__ void operator()(const f32x4 (&acc)[2][2][4][2], const pg8::Unit& u, int wr, int wc, int fr, int fq, const LAS float* ev) const {
        const int row0 = u.pm * 256 + wr * 64 + fr, col0 = u.pn * 256 + wc * 32 + 8 * fq;
#pragma unroll
        for (int ai = 0; ai < 2; ++ai)
#pragma unroll
            for (int m = 0; m < 4; ++m) { const size_t off = (size_t)(row0 + ai * 128 + m * 16) * 1024 + col0;
#pragma unroll
                for (int bj = 0; bj < 2; ++bj) { const f32x4 v0 = acc[ai][bj][m][0], v1 = acc[ai][bj][m][1];
                    const u32x4 g = *(const u32x4*)(gate + off + bj * 128), r = *(const u32x4*)(rp + off + bj * 128);
                    u32x4 w; w.x = cvt_pk_bf16(v0[0] * bflo(g.x) + bflo(r.x), v0[1] * bfhi(g.x) + bfhi(r.x)); w.y = cvt_pk_bf16(v0[2] * bflo(g.y) + bflo(r.y), v0[3] * bfhi(g.y) + bfhi(r.y));
                    w.z = cvt_pk_bf16(v1[0] * bflo(g.z) + bflo(r.z), v1[1] * bfhi(g.z) + bfhi(r.z)); w.w = cvt_pk_bf16(v1[2] * bflo(g.w) + bflo(r.w), v1[3] * bfhi(g.w) + bfhi(r.w));
                    *(u32x4*)(out + off + bj * 128) = w; } }
    }
};
struct EpiO {
    static constexpr bool PERM = true;
    const float* x; const float* mod; bf16_t* out;
    __device__ __forceinline__ void operator()(const f32x4 (&acc)[2][2][4][2], const pg8::Unit& u, int wr, int wc, int fr, int fq, const LAS float* ev) const {
        const int row0 = u.pm * 256 + wr * 64 + fr, col0 = u.pn * 256 + wc * 32 + 8 * fq;
        const float* g1 = mod + (size_t)(u.pm >> 5) * 6144 + M_G1 * 1024;
        f32x4 gv[2][2];
#pragma unroll
        for (int bj = 0; bj < 2; ++bj)
#pragma unroll
            for (int n = 0; n < 2; ++n) gv[bj][n] = *(const f32x4*)(g1 + col0 + bj * 128 + n * 4);
#pragma unroll
        for (int ai = 0; ai < 2; ++ai)
#pragma unroll
            for (int m = 0; m < 4; ++m) { const size_t off = (size_t)(row0 + ai * 128 + m * 16) * 1024 + col0;
#pragma unroll
                for (int bj = 0; bj < 2; ++bj) { const f32x4 x0 = *(const f32x4*)(x + off + bj * 128), x1 = *(const f32x4*)(x + off + bj * 128 + 4);
                    const f32x4 v0 = x0 + gv[bj][0] * acc[ai][bj][m][0], v1 = x1 + gv[bj][1] * acc[ai][bj][m][1];
                    u32x4 w; w.x = cvt_pk_bf16(v0[0], v0[1]); w.y = cvt_pk_bf16(v0[2], v0[3]); w.z = cvt_pk_bf16(v1[0], v1[1]); w.w = cvt_pk_bf16(v1[2], v1[3]);
                    *(u32x4*)(out + off + bj * 128) = w; } }
    }
};

__device__ __forceinline__ void p7_route(const Params& p, Frame& F) {
    LAS bf16_t* At = (LAS bf16_t*)F.lds;
    LAS float* red = (LAS float*)(F.lds + 66560);
    LAS float* lg = (LAS float*)(F.lds + 99328);
    LAS int* etop = (LAS int*)(F.lds + 133120);
    LAS int* wcnt = etop + 1024;
    const float* mod = MODP(p.ws);
    unsigned char* hn = (unsigned char*)p.out + 128 * MiB;
    const bf16_t* x1b = (const bf16_t*)(p.ws + WS_B0);
    const bf16_t* wr = (const bf16_t*)(p.ws + WS_WROUT);
    unsigned char* rt = p.ws + WS_ROUTE;
    unsigned char* topi = rt + RT_TOPI; float* topw = (float*)(rt + RT_TOPW); unsigned short* rankl = (unsigned short*)(rt + RT_RANK); unsigned* hist = (unsigned*)(rt + RT_HIST);
    const int fr = F.lane & 15, fq = F.lane >> 4;
    bf16x8 breg[4][2];
#pragma unroll
    for (int s = 0; s < 4; ++s)
#pragma unroll
        for (int h2 = 0; h2 < 2; ++h2) breg[s][h2] = *(const bf16x8*)(wr + (size_t)(16 * h2 + fr) * 1024 + 128 * F.wave + 32 * s + 8 * fq);
    for (int blk = F.bid; blk < T / 256; blk += F.G) {
        const int t0 = blk * 256, b = t0 / SEQ;
        const float* sc = mod + b * 6144 + M_SC2 * 1024; const float* sh = mod + b * 6144 + M_SH2 * 1024;
        f32x4 gn[4], sf[4];
#pragma unroll
        for (int j = 0; j < 4; ++j) { const f32x4 g = ((const f32x4*)p.norm2)[F.lane + 64 * j], a = ((const f32x4*)sc)[F.lane + 64 * j]; gn[j] = g * (a + 1.0f); sf[j] = ((const f32x4*)sh)[F.lane + 64 * j]; }
        u32x2 n1[4][4], n2[4][4];
#pragma unroll
        for (int j2 = 0; j2 < 4; ++j2)
#pragma unroll
            for (int j = 0; j < 4; ++j) { n1[j2][j] = ((const GAS u32x2*)(x1b + (size_t)(t0 + 4 * F.wave + j2) * D) + F.lane)[64 * j];
                                          n2[j2][j] = ((const GAS u32x2*)(x1b + (size_t)(t0 + 32 + 4 * F.wave + j2) * D) + F.lane)[64 * j]; }
#pragma unroll 1
        for (int it = 0; it < 8; ++it) {
            const int r0 = t0 + 32 * it;
            u32x2 cx[4][4];
#pragma unroll
            for (int j2 = 0; j2 < 4; ++j2)
#pragma unroll
                for (int j = 0; j < 4; ++j) { cx[j2][j] = n1[j2][j]; n1[j2][j] = n2[j2][j];
                    if (it < 6) n2[j2][j] = ((const GAS u32x2*)(x1b + (size_t)(r0 + 64 + 4 * F.wave + j2) * D) + F.lane)[64 * j]; }
            float ssq[4];
#pragma unroll
            for (int j2 = 0; j2 < 4; ++j2) { float s = 0.f;
#pragma unroll
                for (int j = 0; j < 4; ++j) { const u32x2 w = cx[j2][j]; const float x0 = bflo(w.x), x1 = bfhi(w.x), x2 = bflo(w.y), x3 = bfhi(w.y); s += (x0 * x0 + x1 * x1) + (x2 * x2 + x3 * x3); }
                ssq[j2] = s; }
#pragma unroll
            for (int j2 = 0; j2 < 4; ++j2) ssq[j2] = wave_sum(ssq[j2], F.lane);
#pragma unroll
            for (int j2 = 0; j2 < 4; ++j2) {
                const int lr = 4 * F.wave + j2; const size_t row = (size_t)(r0 + lr);
                const float rs = 1.0f / sqrtf(ssq[j2] * (1.f / D) + EPS);
                GAS unsigned* o4 = (GAS unsigned*)(hn + row * D) + F.lane;
#pragma unroll
                for (int j = 0; j < 4; ++j) { const u32x2 w = cx[j2][j];
                    const float o0 = bflo(w.x) * rs * gn[j].x + sf[j].x, o1 = bfhi(w.x) * rs * gn[j].y + sf[j].y, o2 = bflo(w.y) * rs * gn[j].z + sf[j].z, o3 = bfhi(w.y) * rs * gn[j].w + sf[j].w;
                    const unsigned long long ww = (unsigned long long)pk2(o0, o1) | ((unsigned long long)pk2(o2, o3) << 32);
                    *(LAS unsigned long long*)(At + lr * 1032 + 4 * F.lane + 256 * j) = ww;
                    int q8 = 0; q8 = __builtin_amdgcn_cvt_pk_fp8_f32(o0, o1, q8, false); q8 = __builtin_amdgcn_cvt_pk_fp8_f32(o2, o3, q8, true);
                    o4[64 * j] = (unsigned)q8; }
            }
            asm volatile("s_waitcnt lgkmcnt(0)" ::: "memory"); __builtin_amdgcn_s_barrier(); asm volatile("" ::: "memory");
#pragma unroll
            for (int mt = 0; mt < 2; ++mt) {
                f32x4 a0 = {0.f, 0.f, 0.f, 0.f}, a1 = {0.f, 0.f, 0.f, 0.f};
#pragma unroll
                for (int s = 0; s < 4; ++s) { const bf16x8 af = *(const LAS bf16x8*)(At + (16 * mt + fr) * 1032 + 128 * F.wave + 32 * s + 8 * fq);
                    a0 = __builtin_amdgcn_mfma_f32_16x16x32_bf16(af, breg[s][0], a0, 0, 0, 0); a1 = __builtin_amdgcn_mfma_f32_16x16x32_bf16(af, breg[s][1], a1, 0, 0, 0); }
#pragma unroll
                for (int j = 0; j < 4; ++j) { red[(F.wave * 32 + 16 * mt + 4 * fq + j) * 32 + fr] = a0[j]; red[(F.wave * 32 + 16 * mt + 4 * fq + j) * 32 + 16 + fr] = a1[j]; }
            }
            asm volatile("s_waitcnt lgkmcnt(0)" ::: "memory"); __builtin_amdgcn_s_barrier(); asm volatile("" ::: "memory");
#pragma unroll
            for (int q = 0; q < 2; ++q) { const int row = (F.tid >> 5) + 16 * q, e = F.tid & 31; float s = p.b_router[e];
#pragma unroll
              for (int w = 0; w < 8; ++w) s += red[(w * 32 + row) * 32 + e];
              lg[(32 * it + row) * 33 + e] = s; }
        }
        __syncthreads();
        if (F.tid < 256) {
            const int row = F.tid; float v[4]; int ix[4]; unsigned used = 0u;
#pragma unroll
            for (int k = 0; k < 4; ++k) { float best = -3.0e38f; int bi = 0;
                for (int e = 0; e < 32; ++e) { const float x = lg[row * 33 + e]; if (!((used >> e) & 1u) && x > best) { best = x; bi = e; } }
                used |= 1u << bi; v[k] = best; ix[k] = bi; }
            const float e1 = __expf(v[1] - v[0]), e2 = __expf(v[2] - v[0]), e3 = __expf(v[3] - v[0]); const float inv = 1.0f / (1.0f + e1 + e2 + e3);
            const float w4[4] = {inv, e1 * inv, e2 * inv, e3 * inv};
            const size_t tok = (size_t)(t0 + row);
#pragma unroll
            for (int k = 0; k < 4; ++k) { topi[tok * 4 + k] = (unsigned char)ix[k]; topw[tok * 4 + k] = w4[k]; etop[row * 4 + k] = ix[k]; }
        }
        __syncthreads();
        const int a0i = 128 * F.wave + F.lane, a1i = a0i + 64; const int e0 = etop[a0i], e1 = etop[a1i]; int r0 = 0, r1 = 0;
        const unsigned long long lt = (1ull << F.lane) - 1ull;
#pragma unroll 1
        for (int e = 0; e < 32; ++e) { const unsigned long long m0 = __ballot(e0 == e), m1 = __ballot(e1 == e);
            if (e0 == e) r0 = __popcll(m0 & lt); if (e1 == e) r1 = __popcll(m0) + __popcll(m1 & lt);
            if (F.lane == 0) wcnt[F.wave * 32 + e] = __popcll(m0) + __popcll(m1); }
        __syncthreads();
        int b0 = 0, b1 = 0;
        for (int w = 0; w < F.wave; ++w) { b0 += wcnt[w * 32 + e0]; b1 += wcnt[w * 32 + e1]; }
        rankl[(size_t)t0 * 4 + a0i] = (unsigned short)(b0 + r0); rankl[(size_t)t0 * 4 + a1i] = (unsigned short)(b1 + r1);
        if (F.tid < 32) { int s = 0; for (int w = 0; w < 8; ++w) s += wcnt[w * 32 + F.tid]; hist[blk * 32 + F.tid] = (unsigned)s; }
        __syncthreads();
    }
}
__device__ __forceinline__ void p8_slots(const Params& p, Frame& F) {
    LAS int* tot = (LAS int*)F.lds; LAS int* base = tot + 32; LAS int* rup = tot + 64; LAS int* sp = tot + 96;
    unsigned char* rt = p.ws + WS_ROUTE;
    const unsigned char* topi = rt + RT_TOPI; const float* topw = (const float*)(rt + RT_TOPW); const unsigned short* rankl = (const unsigned short*)(rt + RT_RANK); const unsigned* hist = (const unsigned*)(rt + RT_HIST);
    int* slot_tok = (int*)(rt + RT_SLOTTOK); float* slot_w = (float*)(rt + RT_SLOTW); int* tok_slot = (int*)(rt + RT_TOKSLOT); int* tile_exp = (int*)(rt + RT_TILEEXP);
    unsigned* ctl = (unsigned*)(p.ws + WS_CTL);
    for (int blk = F.bid; blk < T / 256; blk += F.G) {
        const int half = blk >> 7;
        __syncthreads();
        { LAS int* part = tot + 1280; const int e = F.tid & 31, pt = F.tid >> 5; int t = 0, bs = 0;
#pragma unroll
          for (int q = 0; q < 8; ++q) { const int b2 = half * 128 + pt * 8 + q; const int h = (int)hist[b2 * 32 + e]; t += h; if (b2 < blk) bs += h; }
          part[pt * 32 + e] = t; part[512 + pt * 32 + e] = bs;
          __syncthreads();
          if (F.tid < 32) { int t2 = 0, b2s = 0;
#pragma unroll
              for (int q = 0; q < 16; ++q) { t2 += part[q * 32 + F.tid]; b2s += part[512 + q * 32 + F.tid]; }
              tot[F.tid] = t2; base[F.tid] = b2s; rup[F.tid] = (t2 + 255) & ~255; } }
        __syncthreads();
        if (F.tid < 33) { int s2 = 0;
#pragma unroll
            for (int e = 0; e < 32; ++e) { const int r = rup[e]; if (e < F.tid) s2 += r; }
            sp[F.tid] = s2; }
        __syncthreads();
        int* st = slot_tok + (size_t)half * PHALF; float* sw = slot_w + (size_t)half * PHALF;
#pragma unroll
        for (int q = 0; q < 2; ++q) { const int a = F.tid * 2 + q; const size_t ga = (size_t)blk * 1024 + a; const int e = topi[ga];
            const int slot = sp[e] + base[e] + (int)rankl[ga];
            st[slot] = (int)(ga >> 2); sw[slot] = topw[ga]; tok_slot[ga] = slot; }
        { LAS int* slotl = tot + 160;
          slotl[F.tid * 2] = sp[topi[(size_t)blk * 1024 + F.tid * 2]] + base[topi[(size_t)blk * 1024 + F.tid * 2]] + (int)rankl[(size_t)blk * 1024 + F.tid * 2];
          slotl[F.tid * 2 + 1] = sp[topi[(size_t)blk * 1024 + F.tid * 2 + 1]] + base[topi[(size_t)blk * 1024 + F.tid * 2 + 1]] + (int)rankl[(size_t)blk * 1024 + F.tid * 2 + 1];
          __syncthreads();
          const unsigned char* hn8 = (const unsigned char*)p.out + 128 * MiB; unsigned char* hs = p.ws + WS_HN8S + (size_t)half * PHALF * 1024;
#pragma unroll 8
          for (int i = 0; i < 32; ++i) { const int tl = F.wave * 32 + i; const u32x4 v = *(const GAS u32x4*)(hn8 + ((size_t)blk * 256 + tl) * 1024 + F.lane * 16);
#pragma unroll
              for (int k = 0; k < 4; ++k) *(GAS u32x4*)(hs + (size_t)slotl[tl * 4 + k] * 1024 + F.lane * 16) = v; }
        }
        if ((blk & 127) == 0) {
            if (F.tid == 0) ctl[CW_NTILES + half] = (unsigned)(sp[32] >> 8);
            for (int e = 0; e < 32; ++e) {
                for (int s = sp[e] + tot[e] + F.tid; s < sp[e] + rup[e]; s += NTHREADS) { st[s] = half * HALF_T; sw[s] = 0.f; }
                for (int t = (sp[e] >> 8) + F.tid; t < ((sp[e] + rup[e]) >> 8); t += NTHREADS) tile_exp[half * 1024 + t] = e;
            }
        }
    }
}
struct SchedG1 {
    static constexpr bool EVEC = true;
    const LAS int* texp; const float* b_gu; int ntiles, G, c;
    __device__ __forceinline__ bool next(int i, pg8::Unit& u) const {
        const long L = (long)i * G + c; int pm, pn; if (!pg8::tile_order(L, ntiles, 8, pm, pn)) return false;
        const int e = __builtin_amdgcn_readfirstlane(texp[pm]); u.pm = pm; u.pn = pn; u.aux = e; u.A = (unsigned)pm * 256u * 1024u; u.B = ((unsigned)e * 2048u + (unsigned)pn * 256u) * 1024u; return true;
    }
    __device__ __forceinline__ void evec_dma(const pg8::Unit& u, LAS unsigned char* dst, int wid) const {
        if (wid < 4) { const __amdgpu_buffer_rsrc_t rs = __builtin_amdgcn_make_buffer_rsrc(const_cast<float*>(b_gu), 0, -1, 0x00020000);
            const int l = (int)__builtin_amdgcn_mbcnt_hi(~0u, __builtin_amdgcn_mbcnt_lo(~0u, 0u));
            __builtin_amdgcn_raw_ptr_buffer_load_lds(rs, (LAS void*)(dst + wid * 256), 4, l * 4, (u.aux * 2048 + (wid >> 1) * 1024 + u.pn * 128 + (wid & 1) * 64) * 4, 0, 0); }
    }
};
struct EpiG1 {
    static constexpr bool PERM = true;
    const float* b_gu; unsigned char* act;
    __device__ __forceinline__ void operator()(const f32x4 (&acc)[2][2][4][2], const pg8::Unit& u, int wr, int wc, int fr, int fq, const LAS float* ev) const {
        const int row0 = u.pm * 256 + wr * 64 + fr, col0 = u.pn * 128 + wc * 32 + 8 * fq;
        const int cl = wc * 32 + 8 * fq;
        const f32x4 bg0 = *(const LAS f32x4*)(ev + cl), bg1 = *(const LAS f32x4*)(ev + cl + 4), bu0 = *(const LAS f32x4*)(ev + 128 + cl), bu1 = *(const LAS f32x4*)(ev + 128 + cl + 4);
        const f32x2 bgp[4] = {{bg0.x, bg0.y}, {bg0.z, bg0.w}, {bg1.x, bg1.y}, {bg1.z, bg1.w}}, bup[4] = {{bu0.x, bu0.y}, {bu0.z, bu0.w}, {bu1.x, bu1.y}, {bu1.z, bu1.w}};
#pragma unroll
        for (int ai = 0; ai < 2; ++ai)
#pragma unroll
            for (int m = 0; m < 4; ++m) {
                float o[8];
#pragma unroll
                for (int q = 0; q < 4; ++q) { const f32x4 ag = acc[ai][0][m][q >> 1], au = acc[ai][1][m][q >> 1];
                    f32x2 g = (q & 1) ? (f32x2){ag.z, ag.w} : (f32x2){ag.x, ag.y}, u = (q & 1) ? (f32x2){au.z, au.w} : (f32x2){au.x, au.y};
                    g = g * 0.015625f + bgp[q]; u = u * 0.015625f + bup[q];
                    g.x = fminf(g.x, 7.0f); g.y = fminf(g.y, 7.0f); u.x = __builtin_amdgcn_fmed3f(u.x, -7.0f, 7.0f); u.y = __builtin_amdgcn_fmed3f(u.y, -7.0f, 7.0f);
                    f32x2 e = g * (-1.702f * 1.44269504f); e.x = __builtin_amdgcn_exp2f(e.x); e.y = __builtin_amdgcn_exp2f(e.y);
                    f32x2 d = e + 1.0f; d.x = __builtin_amdgcn_rcpf(d.x); d.y = __builtin_amdgcn_rcpf(d.y);
                    const f32x2 r = (u * g + g) * d;
                    o[2 * q] = r.x; o[2 * q + 1] = r.y; }
                int w0 = 0, w1 = 0; w0 = __builtin_amdgcn_cvt_pk_fp8_f32(o[0], o[1], w0, false); w0 = __builtin_amdgcn_cvt_pk_fp8_f32(o[2], o[3], w0, true);
                w1 = __builtin_amdgcn_cvt_pk_fp8_f32(o[4], o[5], w1, false); w1 = __builtin_amdgcn_cvt_pk_fp8_f32(o[6], o[7], w1, true);
                *(u32x2*)(act + (size_t)(row0 + ai * 128 + m * 16) * 1024 + col0) = (u32x2){(unsigned)w0, (unsigned)w1}; }
    }
};
struct SchedG2 {
    static constexpr bool EVEC = true;
    const LAS int* texp; const float* b_down; const float* slot_w; int ntiles, G, c;
    __device__ __forceinline__ bool next(int i, pg8::Unit& u) const {
        const long L = (long)i * G + c; int pm, pn; if (!pg8::tile_order(L, ntiles, 4, pm, pn)) return false;
        const int e = __builtin_amdgcn_readfirstlane(texp[pm]); u.pm = pm; u.pn = pn; u.aux = e; u.A = (unsigned)pm * 256u * 1024u; u.B = ((unsigned)e * 1024u + (unsigned)pn * 256u) * 1024u; return true;
    }
    __device__ __forceinline__ void evec_dma(const pg8::Unit& u, LAS unsigned char* dst, int wid) const {
        const __amdgpu_buffer_rsrc_t rs = __builtin_amdgcn_make_buffer_rsrc(const_cast<float*>(wid < 4 ? b_down : slot_w), 0, -1, 0x00020000);
        const int l = (int)__builtin_amdgcn_mbcnt_hi(~0u, __builtin_amdgcn_mbcnt_lo(~0u, 0u));
        __builtin_amdgcn_raw_ptr_buffer_load_lds(rs, (LAS void*)(dst + wid * 256), 4, l * 4, (wid < 4 ? u.aux * 1024 + u.pn * 256 + wid * 64 : u.pm * 256 + (wid - 4) * 64) * 4, 0, 0);
    }
};
struct EpiG2 {
    static constexpr bool PERM = true;
    const float* b_down; const float* slot_w; unsigned char* outa;
    __device__ __forceinline__ void operator()(const f32x4 (&acc)[2][2][4][2], const pg8::Unit& u, int wr, int wc, int fr, int fq, const LAS float* ev) const {
        const int row0 = u.pm * 256 + wr * 64 + fr, col0 = u.pn * 256 + wc * 32 + 8 * fq;
        const int cl = wc * 32 + 8 * fq;
#pragma unroll
        for (int bj = 0; bj < 2; ++bj) { const f32x4 bv0 = *(const LAS f32x4*)(ev + bj * 128 + cl) * 16.0f, bv1 = *(const LAS f32x4*)(ev + bj * 128 + cl + 4) * 16.0f;
#pragma unroll
        for (int ai = 0; ai < 2; ++ai)
#pragma unroll
            for (int m = 0; m < 4; ++m) { const int row = row0 + ai * 128 + m * 16; const float sw = ev[256 + ai * 128 + wr * 64 + m * 16 + fr];
                const f32x4 v0 = (acc[ai][bj][m][0] * 0.25f + bv0) * sw, v1 = (acc[ai][bj][m][1] * 0.25f + bv1) * sw;
                int w0 = 0, w1 = 0; w0 = __builtin_amdgcn_cvt_pk_fp8_f32(v0[0], v0[1], w0, false); w0 = __builtin_amdgcn_cvt_pk_fp8_f32(v0[2], v0[3], w0, true);
                w1 = __builtin_amdgcn_cvt_pk_fp8_f32(v1[0], v1[1], w1, false); w1 = __builtin_amdgcn_cvt_pk_fp8_f32(v1[2], v1[3], w1, true);
                *(GAS u32x2*)(outa + (size_t)row * 1024 + col0 + bj * 128) = (u32x2){(unsigned)w0, (unsigned)w1}; } }
    }
};
__device__ __forceinline__ void p11_combine(const Params& p, Frame& F, int half) {
    const float* mod = MODP(p.ws); const int* tok_slot = (const int*)(p.ws + WS_ROUTE + RT_TOKSLOT); const bf16_t* x1b = (const bf16_t*)(p.ws + WS_B0);
    const unsigned char* outa = half ? p.ws + WS_HN8S + (size_t)PHALF * 1024 : p.ws + WS_OUTA;
    const int gw = F.bid * NWAVES + F.wave, ngw = F.G * NWAVES;
    const int col = 16 * F.lane;
    for (int m = half * HALF_T + gw; m < (half + 1) * HALF_T; m += ngw) {
        const float* g2 = mod + (size_t)(m / SEQ) * 6144 + M_G2 * 1024;
        const GAS int* tsg = (const GAS int*)tok_slot + (size_t)m * 4; const int s0 = tsg[0], s1 = tsg[1], s2 = tsg[2], s3 = tsg[3];
        const u32x4 a = *(const GAS u32x4*)(outa + (size_t)s0 * 1024 + col), b = *(const GAS u32x4*)(outa + (size_t)s1 * 1024 + col),
                    c = *(const GAS u32x4*)(outa + (size_t)s2 * 1024 + col), d = *(const GAS u32x4*)(outa + (size_t)s3 * 1024 + col);
        const u32x4 xa = *(const GAS u32x4*)(x1b + (size_t)m * 1024 + col), xb = *(const GAS u32x4*)(x1b + (size_t)m * 1024 + col + 8);
        const unsigned aw[4] = {a.x, a.y, a.z, a.w}, bw[4] = {b.x, b.y, b.z, b.w}, cw[4] = {c.x, c.y, c.z, c.w}, dw[4] = {d.x, d.y, d.z, d.w};
        const unsigned xw[8] = {xa.x, xa.y, xa.z, xa.w, xb.x, xb.y, xb.z, xb.w};
        float v[16]; float ss = 0.f;
#pragma unroll
        for (int q = 0; q < 4; ++q) {
            const f32x4 gg = *(const GAS f32x4*)(g2 + col + 4 * q);
            const f32x2 lo = (__builtin_amdgcn_cvt_pk_f32_fp8((int)aw[q], false) + __builtin_amdgcn_cvt_pk_f32_fp8((int)bw[q], false)) + (__builtin_amdgcn_cvt_pk_f32_fp8((int)cw[q], false) + __builtin_amdgcn_cvt_pk_f32_fp8((int)dw[q], false));
            const f32x2 hi = (__builtin_amdgcn_cvt_pk_f32_fp8((int)aw[q], true) + __builtin_amdgcn_cvt_pk_f32_fp8((int)bw[q], true)) + (__builtin_amdgcn_cvt_pk_f32_fp8((int)cw[q], true) + __builtin_amdgcn_cvt_pk_f32_fp8((int)dw[q], true));
            v[4 * q + 0] = bflo(xw[2 * q]) + gg.x * 0.0625f * lo.x; v[4 * q + 1] = bfhi(xw[2 * q]) + gg.y * 0.0625f * lo.y;
            v[4 * q + 2] = bflo(xw[2 * q + 1]) + gg.z * 0.0625f * hi.x; v[4 * q + 3] = bfhi(xw[2 * q + 1]) + gg.w * 0.0625f * hi.y;
            ss += (v[4 * q] * v[4 * q] + v[4 * q + 1] * v[4 * q + 1]) + (v[4 * q + 2] * v[4 * q + 2] + v[4 * q + 3] * v[4 * q + 3]); }
        const float rs = 1.0f / sqrtf(wave_sum(ss, F.lane) * (1.f / D) + EPS);
#pragma unroll
        for (int q = 0; q < 4; ++q) { const f32x4 na = *(const GAS f32x4*)(p.norm_f + col + 4 * q);
            *(GAS f32x4*)(p.out + (size_t)m * D + col + 4 * q) = (f32x4){v[4 * q] * rs * na.x, v[4 * q + 1] * rs * na.y, v[4 * q + 2] * rs * na.z, v[4 * q + 3] * rs * na.w}; }
    }
}

constexpr int NPHASES = 14;
__global__ void __launch_bounds__(NTHREADS, 2) fwd_kernel(Params p_arg) {
    extern __shared__ __attribute__((aligned(16))) unsigned char lds_raw[];
    Frame F; F.lds = (LAS unsigned char*)lds_raw; F.tid = threadIdx.x; F.lane = F.tid & 63; F.wave = __builtin_amdgcn_readfirstlane(F.tid >> 6); F.G = gridDim.x; F.bid = blockIdx.x; F.pacc = 0ull;
    typedef const unsigned long long __attribute__((address_space(4))) cu64;
    cu64* kp = (cu64*)__builtin_amdgcn_kernarg_segment_ptr();
    (void)p_arg;
    static_assert(sizeof(Params) % 8 == 0, "Params is a whole number of 8-byte words");
    Params p;
#define LOADP() do { unsigned long long* d_ = (unsigned long long*)&p; _Pragma("unroll") for (int i_ = 0; i_ < (int)(sizeof(Params) / 8); ++i_) d_[i_] = kp[i_]; } while (0)
    LOADP();
    const int kwave = F.wave;
    volatile LAS unsigned* misc = (volatile LAS unsigned*)(F.lds + LDS_MISC);
    if (F.tid < 64) misc[F.tid] = 0u;
    __syncthreads();
    unsigned char* ws = p.ws;
    unsigned* ctl = (unsigned*)(ws + WS_CTL);
    const int lo = p.ph_lo, hi = p.ph_hi;
    XcdBarrier bar; bar.bar = ctl + CW_BAR; bar.x = 0; bar.st = nullptr;
    if (hi - lo > 1) bar = xcd_barrier_post(ctl + CW_BAR, misc + 8);
#ifdef ONLY_PHASE
#define IN(k) ((k) == ONLY_PHASE && lo <= (k) && (k) < hi)
#else
#define IN(k) (lo <= (k) && (k) < hi)
#endif
#ifdef PROBE_PHASE
    volatile LAS unsigned long long* pr_ts = (volatile LAS unsigned long long*)(F.lds + LDS_MISC + 64);
    if (threadIdx.x == 0) { pr_ts[0] = __builtin_amdgcn_s_memrealtime(); pr_ts[1] = 0ull; }
#define SEAM(k) do { if (IN(k) && IN((k) + 1)) xcd_barrier(bar); if (threadIdx.x == 0) { if ((k) + 1 == PROBE_PHASE) pr_ts[0] = __builtin_amdgcn_s_memrealtime(); if ((k) == PROBE_PHASE) pr_ts[1] = __builtin_amdgcn_s_memrealtime(); } } while (0)
#else
#define SEAM(k) do { if (IN(k) && IN((k) + 1)) xcd_barrier(bar); } while (0)
#endif
#define PH() do { int l_; asm volatile("v_mbcnt_lo_u32_b32 %0, -1, 0\n\tv_mbcnt_hi_u32_b32 %0, -1, %0" : "=v"(l_)); const int t_ = kwave * 64 + l_; F.tid = t_; F.lane = l_; F.wave = kwave; asm volatile("" : "+s"(kp)); LOADP(); ws = p.ws; } while (0)

    if (IN(0)) { PH(); p0_ada(p, F); }
    SEAM(0);
    if (IN(1)) { PH(); p1_norm(p, F); __syncthreads(); p0_weights(p, F); }
    SEAM(1);
    if (IN(2)) { PH();
#ifdef DRY_P2
        { Sched2 S{F.G, F.bid}; EpiNull E{(float*)(ws + WS_AGG)};
          pg8::gemm_phase<EpiNull, Sched2, false, false, DRY_P2>(F.lds, F.tid, S, E, 16, 2048u, 2048u, ws + WS_B0, ws + WS_WCAT); }
#endif
        Sched2 S{F.G, F.bid}; Epi2 E{ws, 1.0f};
        pg8::gemm_phase<Epi2, Sched2, false>(F.lds, F.tid, S, E, 16, 2048u, 2048u, ws + WS_B0, ws + WS_WCAT);
#if GATES_F8
        { Sched2G S8{F.G, F.bid}; Epi2 E8{ws, 0.015625f};
          pg8::gemm_phase<Epi2, Sched2G, false, true>(F.lds, F.tid, S8, E8, 8, 1024u, 1024u, ws + WS_B1, ws + WS_ROUTE); }
#endif
    }
    SEAM(2);
    if (IN(3)) { PH(); p3_rnn_fast(p, F);
#if UNFOLD_CH
        dft_stageA_u(p, F);
#else
        dft_fast<0, 1>(p, F);
#endif
    }
    SEAM(3);
    if (IN(4)) { PH(); p3c_carries(p, F); dft_fast<1, 1>(p, F); }
    SEAM(4);
    if (IN(5)) { PH();
        if (F.bid & 1) p4_yg_fast(p, F);
        { SchedPlain S{1024, 1024, 256, 4, F.G, F.bid};
          EpiR E{(const bf16_t*)(ws + WS_B4), (bf16_t*)(ws + WS_B4)};
          pg8::gemm_phase<EpiR, SchedPlain, false>(F.lds, F.tid, S, E, 8, 1024u, 1024u, ws + WS_B7, ws + WS_WF); }
        if (!(F.bid & 1)) p4_yg_fast(p, F);
    }
    SEAM(5);
    if (IN(6)) { PH();
        SchedPlain S{2048, 2048, 256, 4, F.G, F.bid};
        EpiF E{(const bf16_t*)(ws + WS_B5), (const bf16_t*)(ws + WS_B4), (bf16_t*)(ws + WS_B2)};
        pg8::gemm_phase<EpiF, SchedPlain, false>(F.lds, F.tid, S, E, 16, 2048u, 2048u, ws + WS_B1, ws + WS_WR);
    }
    SEAM(6);
    if (IN(7)) { PH();
        if (F.bid & 1) { p_moe_weights(p, F); __syncthreads(); }
        SchedPlain S{2048, 2048, 256, 4, F.G, F.bid};
        EpiO E{p.x, MODP(ws), (bf16_t*)(ws + WS_B0)};
        pg8::gemm_phase<EpiO, SchedPlain, false>(F.lds, F.tid, S, E, 16, 2048u, 2048u, ws + WS_B2, ws + WS_WO);
        if (!(F.bid & 1)) p_moe_weights(p, F);
    }
    SEAM(7);
    if (IN(8)) { PH(); p7_route(p, F); }
    SEAM(8);
    if (IN(9)) { PH(); p8_slots(p, F); }
    SEAM(9);
#pragma unroll 1
    for (int st = 0; st < 4; ++st) {
        const int ph = 10 + st;
        const bool doG1 = st < 2, doG2 = (st == 1 || st == 2), doC = st >= 2;
        const int h1 = st, h2 = st - 1, hc = st - 2;
        if (IN(ph)) { PH();
            if (doC && !(doG2 && (F.bid & 1))) p11_combine(p, F, hc);
            int crot = F.bid;
            if (doG2) {
                const float* slot_w = (const float*)(ws + WS_ROUTE + RT_SLOTW) + (size_t)h2 * PHALF;
                const int* tile_exp = (const int*)(ws + WS_ROUTE + RT_TILEEXP) + h2 * 1024;
                const int ntiles = __builtin_amdgcn_readfirstlane((int)ctl[CW_NTILES + h2]);
                LAS int* texp = (LAS int*)(F.lds + 137216);
                for (int i = F.tid; i < ntiles; i += NTHREADS) texp[i] = tile_exp[i];
                __syncthreads();
                SchedG2 S{texp, p.b_down, slot_w, ntiles, F.G, F.bid};
                EpiG2 E{p.b_down, slot_w, h2 ? ws + WS_HN8S + (size_t)PHALF * 1024 : ws + WS_OUTA};
                pg8::gemm_phase<EpiG2, SchedG2, false, true>(F.lds, F.tid, S, E, 8, 1024u, 1024u, h2 ? ws + WS_HN8S : ws + WS_ACT, ws + WS_WD);
                crot = (F.bid + F.G - (ntiles * 4) % F.G) % F.G;
            }
            if (doG1) {
                const int* tile_exp = (const int*)(ws + WS_ROUTE + RT_TILEEXP) + h1 * 1024;
                const int ntiles = __builtin_amdgcn_readfirstlane((int)ctl[CW_NTILES + h1]);
                LAS int* texp = (LAS int*)(F.lds + 137216);
                for (int i = F.tid; i < ntiles; i += NTHREADS) texp[i] = tile_exp[i];
                __syncthreads();
                SchedG1 S{texp, p.b_gu, ntiles, F.G, crot};
                EpiG1 E{p.b_gu, h1 ? ws + WS_HN8S : ws + WS_ACT};
                pg8::gemm_phase<EpiG1, SchedG1, false, true>(F.lds, F.tid, S, E, 8, 1024u, 1024u, ws + WS_HN8S + (size_t)h1 * PHALF * 1024, ws + WS_WGU);
            }
            if (doC && doG2 && (F.bid & 1)) p11_combine(p, F, hc);
        }
        SEAM(ph);
    }
#ifdef PROBE_SEL
    if (F.bid == 0 && threadIdx.x == 0) { const unsigned long long span = (F.pacc + PT_LDS[1]) * PROBE_MULT, tb = __builtin_amdgcn_s_memrealtime();
        while (__builtin_amdgcn_s_memrealtime() - tb < span) __builtin_amdgcn_s_sleep(8); }
#endif
#ifdef PROBE_PHASE
    if (F.bid == 0 && threadIdx.x == 0) { const unsigned long long span = (pr_ts[1] - pr_ts[0]) * PROBE_MULT, tb = __builtin_amdgcn_s_memrealtime();
        while (__builtin_amdgcn_s_memrealtime() - tb < span) __builtin_amdgcn_s_sleep(8); }
#endif
#undef IN
#undef SEAM
}

extern "C" void kernel_launch(void* const* d_in, const int* in_sizes, int n_in, void* d_out, int out_size, void* d_ws, size_t ws_size, hipStream_t stream) {
    static int grid = 0;
    if (grid == 0) {
        if (n_in != 26 || out_size != T * D || ws_size < WS_END) { fprintf(stderr, "kernel_launch: unexpected shapes (n_in %d out %d ws %zu)\n", n_in, out_size, ws_size); grid = -1; return; }
        int dev = 0, cus = 0, per_cu = 0;
        if (hipGetDevice(&dev) != hipSuccess || hipDeviceGetAttribute(&cus, hipDeviceAttributeMultiprocessorCount, dev) != hipSuccess) { grid = -1; return; }
        if (hipFuncSetAttribute((const void*)fwd_kernel, hipFuncAttributeMaxDynamicSharedMemorySize, LDS_BYTES) != hipSuccess) { fprintf(stderr, "kernel_launch: hipFuncSetAttribute failed\n"); grid = -1; return; }
        if (hipOccupancyMaxActiveBlocksPerMultiprocessor(&per_cu, (const void*)fwd_kernel, NTHREADS, LDS_BYTES) != hipSuccess || per_cu < 1) { fprintf(stderr, "kernel_launch: occupancy query says %d\n", per_cu); }
        (void)hipGetLastError();
        grid = cus > 256 ? 256 : cus;
    }
    if (grid < 0) return;
    (void)hipMemsetAsync((char*)d_ws + WS_CTL, 0, CTL_BYTES, stream);
    Params p{};
    const float** f = (const float**)&p;
    for (int i = 0; i < 26; ++i) f[i] = (const float*)d_in[i];
    p.out = (float*)d_out; p.ws = (unsigned char*)d_ws;
#if SPLIT_LAUNCH
    for (int k = 0; k < NPHASES; ++k) { p.ph_lo = k; p.ph_hi = k + 1; hipLaunchKernelGGL(fwd_kernel, dim3(grid), dim3(NTHREADS), LDS_BYTES, stream, p); }
#else
    p.ph_lo = 0; p.ph_hi = NPHASES;
    hipLaunchKernelGGL(fwd_kernel, dim3(grid), dim3(NTHREADS), LDS_BYTES, stream, p);
#endif
}
```
